# Optimizing an MI355X kernel written in HIP

```python
import math
import jax, jax.numpy as jnp
from jax import lax
import numpy as np

D_MODEL = 4096
BATCH = 1
SEQ = 8192
DEPTH = 2

N_A_LAYERS = DEPTH // 2
N_B_LAYERS = DEPTH - N_A_LAYERS
EPS = 1e-6

SSM_EXPAND = 2
D_INNER = SSM_EXPAND * D_MODEL
SSM_HEAD_DIM = 64
SSM_HEADS = D_INNER // SSM_HEAD_DIM
SSM_GROUPS = 8
SSM_HEADS_PER_GROUP = SSM_HEADS // SSM_GROUPS
D_STATE = 128
SSM_CONV = 4
SSM_CHUNK = 128
SSM_CONV_DIM = D_INNER + 2 * SSM_GROUPS * D_STATE
SSM_IN_DIM = D_INNER + SSM_CONV_DIM + SSM_HEADS
SSM_NORM_EPS = 1e-5

ATTN_HEAD_DIM = 64
N_Q_HEADS = D_MODEL // ATTN_HEAD_DIM
N_KV_HEADS = 8
Q_PER_KV = N_Q_HEADS // N_KV_HEADS
Q_DIM = N_Q_HEADS * ATTN_HEAD_DIM
KV_DIM = N_KV_HEADS * ATTN_HEAD_DIM
WINDOW = 128
ATTN_BLOCK = 128

N_BUCKETS = 32
MAX_DISTANCE = 128

D_FF = 256 * ((8 * D_MODEL // 3 + 255) // 256)
FFN_CONV = 3

kernel_name = 'hybrid_ssd_swa_sink_yoco_block'


def rmsnorm(x, g, eps=EPS):
    xf = x.astype(jnp.float32)
    y = xf * lax.rsqrt(jnp.mean(xf * xf, axis=-1, keepdims=True) + eps)
    return (y * g.astype(jnp.float32)).astype(x.dtype)


def causal_dwconv(x, w, b):
    k_width, seq = w.shape[0], x.shape[1]
    xp = jnp.pad(x, ((0, 0), (k_width - 1, 0), (0, 0)))
    out = b + xp[:, 0:seq] * w[0]
    for k in range(1, k_width):
        out = out + xp[:, k:k + seq] * w[k]
    return out


def ssd_chunked(x, a, bm, cm):
    bsz, seq = x.shape[0], x.shape[1]
    n_chunks = seq // SSM_CHUNK
    x_c = x.reshape(bsz, n_chunks, SSM_CHUNK, SSM_GROUPS, SSM_HEADS_PER_GROUP, SSM_HEAD_DIM).transpose(1, 0, 2, 3, 4, 5)
    a_c = a.reshape(bsz, n_chunks, SSM_CHUNK, SSM_GROUPS, SSM_HEADS_PER_GROUP).transpose(1, 0, 3, 4, 2)
    b_c = bm.reshape(bsz, n_chunks, SSM_CHUNK, SSM_GROUPS, D_STATE).transpose(1, 0, 2, 3, 4)
    c_c = cm.reshape(bsz, n_chunks, SSM_CHUNK, SSM_GROUPS, D_STATE).transpose(1, 0, 2, 3, 4)
    tril = jnp.tril(jnp.ones((SSM_CHUNK, SSM_CHUNK), dtype=bool))

    def step(state, inp):
        xc, ac, bc, cc = inp
        a_cum = jnp.cumsum(ac, axis=-1)
        seg = a_cum[..., :, None] - a_cum[..., None, :]
        decay = jnp.exp(jnp.where(tril, seg, -jnp.inf))
        cb = jnp.einsum('blgn,bsgn->bgls', cc, bc)
        y_diag = jnp.einsum('bgrls,bsgrp->blgrp', cb[:, :, None] * decay, xc)
        y_off = jnp.einsum('blgn,bgrpn->blgrp', cc, state) * jnp.exp(a_cum).transpose(0, 3, 1, 2)[..., None]
        decay_to_end = jnp.exp(a_cum[..., -1:] - a_cum)
        new_state = state * jnp.exp(a_cum[..., -1])[..., None, None] + jnp.einsum('bsgn,bgrs,bsgrp->bgrpn', bc, decay_to_end, xc)
        return new_state, y_diag + y_off

    state0 = jnp.zeros((bsz, SSM_GROUPS, SSM_HEADS_PER_GROUP, SSM_HEAD_DIM, D_STATE), jnp.float32)
    _, ys = lax.scan(step, state0, (x_c, a_c, b_c, c_c))
    return ys.transpose(1, 0, 2, 3, 4, 5).reshape(bsz, seq, SSM_GROUPS, SSM_HEADS_PER_GROUP, SSM_HEAD_DIM)


def mamba2_mixer(u, w_in, conv_w, conv_b, dt_bias, a_log, d_skip, g_norm, w_out):
    bsz, seq, _ = u.shape
    zxbcdt = u @ w_in
    z, xbc, dt = jnp.split(zxbcdt, [D_INNER, D_INNER + SSM_CONV_DIM], axis=-1)
    xbc = jax.nn.silu(causal_dwconv(xbc, conv_w, conv_b))
    xs, bm, cm = jnp.split(xbc, [D_INNER, D_INNER + SSM_GROUPS * D_STATE], axis=-1)
    dt = jax.nn.softplus(dt.astype(jnp.float32) + dt_bias.astype(jnp.float32))
    a = -jnp.exp(a_log.astype(jnp.float32))
    dt = dt.reshape(bsz, seq, SSM_GROUPS, SSM_HEADS_PER_GROUP)
    x_h = xs.astype(jnp.float32).reshape(bsz, seq, SSM_GROUPS, SSM_HEADS_PER_GROUP, SSM_HEAD_DIM)
    y = ssd_chunked(x_h * dt[..., None], dt * a.reshape(SSM_GROUPS, SSM_HEADS_PER_GROUP),
                    bm.astype(jnp.float32).reshape(bsz, seq, SSM_GROUPS, D_STATE),
                    cm.astype(jnp.float32).reshape(bsz, seq, SSM_GROUPS, D_STATE))
    y = y + d_skip.astype(jnp.float32).reshape(SSM_GROUPS, SSM_HEADS_PER_GROUP, 1) * x_h
    y = y.reshape(bsz, seq, D_INNER) * jax.nn.silu(z.astype(jnp.float32))
    yg = y.reshape(bsz, seq, SSM_GROUPS, D_INNER // SSM_GROUPS)
    yg = yg * lax.rsqrt(jnp.mean(yg * yg, axis=-1, keepdims=True) + SSM_NORM_EPS)
    y = yg.reshape(bsz, seq, D_INNER) * g_norm.astype(jnp.float32)
    return y.astype(u.dtype) @ w_out


def t5_bucket(rel):
    max_exact = N_BUCKETS // 2
    relf = jnp.maximum(rel, 1).astype(jnp.float32)
    large = max_exact + (jnp.log(relf / max_exact) / math.log(MAX_DISTANCE / max_exact) * (N_BUCKETS - max_exact)).astype(jnp.int32)
    large = jnp.minimum(large, N_BUCKETS - 1)
    return jnp.where(rel < max_exact, rel, large)


def shared_kv(h, kv_norm, w_kv, b_kv):
    bsz, seq, _ = h.shape
    kv = rmsnorm(h, kv_norm) @ w_kv + b_kv
    k, v = jnp.split(kv, 2, axis=-1)
    return (k.reshape(bsz, seq, N_KV_HEADS, ATTN_HEAD_DIM), v.reshape(bsz, seq, N_KV_HEADS, ATTN_HEAD_DIM))


def swa_sink_attention(u, k_sh, v_sh, w_q, b_q, sinks, rel_bias, w_o, b_o):
    bsz, seq, _ = u.shape
    nb = seq // ATTN_BLOCK
    q = (u @ w_q + b_q).reshape(bsz, nb, ATTN_BLOCK, N_KV_HEADS, Q_PER_KV, ATTN_HEAD_DIM)
    pad = ((0, 0), (ATTN_BLOCK, 0), (0, 0), (0, 0))
    kb = jnp.pad(k_sh, pad).reshape(bsz, nb + 1, ATTN_BLOCK, N_KV_HEADS, ATTN_HEAD_DIM)
    vb = jnp.pad(v_sh, pad).reshape(bsz, nb + 1, ATTN_BLOCK, N_KV_HEADS, ATTN_HEAD_DIM)
    k2 = jnp.concatenate([kb[:, :-1], kb[:, 1:]], axis=2)
    v2 = jnp.concatenate([vb[:, :-1], vb[:, 1:]], axis=2)
    s = jnp.einsum('bnqgrd,bnkgd->bngrqk', q, k2).astype(jnp.float32) * (ATTN_HEAD_DIM ** -0.5)
    q_idx = jnp.arange(ATTN_BLOCK)
    k_idx = jnp.arange(2 * ATTN_BLOCK)
    rel = q_idx[:, None] - k_idx[None, :] + ATTN_BLOCK
    bias = rel_bias.astype(jnp.float32)[t5_bucket(jnp.maximum(rel, 0))]
    bias = bias.transpose(2, 0, 1).reshape(N_KV_HEADS, Q_PER_KV, ATTN_BLOCK, 2 * ATTN_BLOCK)
    key_pos = jnp.arange(nb)[:, None] * ATTN_BLOCK - ATTN_BLOCK + k_idx[None, :]
    mask = (rel >= 0)[None] & (rel < WINDOW)[None] & (key_pos >= 0)[:, None, :]
    s = jnp.where(mask[None, :, None, None], s + bias, -jnp.inf)
    sink = sinks.astype(jnp.float32).reshape(N_KV_HEADS, Q_PER_KV)[..., None, None]
    m = jnp.maximum(jnp.max(s, axis=-1, keepdims=True), sink)
    p = jnp.exp(s - m)
    p = p / (jnp.sum(p, axis=-1, keepdims=True) + jnp.exp(sink - m))
    o = jnp.einsum('bngrqk,bnkgd->bnqgrd', p.astype(v2.dtype), v2).reshape(bsz, seq, Q_DIM)
    return o @ w_o + b_o


def conv_ffn(u, w_up, conv_w, conv_b, w_down):
    gu = causal_dwconv(u @ w_up, conv_w, conv_b)
    g, v = jnp.split(gu, 2, axis=-1)
    return (jax.nn.silu(g) * v) @ w_down


def setup_inputs(seed: int = 0) -> dict:
    key = jax.random.key(seed)
    ks = jax.random.split(key, 26)

    def nrm(k, shape, scale):
        return jax.random.normal(k, shape, jnp.float32) * scale

    def gain(k, shape):
        return 1.0 + nrm(k, shape, 0.05)

    dt = jnp.exp(jax.random.uniform(ks[10], (N_A_LAYERS, SSM_HEADS), jnp.float32, math.log(1e-3), math.log(1e-1)))
    return {
        'x': nrm(ks[0], (BATCH, SEQ, D_MODEL), 1.0),
        'norm_mix_pre': gain(ks[1], (DEPTH, D_MODEL)),
        'norm_mix_post': gain(ks[2], (DEPTH, D_MODEL)),
        'norm_ffn_pre': gain(ks[3], (DEPTH, D_MODEL)),
        'norm_ffn_post': gain(ks[4], (DEPTH, D_MODEL)),
        'ssm_w_in': nrm(ks[5], (N_A_LAYERS, D_MODEL, SSM_IN_DIM), D_MODEL ** -0.5),
        'ssm_conv_w': nrm(ks[6], (N_A_LAYERS, SSM_CONV, SSM_CONV_DIM), SSM_CONV ** -0.5),
        'ssm_conv_b': nrm(ks[7], (N_A_LAYERS, SSM_CONV_DIM), 0.02),
        'ssm_dt_bias': dt + jnp.log(-jnp.expm1(-dt)),
        'ssm_a_log': jnp.log(jax.random.uniform(ks[8], (N_A_LAYERS, SSM_HEADS), jnp.float32, 1.0, 16.0)),
        'ssm_d': gain(ks[9], (N_A_LAYERS, SSM_HEADS)),
        'ssm_norm': gain(ks[11], (N_A_LAYERS, D_INNER)),
        'ssm_w_out': nrm(ks[12], (N_A_LAYERS, D_INNER, D_MODEL), D_INNER ** -0.5),
        'kv_norm': gain(ks[13], (D_MODEL,)),
        'w_kv': nrm(ks[14], (D_MODEL, 2 * KV_DIM), D_MODEL ** -0.5),
        'b_kv': nrm(ks[15], (2 * KV_DIM,), 0.02),
        'attn_w_q': nrm(ks[16], (N_B_LAYERS, D_MODEL, Q_DIM), D_MODEL ** -0.5),
        'attn_b_q': nrm(ks[17], (N_B_LAYERS, Q_DIM), 0.02),
        'attn_sinks': nrm(ks[18], (N_B_LAYERS, N_Q_HEADS), 0.5),
        'attn_w_o': nrm(ks[19], (N_B_LAYERS, Q_DIM, D_MODEL), Q_DIM ** -0.5),
        'attn_b_o': nrm(ks[20], (N_B_LAYERS, D_MODEL), 0.02),
        'rel_bias': nrm(ks[21], (N_BUCKETS, N_Q_HEADS), 0.5),
        'ffn_w_up': nrm(ks[22], (DEPTH, D_MODEL, 2 * D_FF), D_MODEL ** -0.5),
        'ffn_conv_w': nrm(ks[23], (DEPTH, FFN_CONV, 2 * D_FF), FFN_CONV ** -0.5),
        'ffn_conv_b': nrm(ks[24], (DEPTH, 2 * D_FF), 0.02),
        'ffn_w_down': nrm(ks[25], (DEPTH, D_FF, D_MODEL), D_FF ** -0.5),
    }


def reference(x, norm_mix_pre, norm_mix_post, norm_ffn_pre, norm_ffn_post,
              ssm_w_in, ssm_conv_w, ssm_conv_b, ssm_dt_bias, ssm_a_log, ssm_d, ssm_norm, ssm_w_out,
              kv_norm, w_kv, b_kv,
              attn_w_q, attn_b_q, attn_sinks, attn_w_o, attn_b_o, rel_bias,
              ffn_w_up, ffn_conv_w, ffn_conv_b, ffn_w_down):
    h = x
    k_sh, v_sh = None, None
    for i in range(DEPTH):
        if i == N_A_LAYERS:
            k_sh, v_sh = shared_kv(h, kv_norm, w_kv, b_kv)
        u = rmsnorm(h, norm_mix_pre[i])
        if i < N_A_LAYERS:
            mix = mamba2_mixer(u, ssm_w_in[i], ssm_conv_w[i], ssm_conv_b[i], ssm_dt_bias[i],
                               ssm_a_log[i], ssm_d[i], ssm_norm[i], ssm_w_out[i])
        else:
            j = i - N_A_LAYERS
            mix = swa_sink_attention(u, k_sh, v_sh, attn_w_q[j], attn_b_q[j], attn_sinks[j],
                                     rel_bias, attn_w_o[j], attn_b_o[j])
        h = h + rmsnorm(mix, norm_mix_post[i])
        f = conv_ffn(rmsnorm(h, norm_ffn_pre[i]), ffn_w_up[i], ffn_conv_w[i], ffn_conv_b[i], ffn_w_down[i])
        h = h + rmsnorm(f, norm_ffn_post[i])
    return h
```

```cpp
#include <hip/hip_runtime.h>
#include <cstdio>
#include <cstdint>
namespace pg8 {
#define PG8_LAS __attribute__((address_space(3)))
typedef unsigned short bf16_t;
typedef short bf16x8 __attribute__((ext_vector_type(8)));
typedef float f32x4 __attribute__((ext_vector_type(4)));
typedef unsigned u32x4 __attribute__((ext_vector_type(4)));
constexpr int BM = 256, BK = 64, HALF = 128, HTB = HALF * BK * 2  , STAGE_BYTES = 8 * HTB, NXCD = 8, WGM = 8;

__host__ __device__ __forceinline__ int lds_byte(int r, int c) { const int st = (r >> 4) * 2 + (c >> 5), rr = r & 15, cc = c & 31, ob = rr * 64 + cc * 2; return st * 1024 + (ob ^ (((ob >> 9) & 1) << 5)); }
__host__ __device__ __forceinline__ void stage_rc(int b, int& R, int& C) { const int st = b / 1024, sb = b % 1024, swz = sb ^ (((sb >> 9) & 1) << 5); R = (st >> 1) * 16 + swz / 64; C = (st & 1) * 32 + (swz % 64) / 2; }
__host__ __device__ __forceinline__ int perm32(int rho) { const int n = rho >> 4, i = rho & 15; return 8 * (i >> 2) + 4 * n + (i & 3); }

struct Unit { int pm, pn; };
struct Gemm { const bf16_t* A; const bf16_t* Bt; int M, N, K; };

struct StaticOrder {
    int nM, nN, nwg, G, c;
    __host__ __device__ void init(int M, int N, int G_, int c_) { nM = M / BM; nN = N / BM; nwg = nM * nN; G = G_; c = c_; }
    __host__ __device__ bool next(int i, Unit& u) const {
        const long L = (long)i * G + c; if (L >= nwg) return false;
        int wgid = (int)L; { const int q = nwg / NXCD, r = nwg % NXCD, xcd = wgid % NXCD, off = wgid / NXCD; wgid = (xcd < r ? xcd * (q + 1) : r * (q + 1) + (xcd - r) * q) + off; }
        const int nig = WGM * nN, gid = wgid / nig, fm = gid * WGM, gsz = (nM - fm) < WGM ? (nM - fm) : WGM;
        u.pm = fm + ((wgid % nig) % gsz); u.pn = (wgid % nig) / gsz; return true;
    }
    __device__ __forceinline__ void a_ready(const Unit&) const {}
    __device__ __forceinline__ void done(const Unit&) const {}
};

typedef __bf16 bf16v2_t __attribute__((ext_vector_type(2)));
typedef float f32x2_t __attribute__((ext_vector_type(2)));
__device__ __forceinline__ unsigned cvt_pk_bf16(float lo, float hi) { bf16v2_t v = __builtin_convertvector((f32x2_t){lo, hi}, bf16v2_t); return __builtin_bit_cast(unsigned, v); }

struct EpiOut {
    static constexpr bool PERM = true, AFTER_DRAIN = false;
    bf16_t* O; int ldc; const float* bias; float scale;
    __device__ __forceinline__ void operator()(const f32x4 (&acc)[2][2][4][2], const Unit& u, int wr, int wc, int fr, int fq) const {
        const int row0 = u.pm * BM + wr * 64 + fr; const int col0 = u.pn * BM + wc * 32 + 8 * fq;
        f32x4 bv[2][2];
#pragma unroll
        for (int bj = 0; bj < 2; ++bj)
#pragma unroll
            for (int n = 0; n < 2; ++n) bv[bj][n] = bias ? *(const f32x4*)(bias + col0 + bj * HALF + 4 * n) : (f32x4){0.f, 0.f, 0.f, 0.f};
#pragma unroll
        for (int ai = 0; ai < 2; ++ai)
#pragma unroll
            for (int m = 0; m < 4; ++m) { bf16_t* rowp = O + (size_t)(row0 + ai * HALF + m * 16) * ldc + col0;
#pragma unroll
                for (int bj = 0; bj < 2; ++bj) { f32x4 v0 = (acc[ai][bj][m][0] + bv[bj][0]) * scale, v1 = (acc[ai][bj][m][1] + bv[bj][1]) * scale;
                    u32x4 w; w.x = cvt_pk_bf16(v0[0], v0[1]); w.y = cvt_pk_bf16(v0[2], v0[3]); w.z = cvt_pk_bf16(v1[0], v1[1]); w.w = cvt_pk_bf16(v1[2], v1[3]);
                    *(u32x4*)(rowp + bj * HALF) = w; } }
    }
};
struct EpiKVQ {
    static constexpr bool PERM = true, AFTER_DRAIN = false;
    bf16_t* KV; bf16_t* Q; const float* bkv; const float* bq; float qscale;
    __device__ __forceinline__ void operator()(const f32x4 (&acc)[2][2][4][2], const Unit& u, int wr, int wc, int fr, int fq) const {
        const bool isq = u.pn >= 4;
        EpiOut e; Unit v = u;
        if (isq) { e.O = Q; e.ldc = 4096; e.bias = bq; e.scale = qscale; v.pn = u.pn - 4; }
        else     { e.O = KV; e.ldc = 1024; e.bias = bkv; e.scale = 1.0f; }
        e(acc, v, wr, wc, fr, fq);
    }
};

template <class Epi, class Sched, bool ALIGN_EPI = false, bool SP2 = false>
__device__ __forceinline__ void gemm_phase(PG8_LAS unsigned char* lds, const Gemm g, const Sched& S, const Epi& E) {
    int tid_l = threadIdx.x; asm volatile("" : "+v"(tid_l));
    const int tid = tid_l, wid = __builtin_amdgcn_readfirstlane(tid >> 6), lane = tid & 63, wr = wid >> 2, wc = wid & 3, fr = lane & 15, fq = lane >> 4;
    const int K = g.K, nt = K / BK;
    unsigned voffA[2], voffB[2];
#pragma unroll
    for (int i = 0; i < 2; ++i) { int R, C; stage_rc(tid * 16 + i * 8192, R, C); const int Rb = Epi::PERM ? ((R & ~31) + perm32(R & 31)) : R;
        voffA[i] = (unsigned)(R * K + C) * 2u; voffB[i] = (unsigned)(Rb * K + C) * 2u; }
    const size_t kstep = (size_t)(BK * 2);
    const size_t hstep = (size_t)HALF * K * 2;
    const size_t tstep = 2 * hstep;
    const unsigned ldsw = (unsigned)wid * 1024u;
    const int aoff = lds_byte(wr * 64 + fr, fq * 8), boff = lds_byte(wc * 32 + fr, fq * 8);
#define PG8_SA(b, h) (((b) * 2 + (h)) * HTB)
#define PG8_SB(b, h) ((4 + (b) * 2 + (h)) * HTB)
#define PG8_STAGE(bufoff, gbase, voff) do { _Pragma("unroll") for (int _i = 0; _i < 2; ++_i) \
        __builtin_amdgcn_global_load_lds((const unsigned*)((const char*)(gbase) + (voff)[_i]), (PG8_LAS unsigned*)(lds + (bufoff) + ldsw + _i * 8192), 16, 0, 0); } while (0)
#define PG8_LDA(dst, b, h) do { _Pragma("unroll") for (int m = 0; m < 4; ++m) _Pragma("unroll") for (int k = 0; k < 2; ++k) dst[m][k] = *(const PG8_LAS bf16x8*)(lds + PG8_SA(b, h) + aoff + m * 2048 + k * 1024); } while (0)
#define PG8_LDB(dst, b, h) do { _Pragma("unroll") for (int n = 0; n < 2; ++n) _Pragma("unroll") for (int k = 0; k < 2; ++k) dst[n][k] = *(const PG8_LAS bf16x8*)(lds + PG8_SB(b, h) + boff + n * 2048 + k * 1024); } while (0)
#define PG8_MMA(ai, bj, At, Bt) do { __builtin_amdgcn_s_setprio(1); _Pragma("unroll") for (int m = 0; m < 4; ++m) _Pragma("unroll") for (int n = 0; n < 2; ++n) _Pragma("unroll") for (int k = 0; k < 2; ++k) \
        acc[ai][bj][m][n] = __builtin_amdgcn_mfma_f32_16x16x32_bf16(Bt[n][k], At[m][k], acc[ai][bj][m][n], 0, 0, 0); __builtin_amdgcn_s_setprio(0); } while (0)
#define PG8_WAIT_V(n) asm volatile("s_waitcnt vmcnt(" #n ")" ::: "memory")
#define PG8_WAIT_L(n) asm volatile("s_waitcnt lgkmcnt(" #n ")" ::: "memory")
#define PG8_BAR __builtin_amdgcn_s_barrier()
#define PG8_SCHED __builtin_amdgcn_sched_barrier(0)
    Unit cur, nxt; int ui = 0;
    if (!S.next(0, cur)) return;
    f32x4 acc[2][2][4][2];
#pragma unroll
    for (int a = 0; a < 2; ++a)
#pragma unroll
        for (int b = 0; b < 2; ++b)
#pragma unroll
            for (int m = 0; m < 4; ++m)
#pragma unroll
                for (int n = 0; n < 2; ++n) acc[a][b][m][n] = (f32x4){0.f, 0.f, 0.f, 0.f};
    bf16x8 At[4][2], B0[2][2], B1[2][2];
    const char* cA = (const char*)g.A + (size_t)cur.pm * tstep; const char* cB = (const char*)g.Bt + (size_t)cur.pn * tstep;
    S.a_ready(cur);
    if constexpr (SP2) {
        PG8_STAGE(PG8_SB(0, 0), cB, voffB); PG8_STAGE(PG8_SB(0, 1), cB + hstep, voffB); PG8_STAGE(PG8_SA(0, 0), cA, voffA); PG8_STAGE(PG8_SA(0, 1), cA + hstep, voffA);
        if (wr == 1) PG8_BAR;
        PG8_WAIT_V(2); PG8_BAR;
        PG8_STAGE(PG8_SB(1, 0), cB + kstep, voffB); PG8_STAGE(PG8_SA(1, 0), cA + kstep, voffA); PG8_STAGE(PG8_SB(1, 1), cB + hstep + kstep, voffB);
        PG8_WAIT_V(6); PG8_BAR;
    } else {
        PG8_STAGE(PG8_SB(0, 0), cB, voffB); PG8_STAGE(PG8_SA(0, 0), cA, voffA); PG8_STAGE(PG8_SB(0, 1), cB + hstep, voffB); PG8_STAGE(PG8_SA(0, 1), cA + hstep, voffA);
        if (wr == 1) PG8_BAR;
        PG8_WAIT_V(4); PG8_BAR;
        PG8_STAGE(PG8_SB(1, 0), cB + kstep, voffB); PG8_STAGE(PG8_SA(1, 0), cA + kstep, voffA); PG8_STAGE(PG8_SB(1, 1), cB + hstep + kstep, voffB);
        PG8_WAIT_V(6); PG8_BAR;
    }
    for (;;) {
        const bool has_next = S.next(ui + 1, nxt);
        const char* nA = has_next ? (const char*)g.A + (size_t)nxt.pm * tstep : cA; const char* nB = has_next ? (const char*)g.Bt + (size_t)nxt.pn * tstep : cB;
        for (int t = 0; t < nt; t += 2) {
            const bool last = (t == nt - 2);
            const char* a1 = cA + (size_t)(t + 1) * kstep;
            const char* a2 = last ? nA : cA + (size_t)(t + 2) * kstep; const char* b2 = last ? nB : cB + (size_t)(t + 2) * kstep;
            const char* a3 = a2 + kstep; const char* b3 = b2 + kstep;
            if (last && has_next) S.a_ready(nxt);
            if constexpr (SP2) {
            PG8_LDB(B0, 0, 0); PG8_LDB(B1, 0, 1); PG8_SCHED; PG8_LDA(At, 0, 0); PG8_STAGE(PG8_SA(1, 1), a1 + hstep, voffA);
            PG8_WAIT_V(8); PG8_WAIT_L(0); PG8_BAR; PG8_MMA(0, 0, At, B0); PG8_MMA(0, 1, At, B1); PG8_BAR; PG8_SCHED;
            PG8_LDA(At, 0, 1); PG8_STAGE(PG8_SB(0, 0), b2, voffB); PG8_STAGE(PG8_SB(0, 1), b2 + hstep, voffB); PG8_STAGE(PG8_SA(0, 0), a2, voffA);
            PG8_WAIT_V(8); PG8_WAIT_L(0); PG8_BAR; PG8_MMA(1, 0, At, B0); PG8_MMA(1, 1, At, B1); PG8_BAR; PG8_SCHED;
            PG8_LDB(B0, 1, 0); PG8_LDB(B1, 1, 1); PG8_SCHED; PG8_LDA(At, 1, 0); PG8_STAGE(PG8_SA(0, 1), a2 + hstep, voffA);
            PG8_WAIT_V(8); PG8_WAIT_L(0); PG8_BAR; PG8_MMA(0, 0, At, B0); PG8_MMA(0, 1, At, B1); PG8_BAR; PG8_SCHED;
            PG8_LDA(At, 1, 1); PG8_STAGE(PG8_SB(1, 0), b3, voffB); PG8_STAGE(PG8_SB(1, 1), b3 + hstep, voffB); PG8_STAGE(PG8_SA(1, 0), a3, voffA);
            PG8_WAIT_V(8); PG8_WAIT_L(0); PG8_BAR; PG8_MMA(1, 0, At, B0); PG8_MMA(1, 1, At, B1); PG8_BAR; PG8_SCHED;
            } else {
            PG8_LDB(B0, 0, 0); PG8_SCHED; PG8_LDA(At, 0, 0); PG8_STAGE(PG8_SA(1, 1), a1 + hstep, voffA);
            PG8_WAIT_L(8); PG8_BAR; PG8_WAIT_L(0); PG8_MMA(0, 0, At, B0); PG8_BAR; PG8_SCHED;
            PG8_LDB(B1, 0, 1); PG8_STAGE(PG8_SB(0, 0), b2, voffB);
            PG8_BAR; PG8_WAIT_L(0); PG8_MMA(0, 1, At, B1); PG8_BAR;
            PG8_LDA(At, 0, 1); PG8_STAGE(PG8_SA(0, 0), a2, voffA);
            PG8_BAR; PG8_WAIT_L(0); PG8_MMA(1, 0, At, B0); PG8_BAR; PG8_SCHED;
            PG8_STAGE(PG8_SB(0, 1), b2 + hstep, voffB);
            PG8_WAIT_V(6); PG8_BAR; PG8_MMA(1, 1, At, B1); PG8_BAR;
            PG8_LDB(B0, 1, 0); PG8_SCHED; PG8_LDA(At, 1, 0); PG8_STAGE(PG8_SA(0, 1), a2 + hstep, voffA);
            PG8_WAIT_L(8); PG8_BAR; PG8_WAIT_L(0); PG8_MMA(0, 0, At, B0); PG8_BAR; PG8_SCHED;
            PG8_LDB(B1, 1, 1); PG8_STAGE(PG8_SB(1, 0), b3, voffB);
            PG8_BAR; PG8_WAIT_L(0); PG8_MMA(0, 1, At, B1); PG8_BAR;
            PG8_LDA(At, 1, 1); PG8_STAGE(PG8_SA(1, 0), a3, voffA);
            PG8_BAR; PG8_WAIT_L(0); PG8_MMA(1, 0, At, B0); PG8_BAR; PG8_SCHED;
            PG8_STAGE(PG8_SB(1, 1), b3 + hstep, voffB);
            PG8_WAIT_V(6); PG8_BAR; PG8_MMA(1, 1, At, B1); PG8_BAR;
            }
        }
        if constexpr (ALIGN_EPI) { if (wr == 0) PG8_BAR; }
        if constexpr (!Epi::AFTER_DRAIN) { E(acc, cur, wr, wc, fr, fq); S.done(cur); }
        if (!has_next) break;
#pragma unroll
        for (int a = 0; a < 2; ++a)
#pragma unroll
            for (int b = 0; b < 2; ++b)
#pragma unroll
                for (int m = 0; m < 4; ++m)
#pragma unroll
                    for (int n = 0; n < 2; ++n) acc[a][b][m][n] = (f32x4){0.f, 0.f, 0.f, 0.f};
        cur = nxt; cA = nA; cB = nB; ++ui;
        if constexpr (ALIGN_EPI) { if (wr == 1) PG8_BAR; }
    }
    PG8_WAIT_V(0);
    if constexpr (!ALIGN_EPI) { if (wr == 0) PG8_BAR; }
    PG8_BAR;
    if constexpr (Epi::AFTER_DRAIN) { E.fused(acc, cur, wr, wc, fr, fq, lds, wid, lane); S.done(cur); }
#undef PG8_SA
#undef PG8_SB
#undef PG8_STAGE
#undef PG8_LDA
#undef PG8_LDB
#undef PG8_MMA
#undef PG8_WAIT_V
#undef PG8_WAIT_L
#undef PG8_BAR
#undef PG8_SCHED
}
}
#define GAS __attribute__((address_space(1)))
#define LAS __attribute__((address_space(3)))
typedef unsigned short bf16;
typedef unsigned v4u __attribute__((ext_vector_type(4)));
typedef float f32x4 __attribute__((ext_vector_type(4)));
typedef short bf16x8 __attribute__((ext_vector_type(8)));
typedef GAS unsigned gu32;
typedef GAS unsigned long long gu64;
#define RLX_AGENT __ATOMIC_RELAXED, __HIP_MEMORY_SCOPE_AGENT
#define LDS_WAIT() asm volatile("s_waitcnt lgkmcnt(0)" ::: "memory")
#define VM_WAIT() asm volatile("s_waitcnt vmcnt(0)" ::: "memory")
__device__ __forceinline__ unsigned long long rt() { return __builtin_amdgcn_s_memrealtime(); }

#define XB_TMO      128
#define XB_XCNT(j)  (256  + 64 * (j))
#define XB_XSUB(j)  (1280 + 64 * (j))
#define XB_XGEN(j)  (2304 + 64 * (j))
#define XB_TOP      3328
#define XB_TOPGEN   3392
#define XCD_BAR_WORDS 3456
#define XB_SPIN_CAP (1u << 18)

__device__ __forceinline__ unsigned xb_ld(unsigned* p)              { return __hip_atomic_load(p, __ATOMIC_RELAXED, __HIP_MEMORY_SCOPE_AGENT); }
__device__ __forceinline__ unsigned xb_add(unsigned* p, unsigned v) { return __hip_atomic_fetch_add(p, v, __ATOMIC_RELAXED, __HIP_MEMORY_SCOPE_AGENT); }
__device__ __forceinline__ unsigned xb_xcc_id() { return (unsigned)__builtin_amdgcn_s_getreg((3 << 11) | 20) & 0xFu; }
#define XB_SPIN(cond, bar) do { unsigned _sp = 0; while (cond) { __builtin_amdgcn_s_sleep(1); \
    if ((++_sp & 255u) == 0u) { if (xb_ld(&(bar)[XB_TMO])) break; if (_sp > XB_SPIN_CAP) { atomicAdd(&(bar)[XB_TMO], 1u); break; } } } } while (0)

struct XcdBarrier {
    unsigned* bar; unsigned x;
    volatile LAS unsigned* st;
};

__device__ __forceinline__ XcdBarrier xcd_barrier_post(unsigned* bar, volatile LAS unsigned* st) {
    XcdBarrier b; b.bar = bar; b.x = xb_xcc_id(); b.st = st;
    if (threadIdx.x == 0) (void)xb_add(&bar[XB_XCNT(b.x)], 1u);
    return b;
}
__device__ __forceinline__ void xcd_barrier_complete(unsigned* bar, unsigned x, unsigned& nloc, unsigned& nx) {
    const unsigned G = gridDim.x * gridDim.y * gridDim.z;
    unsigned sum, cnt, mine, sp = 0u;
    for (;;) {
        sum = 0u; cnt = 0u; mine = 0u;
#pragma unroll
        for (unsigned j = 0; j < 16; ++j) { const unsigned c = xb_ld(&bar[XB_XCNT(j)]); sum += c; cnt += (c > 0u) ? 1u : 0u; mine = (j == x) ? c : mine; }
        if (sum == G) break;
        __builtin_amdgcn_s_sleep(1);
        if ((++sp & 255u) == 0u) { if (xb_ld(&bar[XB_TMO])) break; if (sp > XB_SPIN_CAP) { atomicAdd(&bar[XB_TMO], 1u); break; } }
    }
    nloc = mine > 0u ? mine : 1u; nx = cnt > 0u ? cnt : 1u;
}

__device__ __forceinline__ void xcd_barrier(const XcdBarrier& b) {
    asm volatile("s_waitcnt vmcnt(0)" ::: "memory");
    __syncthreads();
    if (threadIdx.x == 0) {
        unsigned* bar = b.bar;
        __builtin_amdgcn_s_waitcnt(0);
        unsigned nloc = b.st[0], nx = b.st[1];
        if (nloc == 0u) { xcd_barrier_complete(bar, b.x, nloc, nx); b.st[0] = nloc; b.st[1] = nx; }
        const unsigned old = xb_add(&bar[XB_XSUB(b.x)], 1u);
        const unsigned gen = old / nloc;
        if (old + 1u == (gen + 1u) * nloc) {
            __builtin_amdgcn_fence(__ATOMIC_RELEASE, "agent");
            asm volatile("s_waitcnt vmcnt(0)" ::: "memory");
            const unsigned og = xb_add(&bar[XB_TOP], 1u);
            const unsigned tg = og / nx;
            if (og + 1u == (tg + 1u) * nx) xb_add(&bar[XB_TOPGEN], 1u);
            else XB_SPIN(xb_ld(&bar[XB_TOPGEN]) == tg, bar);
            __builtin_amdgcn_fence(__ATOMIC_ACQUIRE, "agent");
            xb_add(&bar[XB_XGEN(b.x)], 1u);
            asm volatile("s_waitcnt vmcnt(0)" ::: "memory");
        } else {
            XB_SPIN(xb_ld(&bar[XB_XGEN(b.x)]) == gen, bar);
            __builtin_amdgcn_fence(__ATOMIC_ACQUIRE, "agent");
            asm volatile("s_waitcnt vmcnt(0)" ::: "memory");
        }
    }
    __syncthreads();
}


constexpr int SEQ = 8192, DM = 4096, DINNER = 8192, NHEAD = 128, HDIM = 64, NGRP = 8, HPG = 16, DSTATE = 128;
constexpr int CONVD = 10240, NZX = 18432, NIN = 18560, DFF = 11008, NUP = 22016, NKVQ = 5120;
constexpr int CHUNK = 128, NCHUNK = 64;
constexpr float EPS = 1e-6f, SSM_EPS = 1e-5f;
constexpr int NWAVES = 8;

constexpr size_t MiB = 1u << 20;
constexpr size_t WS_CTL = 0, CTL_ZERO_BYTES = 1 * MiB;
constexpr size_t WS_WIN = 1 * MiB;
constexpr size_t WS_WOUT = 146 * MiB;
constexpr size_t WS_WUP0 = 210 * MiB;
constexpr size_t WS_WUP1 = 382 * MiB;
constexpr size_t WS_WDN0 = 554 * MiB;
constexpr size_t WS_WDN1 = 640 * MiB;
constexpr size_t WS_WKVQ = 726 * MiB;
constexpr size_t WS_WO = 766 * MiB;
constexpr size_t WS_A = 798 * MiB;
constexpr size_t WS_MIX = 862 * MiB;
constexpr size_t WS_DTRAW = 926 * MiB;
constexpr size_t WS_DT = 930 * MiB;
constexpr size_t WS_ACUM = 934 * MiB;
constexpr size_t WS_BIG = 938 * MiB;
constexpr size_t WS_ZX = WS_BIG;
constexpr size_t WS_XBC = WS_BIG + 288 * MiB;
constexpr size_t WS_S = WS_BIG + 448 * MiB;
constexpr size_t WS_ST = WS_BIG + 704 * MiB;
constexpr size_t WS_Y = WS_BIG + 832 * MiB;
constexpr size_t WS_GU = WS_BIG;
constexpr size_t WS_ACT = WS_BIG + 344 * MiB;
constexpr size_t WS_Q = WS_BIG;
constexpr size_t WS_KV = WS_BIG + 64 * MiB;
constexpr size_t WS_O = WS_BIG + 80 * MiB;
constexpr size_t WS_END = WS_BIG + 960 * MiB;
constexpr int CW_BAR = 4096;

constexpr int LDS_BYTES = 163840;
constexpr int MISC_OFF = LDS_BYTES - 256;

typedef float f32x4 __attribute__((ext_vector_type(4)));
typedef float f32x16 __attribute__((ext_vector_type(16)));
typedef short bf16x8 __attribute__((ext_vector_type(8)));
typedef short bf16x4 __attribute__((ext_vector_type(4)));
typedef unsigned u32x4 __attribute__((ext_vector_type(4)));
typedef unsigned u32x2 __attribute__((ext_vector_type(2)));
#define DEV __device__ __forceinline__
DEV unsigned pk2(float lo, float hi) { return pg8::cvt_pk_bf16(lo, hi); }
DEV float bf_lo(unsigned w) { return __builtin_bit_cast(float, w << 16); }
DEV float bf_hi(unsigned w) { return __builtin_bit_cast(float, w & 0xffff0000u); }
DEV float bf2f(bf16 b) { return __builtin_bit_cast(float, ((unsigned)b) << 16); }
DEV bf16 f2bf(float f) { return (bf16)(pk2(f, 0.f) & 0xffffu); }
DEV float silu_f(float v) { return v / (1.0f + __expf(-v)); }
DEV float wave_sum(float v) {
#pragma unroll
    for (int o = 1; o < 64; o <<= 1) v += __shfl_xor(v, o);
    return v;
}
DEV void unpack8(const u32x4 w, float (&f)[8]) { f[0] = bf_lo(w.x); f[1] = bf_hi(w.x); f[2] = bf_lo(w.y); f[3] = bf_hi(w.y); f[4] = bf_lo(w.z); f[5] = bf_hi(w.z); f[6] = bf_lo(w.w); f[7] = bf_hi(w.w); }
DEV u32x4 pack8(const float (&f)[8]) { u32x4 w; w.x = pk2(f[0], f[1]); w.y = pk2(f[2], f[3]); w.z = pk2(f[4], f[5]); w.w = pk2(f[6], f[7]); return w; }

struct Ctx { LAS unsigned char* lds; int tid, lane, wave, vcu, G; };

DEV void tr_tile(const float* __restrict__ W, int N, const float* __restrict__ gain, bf16* __restrict__ WT, int K, int row_off, int k0, int n0, LAS float* scr, int lane) {
    const int kr = lane >> 4, nc = (lane & 15) * 4;
#pragma unroll
    for (int i = 0; i < 16; ++i) { const int kk = 4 * i + kr; const f32x4 v = *(const f32x4*)(W + (size_t)(k0 + kk) * N + n0 + nc); const float g = gain ? gain[k0 + kk] : 1.0f;
        LAS float* s = scr + kk * 65 + nc; s[0] = v.x * g; s[1] = v.y * g; s[2] = v.z * g; s[3] = v.w * g; }
    asm volatile("s_waitcnt lgkmcnt(0)" ::: "memory");
    const int c = lane & 7;
#pragma unroll
    for (int j = 0; j < 8; ++j) { const int n = 8 * j + (lane >> 3); const LAS float* s = scr + (8 * c) * 65 + n;
        u32x4 o; o.x = pk2(s[0 * 65], s[1 * 65]); o.y = pk2(s[2 * 65], s[3 * 65]); o.z = pk2(s[4 * 65], s[5 * 65]); o.w = pk2(s[6 * 65], s[7 * 65]);
        *(u32x4*)(WT + (size_t)(row_off + n0 + n) * K + k0 + 8 * c) = o; }
    asm volatile("s_waitcnt lgkmcnt(0)" ::: "memory");
}
DEV void tr_matrix(const Ctx& C, const float* W, int K, int N, const float* gain, bf16* WT, int row_off) {
    LAS float* scr = (LAS float*)(C.lds + C.wave * 16640);
    const int gw = C.vcu * NWAVES + C.wave, NGW = C.G * NWAVES;
    const int nblk = N / 64, items = (K / 64) * nblk;
    for (int it = gw; it < items; it += NGW) { const int kb = it / nblk, nb = it - kb * nblk; tr_tile(W, N, gain, WT, K, row_off, kb * 64, nb * 64, scr, C.lane); }
}

template <bool HAS_MIX, bool WRITE_H, bool WRITE_A>
DEV void thin_row(const bf16* mixrow, const float* hold, float* hnew, const float* gpost, bf16* arow, int lane) {
    float v[8][8];
    if (HAS_MIX) {
        float ss = 0.f;
#pragma unroll
        for (int j = 0; j < 8; ++j) { const u32x4 m = *(const u32x4*)(mixrow + (j * 64 + lane) * 8); unpack8(m, v[j]);
#pragma unroll
            for (int e = 0; e < 8; ++e) ss += v[j][e] * v[j][e]; }
        const float rstd = 1.0f / sqrtf(wave_sum(ss) * (1.0f / DM) + EPS);
#pragma unroll
        for (int j = 0; j < 8; ++j) { const int c0 = (j * 64 + lane) * 8;
            const f32x4 h0 = *(const f32x4*)(hold + c0), h1 = *(const f32x4*)(hold + c0 + 4), g0 = *(const f32x4*)(gpost + c0), g1 = *(const f32x4*)(gpost + c0 + 4);
            v[j][0] = h0.x + v[j][0] * rstd * g0.x; v[j][1] = h0.y + v[j][1] * rstd * g0.y; v[j][2] = h0.z + v[j][2] * rstd * g0.z; v[j][3] = h0.w + v[j][3] * rstd * g0.w;
            v[j][4] = h1.x + v[j][4] * rstd * g1.x; v[j][5] = h1.y + v[j][5] * rstd * g1.y; v[j][6] = h1.z + v[j][6] * rstd * g1.z; v[j][7] = h1.w + v[j][7] * rstd * g1.w; }
    } else {
#pragma unroll
        for (int j = 0; j < 8; ++j) { const int c0 = (j * 64 + lane) * 8; const f32x4 h0 = *(const f32x4*)(hold + c0), h1 = *(const f32x4*)(hold + c0 + 4);
            v[j][0] = h0.x; v[j][1] = h0.y; v[j][2] = h0.z; v[j][3] = h0.w; v[j][4] = h1.x; v[j][5] = h1.y; v[j][6] = h1.z; v[j][7] = h1.w; }
    }
    if (WRITE_H) {
#pragma unroll
        for (int j = 0; j < 8; ++j) { const int c0 = (j * 64 + lane) * 8; *(f32x4*)(hnew + c0) = (f32x4){v[j][0], v[j][1], v[j][2], v[j][3]}; *(f32x4*)(hnew + c0 + 4) = (f32x4){v[j][4], v[j][5], v[j][6], v[j][7]}; }
    }
    if (WRITE_A) {
        float ss = 0.f;
#pragma unroll
        for (int j = 0; j < 8; ++j)
#pragma unroll
            for (int e = 0; e < 8; ++e) ss += v[j][e] * v[j][e];
        const float rstd = 1.0f / sqrtf(wave_sum(ss) * (1.0f / DM) + EPS);
#pragma unroll
        for (int j = 0; j < 8; ++j) { float o[8];
#pragma unroll
            for (int e = 0; e < 8; ++e) o[e] = v[j][e] * rstd;
            *(u32x4*)(arow + (j * 64 + lane) * 8) = pack8(o); }
    }
}
template <bool HAS_MIX, bool WRITE_H, bool WRITE_A>
DEV void thin_phase(const Ctx& C, const bf16* mix, const float* hold, float* hnew, const float* gpost, bf16* abuf) {
    const int gw = C.vcu * NWAVES + C.wave, NGW = C.G * NWAVES;
    for (int r = gw; r < SEQ; r += NGW) thin_row<HAS_MIX, WRITE_H, WRITE_A>(mix + (size_t)r * DM, hold + (size_t)r * DM, hnew + (size_t)r * DM, gpost, abuf + (size_t)r * DM, C.lane);
}

DEV void dt_gemm(const Ctx& C, const bf16* __restrict__ A, const bf16* __restrict__ Bt, float* __restrict__ out) {
    const int r16 = C.lane & 15, kq = C.lane >> 4;
    for (int rb = C.vcu; rb < SEQ / 32; rb += C.G) {
        const bf16* a0 = A + (size_t)(rb * 32 + r16) * DM + kq * 8; const bf16* a1 = a0 + (size_t)16 * DM;
        const bf16* b0 = Bt + (size_t)(C.wave * 16 + r16) * DM + kq * 8;
        f32x4 acc0 = {0.f, 0.f, 0.f, 0.f}, acc1 = {0.f, 0.f, 0.f, 0.f};
#pragma unroll 8
        for (int ks = 0; ks < DM / 32; ++ks) {
            const bf16x8 fa0 = *(const bf16x8*)(a0 + ks * 32), fa1 = *(const bf16x8*)(a1 + ks * 32), fb = *(const bf16x8*)(b0 + ks * 32);
            acc0 = __builtin_amdgcn_mfma_f32_16x16x32_bf16(fa0, fb, acc0, 0, 0, 0);
            acc1 = __builtin_amdgcn_mfma_f32_16x16x32_bf16(fa1, fb, acc1, 0, 0, 0);
        }
#pragma unroll
        for (int r = 0; r < 4; ++r) { out[(size_t)(rb * 32 + kq * 4 + r) * 128 + C.wave * 16 + r16] = acc0[r]; out[(size_t)(rb * 32 + 16 + kq * 4 + r) * 128 + C.wave * 16 + r16] = acc1[r]; }
    }
}

DEV void ssd_prep(const Ctx& C, const bf16* __restrict__ ZX, bf16* __restrict__ XBC, const float* __restrict__ cw, const float* __restrict__ cb,
                  const float* __restrict__ dtraw, const float* __restrict__ dtbias, const float* __restrict__ alog, float* __restrict__ DT, float* __restrict__ ACUM) {
    const int gtid = C.vcu * (NWAVES * 64) + C.tid, nthr = C.G * NWAVES * 64;
    for (int it = gtid; it < NCHUNK * NHEAD; it += nthr) {
        const int c = it / NHEAD, h = it - c * NHEAD; const float bias = dtbias[h], Aneg = -__expf(alog[h]); float run = 0.f;
#pragma unroll 8
        for (int i = 0; i < CHUNK; ++i) { const size_t o = (size_t)(c * CHUNK + i) * NHEAD + h; const float x = dtraw[o] + bias;
            const float dt = fmaxf(x, 0.f) + log1pf(__expf(-fabsf(x))); run += dt * Aneg; DT[o] = dt; ACUM[o] = run; }
    }
    constexpr int RB = 32, NCC = CONVD / 8, NT = (SEQ / RB) * NCC;
    for (int it = gtid; it < NT; it += nthr) {
        const int rb = it / NCC, cc = it - rb * NCC, c0 = cc * 8, t0 = rb * RB;
        float w[4][8], b[8];
#pragma unroll
        for (int k = 0; k < 4; ++k) { const f32x4 a = *(const f32x4*)(cw + k * CONVD + c0), bq = *(const f32x4*)(cw + k * CONVD + c0 + 4); w[k][0] = a.x; w[k][1] = a.y; w[k][2] = a.z; w[k][3] = a.w; w[k][4] = bq.x; w[k][5] = bq.y; w[k][6] = bq.z; w[k][7] = bq.w; }
        { const f32x4 a = *(const f32x4*)(cb + c0), bq = *(const f32x4*)(cb + c0 + 4); b[0] = a.x; b[1] = a.y; b[2] = a.z; b[3] = a.w; b[4] = bq.x; b[5] = bq.y; b[6] = bq.z; b[7] = bq.w; }
        float x3[8], x2[8], x1[8];
        const bf16* src = ZX + DINNER + c0;
        if (t0 >= 3) { unpack8(*(const u32x4*)(src + (size_t)(t0 - 3) * NZX), x3); unpack8(*(const u32x4*)(src + (size_t)(t0 - 2) * NZX), x2); unpack8(*(const u32x4*)(src + (size_t)(t0 - 1) * NZX), x1); }
        else {
#pragma unroll
            for (int e = 0; e < 8; ++e) { x3[e] = 0.f; x2[e] = 0.f; x1[e] = 0.f; } }
        for (int tt = 0; tt < RB; ++tt) { const int t = t0 + tt; float x0[8], o[8]; unpack8(*(const u32x4*)(src + (size_t)t * NZX), x0);
#pragma unroll
            for (int e = 0; e < 8; ++e) { const float s = b[e] + w[0][e] * x3[e] + w[1][e] * x2[e] + w[2][e] * x1[e] + w[3][e] * x0[e]; o[e] = silu_f(s); x3[e] = x2[e]; x2[e] = x1[e]; x1[e] = x0[e]; }
            *(u32x4*)(XBC + (size_t)t * CONVD + c0) = pack8(o); }
    }
}

DEV void ssd_naive(const Ctx& C, const bf16* __restrict__ XBC, const bf16* __restrict__ ZX, const float* __restrict__ DT, const float* __restrict__ alog, const float* __restrict__ dskip, bf16* __restrict__ Y) {
    if (C.wave < 2) {
        for (int h = C.vcu; h < NHEAD; h += C.G) {
            const int g = h / HPG, p = C.wave * 32 + (C.lane & 31), nh = C.lane >> 5; const float Aneg = -__expf(alog[h]), Dk = dskip[h];
            float st[64];
#pragma unroll
            for (int n = 0; n < 64; ++n) st[n] = 0.f;
            for (int t = 0; t < SEQ; ++t) {
                const float dtv = DT[(size_t)t * NHEAD + h]; const float dA = __expf(dtv * Aneg);
                const float xv = bf2f(XBC[(size_t)t * CONVD + h * HDIM + p]); const float dtx = dtv * xv;
                const bf16* Bp = XBC + (size_t)t * CONVD + DINNER + g * DSTATE + nh * 64; const bf16* Cp = Bp + NGRP * DSTATE;
                float y = 0.f;
#pragma unroll
                for (int n8 = 0; n8 < 8; ++n8) { float bb[8], cc[8]; unpack8(*(const u32x4*)(Bp + n8 * 8), bb); unpack8(*(const u32x4*)(Cp + n8 * 8), cc);
#pragma unroll
                    for (int e = 0; e < 8; ++e) { st[n8 * 8 + e] = st[n8 * 8 + e] * dA + dtx * bb[e]; y += st[n8 * 8 + e] * cc[e]; } }
                y += __shfl_xor(y, 32);
                y += Dk * xv;
                const float zv = bf2f(ZX[(size_t)t * NZX + h * HDIM + p]);
                if (nh == 0) Y[(size_t)t * DINNER + h * HDIM + p] = f2bf(y * silu_f(zv));
            }
        }
    }
}
DEV void ssd_groupnorm(bf16* Y, int r0, int nr, int w0, int nw, int lane) {
    for (int it = w0; it < nr * NGRP; it += nw) { const int r = r0 + it / NGRP, g = it % NGRP; bf16* p = Y + (size_t)r * DINNER + g * 1024 + lane * 16;
        float a[8], b[8]; unpack8(*(const u32x4*)p, a); unpack8(*(const u32x4*)(p + 8), b); float ss = 0.f;
#pragma unroll
        for (int e = 0; e < 8; ++e) ss += a[e] * a[e] + b[e] * b[e];
        const float rstd = 1.0f / sqrtf(wave_sum(ss) * (1.0f / 1024.0f) + SSM_EPS);
#pragma unroll
        for (int e = 0; e < 8; ++e) { a[e] *= rstd; b[e] *= rstd; }
        *(u32x4*)p = pack8(a); *(u32x4*)(p + 8) = pack8(b); }
}

DEV void ffn_convgate(const Ctx& C, const bf16* __restrict__ GU, bf16* __restrict__ ACT, const float* __restrict__ cw, const float* __restrict__ cb) {
    const int gtid = C.vcu * (NWAVES * 64) + C.tid, nthr = C.G * NWAVES * 64;
    constexpr int RB = 32, NCC = DFF / 8, NT = (SEQ / RB) * NCC;
    for (int it = gtid; it < NT; it += nthr) {
        const int rb = it / NCC, cc = it - rb * NCC, c0 = cc * 8, t0 = rb * RB;
        float wg[3][8], wv[3][8], bg[8], bv[8];
#pragma unroll
        for (int k = 0; k < 3; ++k) {
            const f32x4 a = *(const f32x4*)(cw + k * NUP + c0), b = *(const f32x4*)(cw + k * NUP + c0 + 4), c = *(const f32x4*)(cw + k * NUP + DFF + c0), d = *(const f32x4*)(cw + k * NUP + DFF + c0 + 4);
            wg[k][0] = a.x; wg[k][1] = a.y; wg[k][2] = a.z; wg[k][3] = a.w; wg[k][4] = b.x; wg[k][5] = b.y; wg[k][6] = b.z; wg[k][7] = b.w;
            wv[k][0] = c.x; wv[k][1] = c.y; wv[k][2] = c.z; wv[k][3] = c.w; wv[k][4] = d.x; wv[k][5] = d.y; wv[k][6] = d.z; wv[k][7] = d.w; }
        { const f32x4 a = *(const f32x4*)(cb + c0), b = *(const f32x4*)(cb + c0 + 4), c = *(const f32x4*)(cb + DFF + c0), d = *(const f32x4*)(cb + DFF + c0 + 4);
            bg[0] = a.x; bg[1] = a.y; bg[2] = a.z; bg[3] = a.w; bg[4] = b.x; bg[5] = b.y; bg[6] = b.z; bg[7] = b.w;
            bv[0] = c.x; bv[1] = c.y; bv[2] = c.z; bv[3] = c.w; bv[4] = d.x; bv[5] = d.y; bv[6] = d.z; bv[7] = d.w; }
        float g2[8], g1[8], v2[8], v1[8];
        const bf16* sg = GU + c0; const bf16* sv = GU + DFF + c0;
        if (t0 >= 2) { unpack8(*(const u32x4*)(sg + (size_t)(t0 - 2) * NUP), g2); unpack8(*(const u32x4*)(sg + (size_t)(t0 - 1) * NUP), g1); unpack8(*(const u32x4*)(sv + (size_t)(t0 - 2) * NUP), v2); unpack8(*(const u32x4*)(sv + (size_t)(t0 - 1) * NUP), v1); }
        else {
#pragma unroll
            for (int e = 0; e < 8; ++e) { g2[e] = 0.f; g1[e] = 0.f; v2[e] = 0.f; v1[e] = 0.f; } }
        for (int tt = 0; tt < RB; ++tt) { const int t = t0 + tt; float g0[8], v0[8], o[8]; unpack8(*(const u32x4*)(sg + (size_t)t * NUP), g0); unpack8(*(const u32x4*)(sv + (size_t)t * NUP), v0);
#pragma unroll
            for (int e = 0; e < 8; ++e) { const float G = bg[e] + wg[0][e] * g2[e] + wg[1][e] * g1[e] + wg[2][e] * g0[e]; const float V = bv[e] + wv[0][e] * v2[e] + wv[1][e] * v1[e] + wv[2][e] * v0[e];
                o[e] = silu_f(G) * V; g2[e] = g1[e]; g1[e] = g0[e]; v2[e] = v1[e]; v1[e] = v0[e]; }
            *(u32x4*)(ACT + (size_t)t * DFF + c0) = pack8(o); }
    }
}

DEV int t5_bucket(int rel) { if (rel < 16) return rel; const int v = 16 + (int)(logf((float)rel * (1.0f / 16.0f)) / logf(8.0f) * 16.0f); return v < 31 ? v : 31; }
DEV void attn_naive(const Ctx& C, const bf16* __restrict__ Q, const bf16* __restrict__ KV, bf16* __restrict__ O, const float* __restrict__ sinks, const float* __restrict__ relb) {
    const int gtid = C.vcu * (NWAVES * 64) + C.tid, nthr = C.G * NWAVES * 64;
    for (int idx = gtid; idx < SEQ * 64; idx += nthr) {
        const int t = idx >> 6, hq = idx & 63, g = hq >> 3;
        float q[64], o[64];
#pragma unroll
        for (int i = 0; i < 8; ++i) { float f[8]; unpack8(*(const u32x4*)(Q + (size_t)t * DM + hq * 64 + i * 8), f);
#pragma unroll
            for (int e = 0; e < 8; ++e) { q[i * 8 + e] = f[e]; o[i * 8 + e] = 0.f; } }
        float m = sinks[hq], l = 1.0f;
        const int j0 = t - 127 > 0 ? t - 127 : 0;
        for (int j = j0; j <= t; ++j) {
            const bf16* kp = KV + (size_t)j * 1024 + g * 64; const bf16* vp = kp + 512; float s = 0.f;
#pragma unroll
            for (int i = 0; i < 8; ++i) { float f[8]; unpack8(*(const u32x4*)(kp + i * 8), f);
#pragma unroll
                for (int e = 0; e < 8; ++e) s += q[i * 8 + e] * f[e]; }
            s += relb[t5_bucket(t - j) * 64 + hq];
            const float mn = fmaxf(m, s), sc = __expf(m - mn), pj = __expf(s - mn); l = l * sc + pj; m = mn;
#pragma unroll
            for (int i = 0; i < 8; ++i) { float f[8]; unpack8(*(const u32x4*)(vp + i * 8), f);
#pragma unroll
                for (int e = 0; e < 8; ++e) o[i * 8 + e] = o[i * 8 + e] * sc + pj * f[e]; }
        }
        const float inv = 1.0f / l;
#pragma unroll
        for (int i = 0; i < 8; ++i) { float f[8];
#pragma unroll
            for (int e = 0; e < 8; ++e) f[e] = o[i * 8 + e] * inv;
            *(u32x4*)(O + (size_t)t * DM + hq * 64 + i * 8) = pack8(f); }
    }
}

struct Args { const float* in[26]; float* out; unsigned char* ws; };
enum { I_X = 0, I_NMPRE, I_NMPOST, I_NFPRE, I_NFPOST, I_WIN, I_SCW, I_SCB, I_DTB, I_ALOG, I_D, I_SNORM, I_WOUT, I_KVN, I_WKV, I_BKV, I_WQ, I_BQ, I_SINK, I_WO, I_BO, I_RELB, I_WUP, I_FCW, I_FCB, I_WDN };

#define RUN_GEMM(EpiT, Aptr, Btptr, N_, K_, Eobj) do { pg8::Gemm g_{(const pg8::bf16_t*)(Aptr), (const pg8::bf16_t*)(Btptr), SEQ, (N_), (K_)}; pg8::StaticOrder S_; S_.init(SEQ, (N_), C.G, (int)blockIdx.x); \
    pg8::gemm_phase<EpiT, pg8::StaticOrder, true, true>(C.lds, g_, S_, Eobj); } while (0)

__global__ void __launch_bounds__(NWAVES * 64, 2) mk_fwd(Args args) {
    extern __shared__ __attribute__((aligned(16))) unsigned char lds_raw[];
    Ctx C; C.lds = (LAS unsigned char*)lds_raw; C.tid = threadIdx.x; C.lane = C.tid & 63; C.wave = __builtin_amdgcn_readfirstlane(C.tid >> 6);
    C.G = gridDim.x; { const int bx = blockIdx.x; C.vcu = (C.G % 8 == 0) ? (bx % 8) * (C.G / 8) + bx / 8 : bx; }
    volatile LAS unsigned* MISC = (volatile LAS unsigned*)(C.lds + MISC_OFF);
    if (C.tid < 64) MISC[C.tid] = 0u;
    __syncthreads();
    unsigned char* ws = args.ws;
    gu32* ctl = (gu32*)(ws + WS_CTL);
    XcdBarrier bar = xcd_barrier_post((unsigned*)(ctl + CW_BAR), MISC + 8);
#define GRID_BAR() xcd_barrier(bar)
    const float* x = args.in[I_X]; float* out = args.out;
    bf16* Win_t = (bf16*)(ws + WS_WIN); bf16* Wout_t = (bf16*)(ws + WS_WOUT); bf16* Wkvq_t = (bf16*)(ws + WS_WKVQ); bf16* Wo_t = (bf16*)(ws + WS_WO);
    bf16* Abuf = (bf16*)(ws + WS_A); bf16* MIX = (bf16*)(ws + WS_MIX);
    float* DTRAW = (float*)(ws + WS_DTRAW); float* DT = (float*)(ws + WS_DT); float* ACUM = (float*)(ws + WS_ACUM);
    bf16* ZX = (bf16*)(ws + WS_ZX); bf16* XBC = (bf16*)(ws + WS_XBC); bf16* Y = (bf16*)(ws + WS_Y);
    bf16* GU = (bf16*)(ws + WS_GU); bf16* ACT = (bf16*)(ws + WS_ACT);
    bf16* Qb = (bf16*)(ws + WS_Q); bf16* KVb = (bf16*)(ws + WS_KV); bf16* Ob = (bf16*)(ws + WS_O);

    tr_matrix(C, args.in[I_WIN], DM, NIN, args.in[I_NMPRE], Win_t, 0);
    tr_matrix(C, args.in[I_WOUT], DINNER, DM, args.in[I_SNORM], Wout_t, 0);
    tr_matrix(C, args.in[I_WUP], DM, NUP, args.in[I_NFPRE], (bf16*)(ws + WS_WUP0), 0);
    tr_matrix(C, args.in[I_WUP] + (size_t)DM * NUP, DM, NUP, args.in[I_NFPRE] + DM, (bf16*)(ws + WS_WUP1), 0);
    tr_matrix(C, args.in[I_WDN], DFF, DM, nullptr, (bf16*)(ws + WS_WDN0), 0);
    tr_matrix(C, args.in[I_WDN] + (size_t)DFF * DM, DFF, DM, nullptr, (bf16*)(ws + WS_WDN1), 0);
    tr_matrix(C, args.in[I_WKV], DM, 1024, args.in[I_KVN], Wkvq_t, 0);
    tr_matrix(C, args.in[I_WQ], DM, DM, args.in[I_NMPRE] + DM, Wkvq_t, 1024);
    tr_matrix(C, args.in[I_WO], DM, DM, nullptr, Wo_t, 0);
    thin_phase<false, false, true>(C, nullptr, x, nullptr, nullptr, Abuf);
    GRID_BAR();

    { pg8::EpiOut E{(pg8::bf16_t*)ZX, NZX, nullptr, 1.0f}; RUN_GEMM(pg8::EpiOut, Abuf, Win_t, NZX, DM, E); }
    dt_gemm(C, Abuf, Win_t + (size_t)NZX * DM, DTRAW);
    GRID_BAR();
#ifndef SKIP_PREP
    ssd_prep(C, ZX, XBC, args.in[I_SCW], args.in[I_SCB], DTRAW, args.in[I_DTB], args.in[I_ALOG], DT, ACUM);
#endif
    GRID_BAR();
#ifndef SKIP_SSDN
    ssd_naive(C, XBC, ZX, DT, args.in[I_ALOG], args.in[I_D], Y);
#endif
    GRID_BAR();
    ssd_groupnorm(Y, 0, SEQ, C.vcu * NWAVES + C.wave, C.G * NWAVES, C.lane);
    GRID_BAR();
    { pg8::EpiOut E{(pg8::bf16_t*)MIX, DM, nullptr, 1.0f}; RUN_GEMM(pg8::EpiOut, Y, Wout_t, DM, DINNER, E); }
    GRID_BAR();
    thin_phase<true, true, true>(C, MIX, x, out, args.in[I_NMPOST], Abuf);
    GRID_BAR();
    { pg8::EpiOut E{(pg8::bf16_t*)GU, NUP, nullptr, 1.0f}; RUN_GEMM(pg8::EpiOut, Abuf, ws + WS_WUP0, NUP, DM, E); }
    GRID_BAR();
    ffn_convgate(C, GU, ACT, args.in[I_FCW], args.in[I_FCB]);
    GRID_BAR();
    { pg8::EpiOut E{(pg8::bf16_t*)MIX, DM, nullptr, 1.0f}; RUN_GEMM(pg8::EpiOut, ACT, ws + WS_WDN0, DM, DFF, E); }
    GRID_BAR();
    thin_phase<true, true, true>(C, MIX, out, out, args.in[I_NFPOST], Abuf);
    GRID_BAR();

    { pg8::EpiKVQ E{(pg8::bf16_t*)KVb, (pg8::bf16_t*)Qb, args.in[I_BKV], args.in[I_BQ], 0.125f}; RUN_GEMM(pg8::EpiKVQ, Abuf, Wkvq_t, NKVQ, DM, E); }
    GRID_BAR();
#ifndef SKIP_ATTN
    attn_naive(C, Qb, KVb, Ob, args.in[I_SINK], args.in[I_RELB]);
#endif
    GRID_BAR();
    { pg8::EpiOut E{(pg8::bf16_t*)MIX, DM, args.in[I_BO], 1.0f}; RUN_GEMM(pg8::EpiOut, Ob, Wo_t, DM, DM, E); }
    GRID_BAR();
    thin_phase<true, true, true>(C, MIX, out, out, args.in[I_NMPOST] + DM, Abuf);
    GRID_BAR();
    { pg8::EpiOut E{(pg8::bf16_t*)GU, NUP, nullptr, 1.0f}; RUN_GEMM(pg8::EpiOut, Abuf, ws + WS_WUP1, NUP, DM, E); }
    GRID_BAR();
    ffn_convgate(C, GU, ACT, args.in[I_FCW] + 3 * NUP, args.in[I_FCB] + NUP);
    GRID_BAR();
    { pg8::EpiOut E{(pg8::bf16_t*)MIX, DM, nullptr, 1.0f}; RUN_GEMM(pg8::EpiOut, ACT, ws + WS_WDN1, DM, DFF, E); }
    GRID_BAR();
    thin_phase<true, true, false>(C, MIX, out, out, args.in[I_NFPOST] + DM, nullptr);
}

extern "C" void kernel_launch(void* const* d_in, const int* in_sizes, int n_in, void* d_out, int out_size, void* d_ws, size_t ws_size, hipStream_t stream) {
    static int grid = 0;
    if (grid == 0) {
        if (n_in != 26 || in_sizes[0] != SEQ * DM || out_size != SEQ * DM || ws_size < WS_END) { fprintf(stderr, "kernel_launch: unexpected shapes: n_in %d in0 %d out %d ws %zu (need %zu)\n", n_in, n_in > 0 ? in_sizes[0] : -1, out_size, ws_size, (size_t)WS_END); grid = -1; return; }
        int dev = 0, cus = 0, per_cu = 0;
        if (hipGetDevice(&dev) != hipSuccess || hipDeviceGetAttribute(&cus, hipDeviceAttributeMultiprocessorCount, dev) != hipSuccess) { fprintf(stderr, "kernel_launch: device query failed\n"); grid = -1; return; }
        if (hipFuncSetAttribute((const void*)mk_fwd, hipFuncAttributeMaxDynamicSharedMemorySize, LDS_BYTES) != hipSuccess) { fprintf(stderr, "kernel_launch: hipFuncSetAttribute failed\n"); grid = -1; return; }
        if (hipOccupancyMaxActiveBlocksPerMultiprocessor(&per_cu, (const void*)mk_fwd, NWAVES * 64, LDS_BYTES) != hipSuccess || per_cu < 1) fprintf(stderr, "kernel_launch: occupancy query reports %d\n", per_cu);
        (void)hipGetLastError();
        grid = cus;
    }
    if (grid < 0) return;
    if (hipMemsetAsync((char*)d_ws + WS_CTL, 0, CTL_ZERO_BYTES, stream) != hipSuccess) { fprintf(stderr, "kernel_launch: memset failed\n"); return; }
    Args a{};
    for (int i = 0; i < 26; ++i) a.in[i] = (const float*)d_in[i];
    a.out = (float*)d_out; a.ws = (unsigned char*)d_ws;
    hipLaunchKernelGGL(mk_fwd, dim3(grid), dim3(NWAVES * 64), LDS_BYTES, stream, a);
    const hipError_t le = hipPeekAtLastError();
    if (le != hipSuccess) fprintf(stderr, "kernel_launch: launch failed: %s\n", hipGetErrorName(le));
}
```

```cpp
#define ZHI8 1
#define BCI8 1
#define ZHI8_Q0 4096
#include <hip/hip_runtime.h>
#include <cstdio>
#include <cstdint>
#ifndef PG8_WGM
#define PG8_WGM 8
#endif
namespace pg8 {
#define PG8_LAS __attribute__((address_space(3)))
typedef unsigned short bf16_t;
typedef short bf16x8 __attribute__((ext_vector_type(8)));
typedef float f32x4 __attribute__((ext_vector_type(4)));
typedef unsigned u32x4 __attribute__((ext_vector_type(4)));
constexpr int BM = 256, BK = 64, HALF = 128, HTB = HALF * BK * 2  , STAGE_BYTES = 8 * HTB, NXCD = 8, WGM = PG8_WGM;

__host__ __device__ __forceinline__ int lds_byte(int r, int c) { const int st = (r >> 4) * 2 + (c >> 5), rr = r & 15, cc = c & 31, ob = rr * 64 + cc * 2; return st * 1024 + (ob ^ (((ob >> 9) & 1) << 5)); }
__host__ __device__ __forceinline__ void stage_rc(int b, int& R, int& C) { const int st = b / 1024, sb = b % 1024, swz = sb ^ (((sb >> 9) & 1) << 5); R = (st >> 1) * 16 + swz / 64; C = (st & 1) * 32 + (swz % 64) / 2; }
__host__ __device__ __forceinline__ int perm32(int rho) { const int n = rho >> 4, i = rho & 15; return 8 * (i >> 2) + 4 * n + (i & 3); }

struct Unit { int pm, pn; };
struct Gemm { const bf16_t* A; const bf16_t* Bt; int M, N, K; };

struct StaticOrder {
    int nM, nN, nwg, G, c;
    __host__ __device__ void init(int M, int N, int G_, int c_) { nM = M / BM; nN = N / BM; nwg = nM * nN; G = G_; c = c_; }
    __host__ __device__ bool next(int i, Unit& u) const {
        const long L = (long)i * G + c; if (L >= nwg) return false;
        int wgid = (int)L; { const int q = nwg / NXCD, r = nwg % NXCD, xcd = wgid % NXCD, off = wgid / NXCD; wgid = (xcd < r ? xcd * (q + 1) : r * (q + 1) + (xcd - r) * q) + off; }
        const int nig = WGM * nN, gid = wgid / nig, fm = gid * WGM, gsz = (nM - fm) < WGM ? (nM - fm) : WGM;
        u.pm = fm + ((wgid % nig) % gsz); u.pn = (wgid % nig) / gsz; return true;
    }
    __device__ __forceinline__ void a_ready(const Unit&) const {}
    __device__ __forceinline__ void done(const Unit&) const {}
};

typedef __bf16 bf16v2_t __attribute__((ext_vector_type(2)));
typedef float f32x2_t __attribute__((ext_vector_type(2)));
typedef unsigned u32x2 __attribute__((ext_vector_type(2)));
__device__ __forceinline__ unsigned cvt_pk_bf16(float lo, float hi) { bf16v2_t v = __builtin_convertvector((f32x2_t){lo, hi}, bf16v2_t); return __builtin_bit_cast(unsigned, v); }

template <bool I8> struct EpiOutT {
    static constexpr bool PERM = true, AFTER_DRAIN = false;
    bf16_t* O; int ldc; const float* bias; float scale; const float* rowscale; const float* colmax;
    __device__ __forceinline__ void operator()(const f32x4 (&acc)[2][2][4][2], const Unit& u, int wr, int wc, int fr, int fq) const {
        const int row0 = u.pm * BM + wr * 64 + fr; const int col0 = u.pn * BM + wc * 32 + 8 * fq;
        float rs[2][4];
#pragma unroll
        for (int ai = 0; ai < 2; ++ai)
#pragma unroll
            for (int m = 0; m < 4; ++m) rs[ai][m] = rowscale ? rowscale[row0 + ai * HALF + m * 16] : 1.0f;
        f32x4 bv[2][2];
#pragma unroll
        for (int bj = 0; bj < 2; ++bj)
#pragma unroll
            for (int n = 0; n < 2; ++n) bv[bj][n] = bias ? *(const f32x4*)(bias + col0 + bj * HALF + 4 * n) : (f32x4){0.f, 0.f, 0.f, 0.f};
#pragma unroll
        for (int ai = 0; ai < 2; ++ai)
#pragma unroll
            for (int m = 0; m < 4; ++m) { bf16_t* rowp = O + (size_t)(row0 + ai * HALF + m * 16) * ldc + col0;
#pragma unroll
                for (int bj = 0; bj < 2; ++bj) { f32x4 a0 = acc[ai][bj][m][0], a1 = acc[ai][bj][m][1];
                    if constexpr (I8) { typedef int v4i_t __attribute__((ext_vector_type(4)));
                        a0 = __builtin_convertvector(__builtin_bit_cast(v4i_t, a0), f32x4) * (*(const f32x4*)(colmax + col0 + bj * HALF) * (1.0f / 127.0f));
                        a1 = __builtin_convertvector(__builtin_bit_cast(v4i_t, a1), f32x4) * (*(const f32x4*)(colmax + col0 + bj * HALF + 4) * (1.0f / 127.0f)); }
                    f32x4 v0 = (a0 * rs[ai][m] + bv[bj][0]) * scale, v1 = (a1 * rs[ai][m] + bv[bj][1]) * scale;
                    u32x4 w; w.x = cvt_pk_bf16(v0[0], v0[1]); w.y = cvt_pk_bf16(v0[2], v0[3]); w.z = cvt_pk_bf16(v1[0], v1[1]); w.w = cvt_pk_bf16(v1[2], v1[3]);
                    *(u32x4*)(rowp + bj * HALF) = w; } }
    }
};
typedef EpiOutT<false> EpiOut; typedef EpiOutT<true> EpiOutI8;
#ifndef PG8_ZB_TILES
#define PG8_ZB_TILES 32
#define PG8_ZB_SHIFT 32
#endif
struct EpiZBC {
    static constexpr bool PERM = true, AFTER_DRAIN = false;
    EpiOut e;
    __device__ __forceinline__ void operator()(const f32x4 (&acc)[2][2][4][2], const Unit& u, int wr, int wc, int fr, int fq) const { Unit v = u; if (u.pn >= PG8_ZB_TILES) v.pn = u.pn + PG8_ZB_SHIFT; e(acc, v, wr, wc, fr, fq); }
};
struct EpiKVQ {
    static constexpr bool PERM = true, AFTER_DRAIN = false;
    bf16_t* KV; bf16_t* Q; const float* bkv; const float* bq; float qscale; const float* rowscale;
    __device__ __forceinline__ void operator()(const f32x4 (&acc)[2][2][4][2], const Unit& u, int wr, int wc, int fr, int fq) const {
        const bool isq = u.pn >= 4;
        EpiOut e; Unit v = u; e.rowscale = rowscale; e.colmax = nullptr;
        if (isq) { e.O = Q; e.ldc = 4096; e.bias = bq; e.scale = qscale; v.pn = u.pn - 4; }
        else     { e.O = KV; e.ldc = 1024; e.bias = bkv; e.scale = 1.0f; }
        e(acc, v, wr, wc, fr, fq);
    }
};
__device__ __forceinline__ float dpp_ror1(float v) { return __builtin_bit_cast(float, __builtin_amdgcn_update_dpp(0, __builtin_bit_cast(int, v), 0x121, 0xf, 0xf, false)); }
__device__ __forceinline__ float dpp_ror2(float v) { return __builtin_bit_cast(float, __builtin_amdgcn_update_dpp(0, __builtin_bit_cast(int, v), 0x122, 0xf, 0xf, false)); }
template <bool I8> struct EpiConvGateT {
    static constexpr bool PERM = true, AFTER_DRAIN = false; const float* colmax;
    bf16_t* ACT; float* HALO; const float* cw; const float* cb; PG8_LAS float* xch; int dff, nup; const float* rowscale;
    __device__ __forceinline__ void operator()(const f32x4 (&acc_in)[2][2][4][2], const Unit& u, int wr, int wc, int fr, int fq) const {
        const int cbase = u.pn * 128 + wc * 32 + 8 * fq;
        f32x4 (&acc)[2][2][4][2] = const_cast<f32x4 (&)[2][2][4][2]>(acc_in);
#pragma unroll
        for (int ai = 0; ai < 2; ++ai)
#pragma unroll
            for (int m = 0; m < 4; ++m) { const float rsv = rowscale[u.pm * BM + ai * HALF + wr * 64 + m * 16 + fr];
#pragma unroll
                for (int bj = 0; bj < 2; ++bj)
#pragma unroll
                    for (int n = 0; n < 2; ++n) {
                        if constexpr (I8) { typedef int v4i_t __attribute__((ext_vector_type(4))); const f32x4 cs = *(const f32x4*)(colmax + bj * dff + cbase + 4 * n) * (1.0f / 127.0f);
                            acc[ai][bj][m][n] = __builtin_convertvector(__builtin_bit_cast(v4i_t, acc[ai][bj][m][n]), f32x4) * cs * rsv; }
                        else acc[ai][bj][m][n] = acc[ai][bj][m][n] * rsv; } }
        if (fr >= 14) {
#pragma unroll
            for (int ai = 0; ai < 2; ++ai)
#pragma unroll
                for (int bj = 0; bj < 2; ++bj)
#pragma unroll
                    for (int n = 0; n < 2; ++n) *(PG8_LAS f32x4*)(xch + (((((ai * 2 + wr) * 4 + wc) * 2 + (fr - 14)) * 2 + bj) * 32 + fq * 8 + n * 4)) = acc[ai][bj][3][n];
        }
        if (wr == 0 && fr < 2) {
#pragma unroll
            for (int bj = 0; bj < 2; ++bj)
#pragma unroll
                for (int n = 0; n < 2; ++n) *(f32x4*)(HALO + (size_t)(u.pm * 4 + fr) * nup + bj * dff + cbase + 4 * n) = acc[0][bj][0][n];
        }
        if (wr == 1 && fr >= 14) {
#pragma unroll
            for (int bj = 0; bj < 2; ++bj)
#pragma unroll
                for (int n = 0; n < 2; ++n) *(f32x4*)(HALO + (size_t)(u.pm * 4 + fr - 12) * nup + bj * dff + cbase + 4 * n) = acc[1][bj][3][n];
        }
        asm volatile("s_waitcnt lgkmcnt(0)" ::: "memory"); __builtin_amdgcn_s_barrier(); asm volatile("" ::: "memory");
        u32x2 ow[2][4];
#pragma unroll
        for (int n = 0; n < 2; ++n) {
            asm volatile("" ::: "memory");
            f32x4 w[2][3], b[2];
#pragma unroll
            for (int bj = 0; bj < 2; ++bj) {
#pragma unroll
                for (int k = 0; k < 3; ++k) w[bj][k] = *(const f32x4*)(cw + (size_t)k * nup + bj * dff + cbase + 4 * n);
                b[bj] = *(const f32x4*)(cb + bj * dff + cbase + 4 * n); }
#pragma unroll
            for (int ai = 0; ai < 2; ++ai) {
                const int pai = (wr == 1) ? ai : 0, pwr = (wr == 1) ? 0 : 1;
                f32x4 x14[2], x15[2];
#pragma unroll
                for (int bj = 0; bj < 2; ++bj) { x14[bj] = *(const PG8_LAS f32x4*)(xch + (((((pai * 2 + pwr) * 4 + wc) * 2 + 0) * 2 + bj) * 32 + fq * 8 + n * 4));
                                                 x15[bj] = *(const PG8_LAS f32x4*)(xch + (((((pai * 2 + pwr) * 4 + wc) * 2 + 1) * 2 + bj) * 32 + fq * 8 + n * 4)); }
#pragma unroll
                for (int m = 0; m < 4; ++m) {
                    f32x4 cv[2];
#pragma unroll
                    for (int bj = 0; bj < 2; ++bj) {
                        const f32x4 cur = acc[ai][bj][m][n]; f32x4 p1, p2;
#pragma unroll
                        for (int j = 0; j < 4; ++j) {
                            const float c1 = dpp_ror1(cur[j]), c2 = dpp_ror2(cur[j]); float q1, q2;
                            if (m == 0) { q1 = x15[bj][j]; q2 = (fr == 1) ? x15[bj][j] : x14[bj][j]; }
                            else { const float pv = acc[ai][bj][m > 0 ? m - 1 : 0][n][j]; q1 = dpp_ror1(pv); q2 = dpp_ror2(pv); }
                            p1[j] = (fr >= 1) ? c1 : q1; p2[j] = (fr >= 2) ? c2 : q2; }
                        cv[bj] = b[bj] + w[bj][0] * p2 + w[bj][1] * p1 + w[bj][2] * cur; }
                    float o[4];
#pragma unroll
                    for (int j = 0; j < 4; ++j) o[j] = cv[0][j] * __builtin_amdgcn_rcpf(1.0f + __expf(-cv[0][j])) * cv[1][j];
                    u32x2 pkd; pkd.x = cvt_pk_bf16(o[0], o[1]); pkd.y = cvt_pk_bf16(o[2], o[3]);
                    if (n == 0) ow[ai][m] = pkd;
                    else { u32x4 wv; wv.x = ow[ai][m].x; wv.y = ow[ai][m].y; wv.z = pkd.x; wv.w = pkd.y;
                        *(u32x4*)(ACT + (size_t)(u.pm * BM + ai * HALF + wr * 64 + m * 16 + fr) * dff + cbase) = wv; } }
            }
        }
    }
};
typedef EpiConvGateT<false> EpiConvGate; typedef EpiConvGateT<true> EpiConvGateI8;

typedef int pg8_v4i __attribute__((ext_vector_type(4)));
template <bool I8> __device__ __forceinline__ f32x4 mma16(const bf16x8 b, const bf16x8 a, const f32x4 c) {
    if constexpr (I8) return __builtin_bit_cast(f32x4, __builtin_amdgcn_mfma_i32_16x16x64_i8(__builtin_bit_cast(pg8_v4i, b), __builtin_bit_cast(pg8_v4i, a), __builtin_bit_cast(pg8_v4i, c), 0, 0, 0));
    else return __builtin_amdgcn_mfma_f32_16x16x32_bf16(b, a, c, 0, 0, 0);
}
template <class Epi, class Sched, bool ALIGN_EPI = false, bool SP2 = false, bool I8 = false>
__device__ __forceinline__ void gemm_phase(PG8_LAS unsigned char* lds, const Gemm g, const Sched& S, const Epi& E) {
    int tid_l = threadIdx.x; asm volatile("" : "+v"(tid_l));
    const int tid = tid_l, wid = __builtin_amdgcn_readfirstlane(tid >> 6), lane = tid & 63, wr = wid >> 2, wc = wid & 3, fr = lane & 15, fq = lane >> 4;
    const int K = g.K, nt = K / BK;
    unsigned voffA[2], voffB[2];
#pragma unroll
    for (int i = 0; i < 2; ++i) { int R, C; stage_rc(tid * 16 + i * 8192, R, C); const int Rb = Epi::PERM ? ((R & ~31) + perm32(R & 31)) : R;
        voffA[i] = (unsigned)(R * K + C) * 2u; voffB[i] = (unsigned)(Rb * K + C) * 2u; }
    const size_t kstep = (size_t)(BK * 2);
    const size_t hstep = (size_t)HALF * K * 2;
    const size_t tstep = 2 * hstep;
    const unsigned ldsw = (unsigned)wid * 1024u;
    const int aoff = lds_byte(wr * 64 + fr, fq * 8), boff = lds_byte(wc * 32 + fr, fq * 8);
#define PG8_SA(b, h) (((b) * 2 + (h)) * HTB)
#define PG8_SB(b, h) ((4 + (b) * 2 + (h)) * HTB)
#define PG8_STAGE(bufoff, gbase, voff) do { _Pragma("unroll") for (int _i = 0; _i < 2; ++_i) \
        __builtin_amdgcn_global_load_lds((const unsigned*)((const char*)(gbase) + (voff)[_i]), (PG8_LAS unsigned*)(lds + (bufoff) + ldsw + _i * 8192), 16, 0, 0); } while (0)
#define PG8_LDA(dst, b, h) do { _Pragma("unroll") for (int m = 0; m < 4; ++m) _Pragma("unroll") for (int k = 0; k < 2; ++k) dst[m][k] = *(const PG8_LAS bf16x8*)(lds + PG8_SA(b, h) + aoff + m * 2048 + k * 1024); } while (0)
#define PG8_LDB(dst, b, h) do { _Pragma("unroll") for (int n = 0; n < 2; ++n) _Pragma("unroll") for (int k = 0; k < 2; ++k) dst[n][k] = *(const PG8_LAS bf16x8*)(lds + PG8_SB(b, h) + boff + n * 2048 + k * 1024); } while (0)
#define PG8_MMA(ai, bj, At, Bt) do { __builtin_amdgcn_s_setprio(1); _Pragma("unroll") for (int m = 0; m < 4; ++m) _Pragma("unroll") for (int n = 0; n < 2; ++n) _Pragma("unroll") for (int k = 0; k < 2; ++k) \
        acc[ai][bj][m][n] = mma16<I8>(Bt[n][k], At[m][k], acc[ai][bj][m][n]); __builtin_amdgcn_s_setprio(0); } while (0)
#define PG8_WAIT_V(n) asm volatile("s_waitcnt vmcnt(" #n ")" ::: "memory")
#define PG8_WAIT_L(n) asm volatile("s_waitcnt lgkmcnt(" #n ")" ::: "memory")
#define PG8_BAR __builtin_amdgcn_s_barrier()
#define PG8_SCHED __builtin_amdgcn_sched_barrier(0)
    Unit cur, nxt; int ui = 0;
    if (!S.next(0, cur)) return;
    f32x4 acc[2][2][4][2];
#pragma unroll
    for (int a = 0; a < 2; ++a)
#pragma unroll
        for (int b = 0; b < 2; ++b)
#pragma unroll
            for (int m = 0; m < 4; ++m)
#pragma unroll
                for (int n = 0; n < 2; ++n) acc[a][b][m][n] = (f32x4){0.f, 0.f, 0.f, 0.f};
    bf16x8 At[4][2], B0[2][2], B1[2][2];
    const char* cA = (const char*)g.A + (size_t)cur.pm * tstep; const char* cB = (const char*)g.Bt + (size_t)cur.pn * tstep;
    S.a_ready(cur);
    if constexpr (SP2) {
        PG8_STAGE(PG8_SB(0, 0), cB, voffB); PG8_STAGE(PG8_SB(0, 1), cB + hstep, voffB); PG8_STAGE(PG8_SA(0, 0), cA, voffA); PG8_STAGE(PG8_SA(0, 1), cA + hstep, voffA);
        if (wr == 1) PG8_BAR;
        PG8_WAIT_V(2); PG8_BAR;
        PG8_STAGE(PG8_SB(1, 0), cB + kstep, voffB); PG8_STAGE(PG8_SA(1, 0), cA + kstep, voffA); PG8_STAGE(PG8_SB(1, 1), cB + hstep + kstep, voffB);
        PG8_WAIT_V(6); PG8_BAR;
    } else {
        PG8_STAGE(PG8_SB(0, 0), cB, voffB); PG8_STAGE(PG8_SA(0, 0), cA, voffA); PG8_STAGE(PG8_SB(0, 1), cB + hstep, voffB); PG8_STAGE(PG8_SA(0, 1), cA + hstep, voffA);
        if (wr == 1) PG8_BAR;
        PG8_WAIT_V(4); PG8_BAR;
        PG8_STAGE(PG8_SB(1, 0), cB + kstep, voffB); PG8_STAGE(PG8_SA(1, 0), cA + kstep, voffA); PG8_STAGE(PG8_SB(1, 1), cB + hstep + kstep, voffB);
        PG8_WAIT_V(6); PG8_BAR;
    }
    for (;;) {
        const bool has_next = S.next(ui + 1, nxt);
        const char* nA = has_next ? (const char*)g.A + (size_t)nxt.pm * tstep : cA; const char* nB = has_next ? (const char*)g.Bt + (size_t)nxt.pn * tstep : cB;
        for (int t = 0; t < nt; t += 2) {
            const bool last = (t == nt - 2);
            const char* a1 = cA + (size_t)(t + 1) * kstep;
            const char* a2 = last ? nA : cA + (size_t)(t + 2) * kstep; const char* b2 = last ? nB : cB + (size_t)(t + 2) * kstep;
            const char* a3 = a2 + kstep; const char* b3 = b2 + kstep;
            if (last && has_next) S.a_ready(nxt);
            if constexpr (SP2) {
            PG8_LDB(B0, 0, 0); PG8_LDB(B1, 0, 1); PG8_SCHED; PG8_LDA(At, 0, 0); PG8_STAGE(PG8_SA(1, 1), a1 + hstep, voffA);
            PG8_WAIT_V(8); PG8_WAIT_L(0); PG8_BAR; PG8_MMA(0, 0, At, B0); PG8_MMA(0, 1, At, B1); PG8_BAR; PG8_SCHED;
            PG8_LDA(At, 0, 1); PG8_STAGE(PG8_SB(0, 0), b2, voffB); PG8_STAGE(PG8_SB(0, 1), b2 + hstep, voffB); PG8_STAGE(PG8_SA(0, 0), a2, voffA);
            PG8_WAIT_V(8); PG8_WAIT_L(0); PG8_BAR; PG8_MMA(1, 0, At, B0); PG8_MMA(1, 1, At, B1); PG8_BAR; PG8_SCHED;
            PG8_LDB(B0, 1, 0); PG8_LDB(B1, 1, 1); PG8_SCHED; PG8_LDA(At, 1, 0); PG8_STAGE(PG8_SA(0, 1), a2 + hstep, voffA);
            PG8_WAIT_V(8); PG8_WAIT_L(0); PG8_BAR; PG8_MMA(0, 0, At, B0); PG8_MMA(0, 1, At, B1); PG8_BAR; PG8_SCHED;
            PG8_LDA(At, 1, 1); PG8_STAGE(PG8_SB(1, 0), b3, voffB); PG8_STAGE(PG8_SB(1, 1), b3 + hstep, voffB); PG8_STAGE(PG8_SA(1, 0), a3, voffA);
            PG8_WAIT_V(8); PG8_WAIT_L(0); PG8_BAR; PG8_MMA(1, 0, At, B0); PG8_MMA(1, 1, At, B1); PG8_BAR; PG8_SCHED;
            } else {
            PG8_LDB(B0, 0, 0); PG8_SCHED; PG8_LDA(At, 0, 0); PG8_STAGE(PG8_SA(1, 1), a1 + hstep, voffA);
            PG8_WAIT_L(8); PG8_BAR; PG8_WAIT_L(0); PG8_MMA(0, 0, At, B0); PG8_BAR; PG8_SCHED;
            PG8_LDB(B1, 0, 1); PG8_STAGE(PG8_SB(0, 0), b2, voffB);
            PG8_BAR; PG8_WAIT_L(0); PG8_MMA(0, 1, At, B1); PG8_BAR;
            PG8_LDA(At, 0, 1); PG8_STAGE(PG8_SA(0, 0), a2, voffA);
            PG8_BAR; PG8_WAIT_L(0); PG8_MMA(1, 0, At, B0); PG8_BAR; PG8_SCHED;
            PG8_STAGE(PG8_SB(0, 1), b2 + hstep, voffB);
            PG8_WAIT_V(6); PG8_BAR; PG8_MMA(1, 1, At, B1); PG8_BAR;
            PG8_LDB(B0, 1, 0); PG8_SCHED; PG8_LDA(At, 1, 0); PG8_STAGE(PG8_SA(0, 1), a2 + hstep, voffA);
            PG8_WAIT_L(8); PG8_BAR; PG8_WAIT_L(0); PG8_MMA(0, 0, At, B0); PG8_BAR; PG8_SCHED;
            PG8_LDB(B1, 1, 1); PG8_STAGE(PG8_SB(1, 0), b3, voffB);
            PG8_BAR; PG8_WAIT_L(0); PG8_MMA(0, 1, At, B1); PG8_BAR;
            PG8_LDA(At, 1, 1); PG8_STAGE(PG8_SA(1, 0), a3, voffA);
            PG8_BAR; PG8_WAIT_L(0); PG8_MMA(1, 0, At, B0); PG8_BAR; PG8_SCHED;
            PG8_STAGE(PG8_SB(1, 1), b3 + hstep, voffB);
            PG8_WAIT_V(6); PG8_BAR; PG8_MMA(1, 1, At, B1); PG8_BAR;
            }
        }
        if constexpr (ALIGN_EPI) { if (wr == 0) PG8_BAR; }
        if constexpr (!Epi::AFTER_DRAIN) { E(acc, cur, wr, wc, fr, fq); S.done(cur); }
        if (!has_next) break;
#pragma unroll
        for (int a = 0; a < 2; ++a)
#pragma unroll
            for (int b = 0; b < 2; ++b)
#pragma unroll
                for (int m = 0; m < 4; ++m)
#pragma unroll
                    for (int n = 0; n < 2; ++n) acc[a][b][m][n] = (f32x4){0.f, 0.f, 0.f, 0.f};
        cur = nxt; cA = nA; cB = nB; ++ui;
        if constexpr (ALIGN_EPI) { if (wr == 1) PG8_BAR; }
    }
    PG8_WAIT_V(0);
    if constexpr (!ALIGN_EPI) { if (wr == 0) PG8_BAR; }
    PG8_BAR;
    if constexpr (Epi::AFTER_DRAIN) { E.fused(acc, cur, wr, wc, fr, fq, lds, wid, lane); S.done(cur); }
#undef PG8_SA
#undef PG8_SB
#undef PG8_STAGE
#undef PG8_LDA
#undef PG8_LDB
#undef PG8_MMA
#undef PG8_WAIT_V
#undef PG8_WAIT_L
#undef PG8_BAR
#undef PG8_SCHED
}
}
#define GAS __attribute__((address_space(1)))
#define LAS __attribute__((address_space(3)))
typedef unsigned short bf16;
typedef unsigned v4u __attribute__((ext_vector_type(4)));
typedef float f32x4 __attribute__((ext_vector_type(4)));
typedef short bf16x8 __attribute__((ext_vector_type(8)));
typedef GAS unsigned gu32;
typedef GAS unsigned long long gu64;
#define RLX_AGENT __ATOMIC_RELAXED, __HIP_MEMORY_SCOPE_AGENT
#define LDS_WAIT() asm volatile("s_waitcnt lgkmcnt(0)" ::: "memory")
#define VM_WAIT() asm volatile("s_waitcnt vmcnt(0)" ::: "memory")
__device__ __forceinline__ unsigned long long rt() { return __builtin_amdgcn_s_memrealtime(); }

#define XB_TMO      128
#define XB_XCNT(j)  (256  + 64 * (j))
#define XB_XSUB(j)  (1280 + 64 * (j))
#define XB_XGEN(j)  (2304 + 64 * (j))
#define XB_TOP      3328
#define XB_TOPGEN   3392
#define XCD_BAR_WORDS 3456
#define XB_SPIN_CAP (1u << 18)

__device__ __forceinline__ unsigned xb_ld(unsigned* p)              { return __hip_atomic_load(p, __ATOMIC_RELAXED, __HIP_MEMORY_SCOPE_AGENT); }
__device__ __forceinline__ unsigned xb_add(unsigned* p, unsigned v) { return __hip_atomic_fetch_add(p, v, __ATOMIC_RELAXED, __HIP_MEMORY_SCOPE_AGENT); }
__device__ __forceinline__ unsigned xb_xcc_id() { return (unsigned)__builtin_amdgcn_s_getreg((3 << 11) | 20) & 0xFu; }
#define XB_SPIN(cond, bar) do { unsigned _sp = 0; while (cond) { __builtin_amdgcn_s_sleep(1); \
    if ((++_sp & 255u) == 0u) { if (xb_ld(&(bar)[XB_TMO])) break; if (_sp > XB_SPIN_CAP) { atomicAdd(&(bar)[XB_TMO], 1u); break; } } } } while (0)

struct XcdBarrier {
    unsigned* bar; unsigned x;
    volatile LAS unsigned* st;
};

__device__ __forceinline__ XcdBarrier xcd_barrier_post(unsigned* bar, volatile LAS unsigned* st) {
    XcdBarrier b; b.bar = bar; b.x = xb_xcc_id(); b.st = st;
    if (threadIdx.x == 0) (void)xb_add(&bar[XB_XCNT(b.x)], 1u);
    return b;
}
__device__ __forceinline__ void xcd_barrier_complete(unsigned* bar, unsigned x, unsigned& nloc, unsigned& nx) {
    const unsigned G = gridDim.x * gridDim.y * gridDim.z;
    unsigned sum, cnt, mine, sp = 0u;
    for (;;) {
        sum = 0u; cnt = 0u; mine = 0u;
#pragma unroll
        for (unsigned j = 0; j < 16; ++j) { const unsigned c = xb_ld(&bar[XB_XCNT(j)]); sum += c; cnt += (c > 0u) ? 1u : 0u; mine = (j == x) ? c : mine; }
        if (sum == G) break;
        __builtin_amdgcn_s_sleep(1);
        if ((++sp & 255u) == 0u) { if (xb_ld(&bar[XB_TMO])) break; if (sp > XB_SPIN_CAP) { atomicAdd(&bar[XB_TMO], 1u); break; } }
    }
    nloc = mine > 0u ? mine : 1u; nx = cnt > 0u ? cnt : 1u;
}

__device__ __forceinline__ void xcd_barrier(const XcdBarrier& b) {
    asm volatile("s_waitcnt vmcnt(0)" ::: "memory");
    __syncthreads();
    if (threadIdx.x == 0) {
        unsigned* bar = b.bar;
        __builtin_amdgcn_s_waitcnt(0);
        unsigned nloc = b.st[0], nx = b.st[1];
        if (nloc == 0u) { xcd_barrier_complete(bar, b.x, nloc, nx); b.st[0] = nloc; b.st[1] = nx; }
        const unsigned old = xb_add(&bar[XB_XSUB(b.x)], 1u);
        const unsigned gen = old / nloc;
        if (old + 1u == (gen + 1u) * nloc) {
            __builtin_amdgcn_fence(__ATOMIC_RELEASE, "agent");
            asm volatile("s_waitcnt vmcnt(0)" ::: "memory");
            const unsigned og = xb_add(&bar[XB_TOP], 1u);
            const unsigned tg = og / nx;
            if (og + 1u == (tg + 1u) * nx) xb_add(&bar[XB_TOPGEN], 1u);
            else XB_SPIN(xb_ld(&bar[XB_TOPGEN]) == tg, bar);
            __builtin_amdgcn_fence(__ATOMIC_ACQUIRE, "agent");
            xb_add(&bar[XB_XGEN(b.x)], 1u);
            asm volatile("s_waitcnt vmcnt(0)" ::: "memory");
        } else {
            XB_SPIN(xb_ld(&bar[XB_XGEN(b.x)]) == gen, bar);
            __builtin_amdgcn_fence(__ATOMIC_ACQUIRE, "agent");
            asm volatile("s_waitcnt vmcnt(0)" ::: "memory");
        }
    }
    __syncthreads();
}


constexpr int SEQ = 8192, DM = 4096, DINNER = 8192, NHEAD = 128, HDIM = 64, NGRP = 8, HPG = 16, DSTATE = 128;
constexpr int CONVD = 10240, NZX = 18432, NIN = 18560, DFF = 11008, NUP = 22016, NKVQ = 5120;
constexpr int CHUNK = 128, NCHUNK = 64;
#ifdef ZHI8
#ifndef ZHI8_Q0
#define ZHI8_Q0 4096
#endif
#ifdef BCI8
constexpr int NZI8 = NZX - ZHI8_Q0, NBC = NZX - NZI8;
#else
constexpr int NZI8 = 16384 - ZHI8_Q0, NBC = NZX - NZI8;
#endif
#elif defined(XBCI8)
constexpr int NZI8 = 10240, NBC = NZX - NZI8;
#elif defined(ZXI8)
constexpr int NZI8 = 16384, NBC = NZX - NZI8;
#else
constexpr int NZI8 = 8192, NBC = NZX - NZI8;
#endif
#ifdef ZHI8
constexpr int QCOL0 = ZHI8_Q0;
#elif defined(ZXI8)
constexpr int QCOL0 = 0;
#else
constexpr int QCOL0 = DINNER;
#endif
constexpr float EPS = 1e-6f, SSM_EPS = 1e-5f;
constexpr int NWAVES = 8;

constexpr size_t MiB = 1u << 20;
constexpr size_t WS_CTL = 0, CTL_ZERO_BYTES = 1 * MiB;
constexpr size_t WS_WIN = 1 * MiB;
constexpr size_t WS_WOUT = 146 * MiB;
constexpr size_t WS_WUP0 = 210 * MiB;
constexpr size_t WS_WUP1 = 382 * MiB;
constexpr size_t WS_WDN0 = 554 * MiB;
constexpr size_t WS_WDN1 = 640 * MiB;
constexpr size_t WS_WKVQ = 726 * MiB;
constexpr size_t WS_WO = 766 * MiB;
constexpr size_t WS_A = 798 * MiB;
constexpr size_t WS_MIX = 862 * MiB;
constexpr size_t WS_DTRAW = 926 * MiB;
constexpr size_t WS_DT = 930 * MiB;
constexpr size_t WS_ACUM = 934 * MiB;
constexpr size_t WS_HALO = WS_DTRAW;
constexpr size_t WS_RS = 937 * MiB;
constexpr size_t WS_RSQ = 937 * MiB + 65536;
constexpr size_t WS_CMAX = 512 * 1024;
constexpr size_t WS_BIG = 938 * MiB;
constexpr size_t WS_A8 = WS_BIG;
constexpr size_t WS_ZX = WS_BIG;
constexpr size_t WS_S = WS_BIG + 448 * MiB;
constexpr size_t WS_ST = WS_BIG + 704 * MiB;
constexpr size_t WS_Y = WS_BIG + 832 * MiB;
constexpr size_t WS_ACT = WS_BIG + 344 * MiB;
constexpr size_t WS_Q = WS_BIG;
constexpr size_t WS_KV = WS_BIG + 64 * MiB;
constexpr size_t WS_O = WS_BIG + 80 * MiB;
constexpr size_t WS_END = WS_BIG + 960 * MiB;
constexpr int CW_BAR = 4096;

constexpr int LDS_BYTES = 163840;
constexpr int MISC_OFF = LDS_BYTES - 256;

typedef float f32x4 __attribute__((ext_vector_type(4)));
typedef float f32x16 __attribute__((ext_vector_type(16)));
typedef short bf16x8 __attribute__((ext_vector_type(8)));
typedef short bf16x4 __attribute__((ext_vector_type(4)));
typedef unsigned u32x4 __attribute__((ext_vector_type(4)));
typedef unsigned u32x2 __attribute__((ext_vector_type(2)));
#define DEV __device__ __forceinline__
DEV unsigned pk2(float lo, float hi) { return pg8::cvt_pk_bf16(lo, hi); }
DEV float bf_lo(unsigned w) { return __builtin_bit_cast(float, w << 16); }
DEV float bf_hi(unsigned w) { return __builtin_bit_cast(float, w & 0xffff0000u); }
DEV float bf2f(bf16 b) { return __builtin_bit_cast(float, ((unsigned)b) << 16); }
DEV bf16 f2bf(float f) { return (bf16)(pk2(f, 0.f) & 0xffffu); }
DEV float silu_f(float v) { return v * __builtin_amdgcn_rcpf(1.0f + __expf(-v)); }
DEV float wave_sum(float v) {
#pragma unroll
    for (int o = 1; o < 64; o <<= 1) v += __shfl_xor(v, o);
    return v;
}
DEV void unpack8(const u32x4 w, float (&f)[8]) { f[0] = bf_lo(w.x); f[1] = bf_hi(w.x); f[2] = bf_lo(w.y); f[3] = bf_hi(w.y); f[4] = bf_lo(w.z); f[5] = bf_hi(w.z); f[6] = bf_lo(w.w); f[7] = bf_hi(w.w); }
DEV u32x4 pack8(const float (&f)[8]) { u32x4 w; w.x = pk2(f[0], f[1]); w.y = pk2(f[2], f[3]); w.z = pk2(f[4], f[5]); w.w = pk2(f[6], f[7]); return w; }

struct Ctx { LAS unsigned char* lds; int tid, lane, wave, vcu, G; };

struct TrTile { f32x4 v[16]; float g[16]; };
DEV void tr_load(TrTile& t, const float* __restrict__ W, int N, const float* __restrict__ gain, int k0, int n0, int lane) {
    const int kr = lane >> 4, nc = (lane & 15) * 4;
#pragma unroll
    for (int i = 0; i < 16; ++i) { const int kk = 4 * i + kr; t.v[i] = __builtin_nontemporal_load((const f32x4*)(W + (size_t)(k0 + kk) * N + n0 + nc));     t.g[i] = gain ? gain[k0 + kk] : 1.0f; }
}
DEV void tr_store(const TrTile& t, bf16* __restrict__ WT, int K, int row_off, int k0, int n0, LAS float* scr, int lane) {
    const int kr = lane >> 4, nc = (lane & 15) * 4;
#pragma unroll
    for (int i = 0; i < 16; ++i) { const int kk = 4 * i + kr; LAS float* s = scr + kk * 65 + nc; s[0] = t.v[i].x * t.g[i]; s[1] = t.v[i].y * t.g[i]; s[2] = t.v[i].z * t.g[i]; s[3] = t.v[i].w * t.g[i]; }
    asm volatile("s_waitcnt lgkmcnt(0)" ::: "memory");
    const int c = lane & 7;
#pragma unroll
    for (int j = 0; j < 8; ++j) { const int n = 8 * j + (lane >> 3); const LAS float* s = scr + (8 * c) * 65 + n;
        u32x4 o; o.x = pk2(s[0 * 65], s[1 * 65]); o.y = pk2(s[2 * 65], s[3 * 65]); o.z = pk2(s[4 * 65], s[5 * 65]); o.w = pk2(s[6 * 65], s[7 * 65]);
        __builtin_nontemporal_store(o, (u32x4*)(WT + (size_t)(row_off + n0 + n) * K + k0 + 8 * c)); }
    asm volatile("s_waitcnt lgkmcnt(0)" ::: "memory");
}
DEV int tr_row_up(int n0) { const int isv = n0 >= DFF ? 1 : 0, m0 = n0 - isv * DFF; return (m0 >> 7) * 256 + isv * 128 + (m0 & 127); }
template <bool UPMAP = false>
DEV void tr_matrix(const Ctx& C, const float* W, int K, int N, const float* gain, bf16* WT, int row_off, int gw_in = -1, int NGW_in = 0, int part_lo = 0, int part_hi = 20, int ldW = 0) {
    LAS float* scr = (LAS float*)(C.lds + C.wave * 16640);
    const int gw = gw_in < 0 ? C.vcu * NWAVES + C.wave : gw_in, NGW = gw_in < 0 ? C.G * NWAVES : NGW_in;
    const int ld = ldW ? ldW : N; const int nblk = N / 64, items_all = (K / 64) * nblk;
    const int it_lo = (int)((long)items_all * part_lo / 20), items = (int)((long)items_all * part_hi / 20);
    if (it_lo + gw >= items) return;
    TrTile cur, nxt;
    { const int kb = (it_lo + gw) / nblk, nb = (it_lo + gw) - kb * nblk; tr_load(cur, W, ld, gain, kb * 64, nb * 64, C.lane); }
    for (int it = it_lo + gw; it < items; it += NGW) { const int kb = it / nblk, nb = it - kb * nblk; const int n0 = nb * 64; int ro = row_off;
        if (UPMAP) { const int isv = n0 >= DFF ? 1 : 0, m0 = n0 - isv * DFF; ro = (m0 >> 7) * 256 + isv * 128 + (m0 & 127) - n0; }
        const int it2 = it + NGW; const bool more = it2 < items;
        if (more) { const int kb2 = it2 / nblk, nb2 = it2 - kb2 * nblk; tr_load(nxt, W, ld, gain, kb2 * 64, nb2 * 64, C.lane); }
        tr_store(cur, WT, K, ro, kb * 64, n0, scr, C.lane);
        if (more) cur = nxt; }
}
template <bool HAS_GAIN>
DEV void tr_wide(const Ctx& C, const float* __restrict__ W, int K, int N, const float* __restrict__ gain, bf16* __restrict__ WT, int row_off, int ld) {
    constexpr int TN = 128, TK = 256, TPB = TK * 2 + 16;
    LAS unsigned char* T = C.lds;
    const int tid = C.tid, quad = tid & 31, rsub = tid >> 5;
    const int nblk = N / TN, items = (K / TK) * nblk;
    int it = C.vcu; if (it >= items) return;
    f32x4 cur[16], nxt[16];
    { const int kb = it / nblk, nb = it - kb * nblk; const float* src = W + (size_t)(kb * TK) * ld + nb * TN + quad * 4;
#pragma unroll
      for (int i = 0; i < 16; ++i) cur[i] = __builtin_nontemporal_load((const f32x4*)(src + (size_t)(4 * (rsub + 16 * (i >> 2)) + (i & 3)) * ld)); }
    for (;;) {
        const int kb = it / nblk, nb = it - kb * nblk, k0 = kb * TK, n0 = nb * TN;
        const int it2 = it + C.G; const bool more = it2 < items;
        if (more) { const int kb2 = it2 / nblk, nb2 = it2 - kb2 * nblk; const float* src = W + (size_t)(kb2 * TK) * ld + nb2 * TN + quad * 4;
#pragma unroll
            for (int i = 0; i < 16; ++i) nxt[i] = __builtin_nontemporal_load((const f32x4*)(src + (size_t)(4 * (rsub + 16 * (i >> 2)) + (i & 3)) * ld)); }
#pragma unroll
        for (int j = 0; j < 4; ++j) { const int rbl = rsub + 16 * j; f32x4 g4 = {1.f, 1.f, 1.f, 1.f}; if constexpr (HAS_GAIN) g4 = *(const f32x4*)(gain + k0 + 4 * rbl);
            LAS unsigned char* tp = T + (quad * 4) * TPB + 16 * ((rbl >> 1) ^ (quad & 7)) + 8 * (rbl & 1);
#pragma unroll
            for (int c = 0; c < 4; ++c) { u32x2 w; w.x = pk2(cur[4 * j + 0][c] * g4.x, cur[4 * j + 1][c] * g4.y); w.y = pk2(cur[4 * j + 2][c] * g4.z, cur[4 * j + 3][c] * g4.w);
                *(LAS u32x2*)(tp + c * TPB) = w; } }
        __syncthreads();
#pragma unroll 4
        for (int j = 0; j < 8; ++j) { const int id = tid + 512 * j, n = id >> 5, ch = id & 31;
            __builtin_nontemporal_store(*(const LAS u32x4*)(T + n * TPB + 16 * (ch ^ ((n >> 2) & 7))), (u32x4*)(WT + (size_t)(row_off + n0 + n) * K + k0 + ch * 8)); }
        __syncthreads();
        if (!more) break;
#pragma unroll
        for (int i = 0; i < 16; ++i) cur[i] = nxt[i];
        it = it2;
    }
}
DEV void w_colmax(const Ctx& C, const float* __restrict__ W, int K, int N, const float* __restrict__ gain, float* __restrict__ cmax, int ld) {
    const int gw = C.vcu * NWAVES + C.wave, NGW = C.G * NWAVES; const int ncb = N / 256, items = (K / 64) * ncb;
    for (int it = gw; it < items; it += NGW) { const int kb = it / ncb, nb = it - kb * ncb; const float* src = W + (size_t)(kb * 64) * ld + nb * 256 + C.lane * 4;
        f32x4 mx = {0.f, 0.f, 0.f, 0.f};
#pragma unroll 1
        for (int k0 = 0; k0 < 64; k0 += 16) { f32x4 v[16];
#pragma unroll
            for (int i = 0; i < 16; ++i) v[i] = __builtin_nontemporal_load((const f32x4*)(src + (size_t)(k0 + i) * ld));
#pragma unroll
            for (int i = 0; i < 16; ++i) { const float gk = gain[kb * 64 + k0 + i]; mx.x = fmaxf(mx.x, fabsf(v[i].x * gk)); mx.y = fmaxf(mx.y, fabsf(v[i].y * gk)); mx.z = fmaxf(mx.z, fabsf(v[i].z * gk)); mx.w = fmaxf(mx.w, fabsf(v[i].w * gk)); } }
        unsigned* dst = (unsigned*)(cmax + nb * 256 + C.lane * 4);
        atomicMax(dst + 0, __float_as_uint(mx.x)); atomicMax(dst + 1, __float_as_uint(mx.y)); atomicMax(dst + 2, __float_as_uint(mx.z)); atomicMax(dst + 3, __float_as_uint(mx.w)); }
}
template <bool UPMAP>
DEV void w_quant(const Ctx& C, const float* __restrict__ W, int K, int N, const float* __restrict__ gain, const float* __restrict__ cmax, signed char* __restrict__ WQ, int ld) {
    LAS float* scr = (LAS float*)(C.lds + C.wave * 16640);
    const int gw = C.vcu * NWAVES + C.wave, NGW = C.G * NWAVES; const int nblk = N / 64, items = (K / 64) * nblk, lane = C.lane;
    for (int it = gw; it < items; it += NGW) { const int kb = it / nblk, nb = it - kb * nblk, k0 = kb * 64, n0 = nb * 64;
        const int kr = lane >> 4, nc = (lane & 15) * 4; f32x4 v[16]; float gk[16];
#pragma unroll
        for (int i = 0; i < 16; ++i) v[i] = __builtin_nontemporal_load((const f32x4*)(W + (size_t)(k0 + 4 * i + kr) * ld + n0 + nc));
#pragma unroll
        for (int i = 0; i < 16; ++i) gk[i] = gain[k0 + 4 * i + kr];
        const f32x4 cm = *(const f32x4*)(cmax + n0 + nc); const f32x4 sc = {cm.x > 0.f ? 127.0f / cm.x : 0.f, cm.y > 0.f ? 127.0f / cm.y : 0.f, cm.z > 0.f ? 127.0f / cm.z : 0.f, cm.w > 0.f ? 127.0f / cm.w : 0.f};
#pragma unroll
        for (int i = 0; i < 16; ++i) { LAS float* sp = scr + (4 * i + kr) * 65 + nc; sp[0] = v[i].x * gk[i] * sc.x; sp[1] = v[i].y * gk[i] * sc.y; sp[2] = v[i].z * gk[i] * sc.z; sp[3] = v[i].w * gk[i] * sc.w; }
        asm volatile("s_waitcnt lgkmcnt(0)" ::: "memory");
        const int c = lane & 3, drow0 = UPMAP ? tr_row_up(n0) : n0;
#pragma unroll
        for (int j = 0; j < 4; ++j) { const int n = 16 * j + (lane >> 2); const LAS float* sp = scr + (16 * c) * 65 + n; u32x4 o;
#pragma unroll
            for (int d = 0; d < 4; ++d) { unsigned w = 0u;
#pragma unroll
                for (int b = 0; b < 4; ++b) w |= ((unsigned)(int)__builtin_rintf(sp[(4 * d + b) * 65]) & 255u) << (8 * b);
                o[d] = w; }
            __builtin_nontemporal_store(o, (u32x4*)(WQ + (size_t)(drow0 + n) * K + k0 + 16 * c)); }
        asm volatile("s_waitcnt lgkmcnt(0)" ::: "memory"); }
}
template <bool UPMAP>
DEV void w_quant_stripe(const Ctx& C, const float* __restrict__ W, int N, const float* __restrict__ gain, float* __restrict__ cmax, signed char* __restrict__ WQ, int ld) {
    constexpr int K = 4096, TP = 4112;
    LAS unsigned char* T = C.lds; LAS float* red = (LAS float*)(C.lds + 32 * TP); LAS float* cm = red + 64 * 32;
    const int tid = C.tid, quad = tid & 7, rsub = tid >> 3;
    for (int st = C.vcu; st < N / 32; st += C.G) { const int n0 = st * 32; const float* src = W + n0 + quad * 4;
        f32x4 mx = {0.f, 0.f, 0.f, 0.f};
#pragma unroll 1
        for (int b = 0; b < 2; ++b) { f32x4 v[32];
#pragma unroll
            for (int i = 0; i < 32; ++i) v[i] = *(const f32x4*)(src + (size_t)(rsub + 64 * (32 * b + i)) * ld);
#pragma unroll
            for (int i = 0; i < 32; ++i) { const float gk = gain[rsub + 64 * (32 * b + i)]; mx.x = fmaxf(mx.x, fabsf(v[i].x * gk)); mx.y = fmaxf(mx.y, fabsf(v[i].y * gk)); mx.z = fmaxf(mx.z, fabsf(v[i].z * gk)); mx.w = fmaxf(mx.w, fabsf(v[i].w * gk)); } }
        *(LAS f32x4*)(red + rsub * 32 + quad * 4) = mx;
        __syncthreads();
        if (tid < 32) { float m = 0.f;
#pragma unroll 8
            for (int r = 0; r < 64; ++r) m = fmaxf(m, red[r * 32 + tid]);
            cm[tid] = m; cmax[n0 + tid] = m; }
        __syncthreads();
        const f32x4 cq = *(const LAS f32x4*)(cm + quad * 4);
        const f32x4 sc = {cq.x > 0.f ? 127.0f / cq.x : 0.f, cq.y > 0.f ? 127.0f / cq.y : 0.f, cq.z > 0.f ? 127.0f / cq.z : 0.f, cq.w > 0.f ? 127.0f / cq.w : 0.f};
#pragma unroll 1
        for (int b = 0; b < 2; ++b) { f32x4 v[32];
#pragma unroll
            for (int i = 0; i < 32; ++i) v[i] = *(const f32x4*)(src + (size_t)(4 * (rsub + 64 * (8 * b + (i >> 2))) + (i & 3)) * ld);
#pragma unroll
            for (int j = 0; j < 8; ++j) { const int rb = rsub + 64 * (8 * b + j); unsigned w0 = 0u, w1 = 0u, w2 = 0u, w3 = 0u;
#pragma unroll
                for (int r = 0; r < 4; ++r) { const float gk = gain[4 * rb + r]; const f32x4 x = v[4 * j + r];
                    w0 |= ((unsigned)(int)__builtin_rintf(x.x * gk * sc.x) & 255u) << (8 * r); w1 |= ((unsigned)(int)__builtin_rintf(x.y * gk * sc.y) & 255u) << (8 * r);
                    w2 |= ((unsigned)(int)__builtin_rintf(x.z * gk * sc.z) & 255u) << (8 * r); w3 |= ((unsigned)(int)__builtin_rintf(x.w * gk * sc.w) & 255u) << (8 * r); }
                LAS unsigned char* tp = T + (quad * 4) * TP + 4 * rb;
                *(LAS unsigned*)(tp) = w0; *(LAS unsigned*)(tp + TP) = w1; *(LAS unsigned*)(tp + 2 * TP) = w2; *(LAS unsigned*)(tp + 3 * TP) = w3; } }
        __syncthreads();
        const int drow0 = UPMAP ? tr_row_up(n0) : n0;
#pragma unroll 4
        for (int j = 0; j < 16; ++j) { const int id = tid + 512 * j, col = id >> 8, ch = id & 255;
            __builtin_nontemporal_store(*(const LAS u32x4*)(T + col * TP + ch * 16), (u32x4*)(WQ + (size_t)(drow0 + col) * K + ch * 16)); }
        __syncthreads();
    }
}
constexpr int CW_QCNT = 65536;
template <bool UPMAP, int LD>
DEV void w_quant_half(const Ctx& C, const float* __restrict__ W, const float* __restrict__ gain, float* __restrict__ cmax, signed char* __restrict__ WQ, unsigned* cnt, int tt) {
    constexpr int K = 4096, KH = 2048, TP = 2064;
    LAS unsigned char* T = C.lds; LAS float* red = (LAS float*)(C.lds + 32 * TP); LAS float* cm = red + 64 * 32;
    const int tid = C.tid, quad = tid & 7, rsub = tid >> 3;
    const int st = tt >> 1, half = tt & 1, n0 = st * 32; const float* src = W + n0 + quad * 4;
    f32x4 v[32];
#pragma unroll
    for (int i = 0; i < 32; ++i) v[i] = __builtin_nontemporal_load((const f32x4*)(src + (size_t)(4 * (rsub + 64 * (8 * half + (i >> 2))) + (i & 3)) * LD));
    f32x4 mx = {0.f, 0.f, 0.f, 0.f};
#pragma unroll
    for (int j = 0; j < 8; ++j) { const f32x4 g4 = *(const f32x4*)(gain + 4 * (rsub + 64 * (8 * half + j)));
#pragma unroll
        for (int r = 0; r < 4; ++r) { f32x4 x = v[4 * j + r] * g4[r]; v[4 * j + r] = x;
            mx.x = fmaxf(mx.x, fabsf(x.x)); mx.y = fmaxf(mx.y, fabsf(x.y)); mx.z = fmaxf(mx.z, fabsf(x.z)); mx.w = fmaxf(mx.w, fabsf(x.w)); } }
    *(LAS f32x4*)(red + rsub * 32 + quad * 4) = mx;
    __syncthreads();
    if (tid < 64) {
        if (tid < 32) { float m = 0.f;
#pragma unroll 8
            for (int r = 0; r < 64; ++r) m = fmaxf(m, red[r * 32 + tid]);
            const unsigned old = __hip_atomic_fetch_max((unsigned*)cmax + n0 + tid, __builtin_bit_cast(unsigned, m), __ATOMIC_RELAXED, __HIP_MEMORY_SCOPE_AGENT);
            asm volatile("" :: "v"(old)); }
        asm volatile("s_waitcnt vmcnt(0)" ::: "memory");
        if (tid == 0) { (void)xb_add(cnt, 1u); unsigned sp = 0u;
            while (xb_ld(cnt) < 2u) { __builtin_amdgcn_s_sleep(1); if (++sp > (1u << 20)) break; } }
        asm volatile("" ::: "memory");
        if (tid < 32) cm[tid] = __builtin_bit_cast(float, xb_ld((unsigned*)cmax + n0 + tid));
    }
    __syncthreads();
    const f32x4 cq = *(const LAS f32x4*)(cm + quad * 4);
    const f32x4 sc = {cq.x > 0.f ? 127.0f / cq.x : 0.f, cq.y > 0.f ? 127.0f / cq.y : 0.f, cq.z > 0.f ? 127.0f / cq.z : 0.f, cq.w > 0.f ? 127.0f / cq.w : 0.f};
#pragma unroll
    for (int j = 0; j < 8; ++j) { const int rbl = rsub + 64 * j; unsigned w0 = 0u, w1 = 0u, w2 = 0u, w3 = 0u;
#pragma unroll
        for (int r = 0; r < 4; ++r) { const f32x4 x = v[4 * j + r];
            w0 |= ((unsigned)(int)__builtin_rintf(x.x * sc.x) & 255u) << (8 * r); w1 |= ((unsigned)(int)__builtin_rintf(x.y * sc.y) & 255u) << (8 * r);
            w2 |= ((unsigned)(int)__builtin_rintf(x.z * sc.z) & 255u) << (8 * r); w3 |= ((unsigned)(int)__builtin_rintf(x.w * sc.w) & 255u) << (8 * r); }
        LAS unsigned char* tp = T + (quad * 4) * TP + 4 * rbl;
        *(LAS unsigned*)(tp) = w0; *(LAS unsigned*)(tp + TP) = w1; *(LAS unsigned*)(tp + 2 * TP) = w2; *(LAS unsigned*)(tp + 3 * TP) = w3; }
    __syncthreads();
    const int drow0 = UPMAP ? tr_row_up(n0) : n0;
#pragma unroll 4
    for (int j = 0; j < 8; ++j) { const int id = tid + 512 * j, col = id >> 7, ch = id & 127;
        __builtin_nontemporal_store(*(const LAS u32x4*)(T + col * TP + ch * 16), (u32x4*)(WQ + (size_t)(drow0 + col) * K + half * KH + ch * 16)); }
    __syncthreads();
}
struct QTask { const float* W; const float* gain; float* cmax; signed char* WQ; unsigned* cnt; int ld, up, n0, part; };
DEV void q_load(f32x4 (&v)[16], const QTask& k, int quad, int rsub) {
    const float* src = k.W + k.n0 + quad * 4;
#pragma unroll
    for (int i = 0; i < 16; ++i) v[i] = __builtin_nontemporal_load((const f32x4*)(src + (size_t)(4 * (rsub + 64 * (4 * k.part + (i >> 2))) + (i & 3)) * k.ld));
}
DEV void w_quant_pipe(const Ctx& C, const float* Win, const float* gin, const float* Wup, const float* gup, float* CMAX, signed char* Qin, signed char* Qup0, signed char* Qup1, unsigned* cntb) {
    constexpr int K = 4096, KQ = 1024, TP = 1040, T_IN = NZI8 / 8, T_UP = NUP / 8, T_ALL = T_IN + 2 * T_UP;
    LAS unsigned char* T = C.lds; LAS float* red = (LAS float*)(C.lds + 32 * TP); LAS float* cm = red + 64 * 32;
    const int tid = C.tid, quad = tid & 7, rsub = tid >> 3;
    auto decode = [&](int t, QTask& k) {
        k.cnt = cntb + (t >> 2); k.part = t & 3;
        if (t < T_IN) { k.W = Win; k.gain = gin; k.cmax = CMAX + 2 * NUP; k.WQ = Qin; k.ld = NIN; k.up = 0; k.n0 = (t >> 2) * 32; }
        else { const int u = t - T_IN, L = u >= T_UP ? 1 : 0, tt = u - L * T_UP;
            k.W = Wup + (size_t)L * DM * NUP; k.gain = gup + L * DM; k.cmax = CMAX + L * NUP; k.WQ = L ? Qup1 : Qup0; k.ld = NUP; k.up = 1; k.n0 = (tt >> 2) * 32; } };
    int t = C.vcu; if (t >= T_ALL) return;
    QTask k; decode(t, k);
    f32x4 cur[16], nxt[16];
    q_load(cur, k, quad, rsub);
    for (;;) {
        f32x4 mx = {0.f, 0.f, 0.f, 0.f};
#pragma unroll
        for (int j = 0; j < 4; ++j) { const f32x4 g4 = *(const f32x4*)(k.gain + 4 * (rsub + 64 * (4 * k.part + j)));
#pragma unroll
            for (int r = 0; r < 4; ++r) { f32x4 x = cur[4 * j + r] * g4[r]; cur[4 * j + r] = x;
                mx.x = fmaxf(mx.x, fabsf(x.x)); mx.y = fmaxf(mx.y, fabsf(x.y)); mx.z = fmaxf(mx.z, fabsf(x.z)); mx.w = fmaxf(mx.w, fabsf(x.w)); } }
        *(LAS f32x4*)(red + rsub * 32 + quad * 4) = mx;
        __syncthreads();
        if (tid < 64) {
            if (tid < 32) { float m = 0.f;
#pragma unroll 8
                for (int r = 0; r < 64; ++r) m = fmaxf(m, red[r * 32 + tid]);
                const unsigned old = __hip_atomic_fetch_max((unsigned*)k.cmax + k.n0 + tid, __builtin_bit_cast(unsigned, m), __ATOMIC_RELAXED, __HIP_MEMORY_SCOPE_AGENT);
                asm volatile("" :: "v"(old)); }
            asm volatile("s_waitcnt vmcnt(0)" ::: "memory");
            if (tid == 0) (void)xb_add(k.cnt, 1u);
        }
        const int t2 = t + C.G; const bool has2 = t2 < T_ALL; QTask k2;
        if (has2) { decode(t2, k2); q_load(nxt, k2, quad, rsub); }
        if (tid < 64) {
            if (tid == 0) { unsigned sp = 0u; while (xb_ld(k.cnt) < 4u) { __builtin_amdgcn_s_sleep(1); if (++sp > (1u << 20)) break; } }
            asm volatile("" ::: "memory");
            if (tid < 32) cm[tid] = __builtin_bit_cast(float, xb_ld((unsigned*)k.cmax + k.n0 + tid));
        }
        __syncthreads();
        const f32x4 cq = *(const LAS f32x4*)(cm + quad * 4);
        const f32x4 sc = {cq.x > 0.f ? 127.0f / cq.x : 0.f, cq.y > 0.f ? 127.0f / cq.y : 0.f, cq.z > 0.f ? 127.0f / cq.z : 0.f, cq.w > 0.f ? 127.0f / cq.w : 0.f};
#pragma unroll
        for (int j = 0; j < 4; ++j) { const int rbl = rsub + 64 * j; unsigned w0 = 0u, w1 = 0u, w2 = 0u, w3 = 0u;
#pragma unroll
            for (int r = 0; r < 4; ++r) { const f32x4 x = cur[4 * j + r];
                w0 |= ((unsigned)(int)__builtin_rintf(x.x * sc.x) & 255u) << (8 * r); w1 |= ((unsigned)(int)__builtin_rintf(x.y * sc.y) & 255u) << (8 * r);
                w2 |= ((unsigned)(int)__builtin_rintf(x.z * sc.z) & 255u) << (8 * r); w3 |= ((unsigned)(int)__builtin_rintf(x.w * sc.w) & 255u) << (8 * r); }
            LAS unsigned char* tp = T + (quad * 4) * TP + 4 * rbl;
            *(LAS unsigned*)(tp) = w0; *(LAS unsigned*)(tp + TP) = w1; *(LAS unsigned*)(tp + 2 * TP) = w2; *(LAS unsigned*)(tp + 3 * TP) = w3; }
        __syncthreads();
        const int drow0 = k.up ? tr_row_up(k.n0) : k.n0;
#pragma unroll
        for (int j = 0; j < 4; ++j) { const int id = tid + 512 * j, col = id >> 6, ch = id & 63;
            __builtin_nontemporal_store(*(const LAS u32x4*)(T + col * TP + ch * 16), (u32x4*)(k.WQ + (size_t)(drow0 + col) * K + k.part * KQ + ch * 16)); }
        __syncthreads();
        if (!has2) break;
#pragma unroll
        for (int i = 0; i < 16; ++i) cur[i] = nxt[i];
        k = k2; t = t2;
    }
}
template <int SC>
DEV void w_quant_wide(const Ctx& C, const float* Win, const float* gin, const float* Wup, const float* gup, float* CMAX, signed char* Qin, signed char* Qup0, signed char* Qup1, unsigned* cntb) {
    constexpr int K = 4096, QN = SC / 4, RP = 2048 / SC, KB = 65536 / SC, P = SC / 16, TP = KB + 16, NCH = KB / 16;
    constexpr int T_IN = (NZI8 / SC) * P, T_UP = (NUP / SC) * P, T_ALL = T_IN + 2 * T_UP;
    LAS unsigned char* T = C.lds; LAS float* red = (LAS float*)(C.lds + SC * TP); LAS float* cm = red + RP * SC;
    const int tid = C.tid, quad = tid % QN, rsub = tid / QN;
    for (int t = C.vcu; t < T_ALL; t += C.G) {
        const float* W; const float* gain; float* cmax; signed char* WQ; int ld, up, tt;
        if (t < T_IN) { W = Win; gain = gin; cmax = CMAX + 2 * NUP; WQ = Qin; ld = NIN; up = 0; tt = t; }
        else { const int u = t - T_IN, L = u >= T_UP ? 1 : 0; tt = u - L * T_UP; W = Wup + (size_t)L * DM * NUP; gain = gup + L * DM; cmax = CMAX + L * NUP; WQ = L ? Qup1 : Qup0; ld = NUP; up = 1; }
        const int n0 = (tt / P) * SC, part = tt % P; unsigned* cnt = cntb + t / P;
        const float* src = W + (size_t)(part * KB) * ld + n0 + quad * 4;
        f32x4 v[32];
#pragma unroll
        for (int i = 0; i < 32; ++i) v[i] = __builtin_nontemporal_load((const f32x4*)(src + (size_t)(4 * (rsub + RP * (i >> 2)) + (i & 3)) * ld));
        f32x4 mx = {0.f, 0.f, 0.f, 0.f};
#pragma unroll
        for (int j = 0; j < 8; ++j) { const f32x4 g4 = *(const f32x4*)(gain + part * KB + 4 * (rsub + RP * j));
#pragma unroll
            for (int r = 0; r < 4; ++r) { f32x4 x = v[4 * j + r] * g4[r]; v[4 * j + r] = x;
                mx.x = fmaxf(mx.x, fabsf(x.x)); mx.y = fmaxf(mx.y, fabsf(x.y)); mx.z = fmaxf(mx.z, fabsf(x.z)); mx.w = fmaxf(mx.w, fabsf(x.w)); } }
        *(LAS f32x4*)(red + rsub * SC + quad * 4) = mx;
        __syncthreads();
        if (tid < SC) { float m = 0.f;
#pragma unroll
            for (int r = 0; r < RP; ++r) m = fmaxf(m, red[r * SC + tid]);
            const unsigned old = __hip_atomic_fetch_max((unsigned*)cmax + n0 + tid, __builtin_bit_cast(unsigned, m), __ATOMIC_RELAXED, __HIP_MEMORY_SCOPE_AGENT);
            asm volatile("" :: "v"(old));
            asm volatile("s_waitcnt vmcnt(0)" ::: "memory"); }
        __syncthreads();
        if (tid == 0) { (void)xb_add(cnt, 1u); unsigned sp = 0u; while (xb_ld(cnt) < (unsigned)P) { __builtin_amdgcn_s_sleep(1); if (++sp > (1u << 20)) break; } }
        __syncthreads();
        if (tid < SC) cm[tid] = __builtin_bit_cast(float, xb_ld((unsigned*)cmax + n0 + tid));
        __syncthreads();
        const f32x4 cq = *(const LAS f32x4*)(cm + quad * 4);
        const f32x4 sc = {cq.x > 0.f ? 127.0f / cq.x : 0.f, cq.y > 0.f ? 127.0f / cq.y : 0.f, cq.z > 0.f ? 127.0f / cq.z : 0.f, cq.w > 0.f ? 127.0f / cq.w : 0.f};
#pragma unroll
        for (int j = 0; j < 8; ++j) { const int rbl = rsub + RP * j; unsigned w0 = 0u, w1 = 0u, w2 = 0u, w3 = 0u;
#pragma unroll
            for (int r = 0; r < 4; ++r) { const f32x4 x = v[4 * j + r];
                w0 |= ((unsigned)(int)__builtin_rintf(x.x * sc.x) & 255u) << (8 * r); w1 |= ((unsigned)(int)__builtin_rintf(x.y * sc.y) & 255u) << (8 * r);
                w2 |= ((unsigned)(int)__builtin_rintf(x.z * sc.z) & 255u) << (8 * r); w3 |= ((unsigned)(int)__builtin_rintf(x.w * sc.w) & 255u) << (8 * r); }
            LAS unsigned char* tp = T + (quad * 4) * TP + 16 * ((rbl >> 2) ^ (quad & 7)) + 4 * (rbl & 3);
            *(LAS unsigned*)(tp) = w0; *(LAS unsigned*)(tp + TP) = w1; *(LAS unsigned*)(tp + 2 * TP) = w2; *(LAS unsigned*)(tp + 3 * TP) = w3; }
        __syncthreads();
#pragma unroll 4
        for (int j = 0; j < 8; ++j) { const int id = tid + 512 * j, col = id / NCH, ch = id % NCH; const int nc = n0 + col, drow = up ? tr_row_up(nc) : nc;
            __builtin_nontemporal_store(*(const LAS u32x4*)(T + col * TP + 16 * (ch ^ ((col >> 2) & 7))), (u32x4*)(WQ + (size_t)drow * K + part * KB + ch * 16)); }
        __syncthreads();
    }
}
DEV void ffn_fixup(const Ctx& C, const float* __restrict__ HALO, bf16* __restrict__ ACT, const float* __restrict__ cw, const float* __restrict__ cb) {
    const int gtid = C.vcu * (NWAVES * 64) + C.tid, nthr = C.G * NWAVES * 64;
    constexpr int NCC = DFF / 4, NT = (SEQ / 256) * NCC;
    for (int it = gtid; it < NT; it += nthr) { const int pm = it / NCC, c0 = (it - pm * NCC) * 4;
        f32x4 r[2][4];
#pragma unroll
        for (int bj = 0; bj < 2; ++bj) {
            r[bj][0] = pm ? *(const f32x4*)(HALO + (size_t)((pm - 1) * 4 + 2) * NUP + bj * DFF + c0) : (f32x4){0.f, 0.f, 0.f, 0.f};
            r[bj][1] = pm ? *(const f32x4*)(HALO + (size_t)((pm - 1) * 4 + 3) * NUP + bj * DFF + c0) : (f32x4){0.f, 0.f, 0.f, 0.f};
            r[bj][2] = *(const f32x4*)(HALO + (size_t)(pm * 4 + 0) * NUP + bj * DFF + c0);
            r[bj][3] = *(const f32x4*)(HALO + (size_t)(pm * 4 + 1) * NUP + bj * DFF + c0); }
        f32x4 w[2][3], b[2];
#pragma unroll
        for (int bj = 0; bj < 2; ++bj) {
#pragma unroll
            for (int k = 0; k < 3; ++k) w[bj][k] = *(const f32x4*)(cw + (size_t)k * NUP + bj * DFF + c0);
            b[bj] = *(const f32x4*)(cb + bj * DFF + c0); }
#pragma unroll
        for (int rr = 0; rr < 2; ++rr) {
            const f32x4 G = b[0] + w[0][0] * r[0][rr] + w[0][1] * r[0][rr + 1] + w[0][2] * r[0][rr + 2];
            const f32x4 V = b[1] + w[1][0] * r[1][rr] + w[1][1] * r[1][rr + 1] + w[1][2] * r[1][rr + 2];
            u32x2 o; o.x = pk2(silu_f(G.x) * V.x, silu_f(G.y) * V.y); o.y = pk2(silu_f(G.z) * V.z, silu_f(G.w) * V.w);
            *(u32x2*)(ACT + (size_t)(pm * 256 + rr) * DFF + c0) = o; }
    }
}

DEV float wave_max(float v) {
#pragma unroll
    for (int o = 1; o < 64; o <<= 1) v = fmaxf(v, __shfl_xor(v, o));
    return v;
}
template <bool HOLD_F32, bool OUT_F32, bool Q8 = false>
DEV void thin_row(const bf16* mixrow, const void* holdv, void* hnewv, const float* gpost, float* rs, int lane, signed char* a8row = nullptr, float* rsq = nullptr) {
    float v[8][8];
    float ss = 0.f;
#pragma unroll
    for (int j = 0; j < 8; ++j) { const u32x4 m = *(const u32x4*)(mixrow + (j * 64 + lane) * 8); unpack8(m, v[j]);
#pragma unroll
        for (int e = 0; e < 8; ++e) ss += v[j][e] * v[j][e]; }
    const float rstd = 1.0f / sqrtf(wave_sum(ss) * (1.0f / DM) + EPS);
    float ss2 = 0.f;
#pragma unroll
    for (int j = 0; j < 8; ++j) { const int c0 = (j * 64 + lane) * 8; float h[8];
        if (HOLD_F32) { const f32x4 h0 = *(const f32x4*)((const float*)holdv + c0), h1 = *(const f32x4*)((const float*)holdv + c0 + 4); h[0] = h0.x; h[1] = h0.y; h[2] = h0.z; h[3] = h0.w; h[4] = h1.x; h[5] = h1.y; h[6] = h1.z; h[7] = h1.w; }
        else unpack8(*(const u32x4*)((const bf16*)holdv + c0), h);
        const f32x4 g0 = *(const f32x4*)(gpost + c0), g1 = *(const f32x4*)(gpost + c0 + 4); const float g[8] = {g0.x, g0.y, g0.z, g0.w, g1.x, g1.y, g1.z, g1.w};
#pragma unroll
        for (int e = 0; e < 8; ++e) v[j][e] = h[e] + v[j][e] * rstd * g[e];
        if (OUT_F32) { *(f32x4*)((float*)hnewv + c0) = (f32x4){v[j][0], v[j][1], v[j][2], v[j][3]}; *(f32x4*)((float*)hnewv + c0 + 4) = (f32x4){v[j][4], v[j][5], v[j][6], v[j][7]}; }
        else { const u32x4 w = pack8(v[j]); *(u32x4*)((bf16*)hnewv + c0) = w; float r[8]; unpack8(w, r);
#pragma unroll
            for (int e = 0; e < 8; ++e) ss2 += r[e] * r[e]; } }
    if (!OUT_F32) { const float rstd2 = 1.0f / sqrtf(wave_sum(ss2) * (1.0f / DM) + EPS); if (lane == 0) *rs = rstd2;
        if constexpr (Q8) {
            float am = 0.f;
#pragma unroll
            for (int j = 0; j < 8; ++j)
#pragma unroll
                for (int e = 0; e < 8; ++e) am = fmaxf(am, fabsf(v[j][e]));
            am = fmaxf(wave_max(am), 1e-30f); const float sq = 127.0f / am;
#pragma unroll
            for (int j = 0; j < 8; ++j) { unsigned lo = 0u, hi = 0u;
#pragma unroll
                for (int e = 0; e < 4; ++e) { lo |= ((unsigned)(int)__builtin_rintf(v[j][e] * sq) & 255u) << (8 * e); hi |= ((unsigned)(int)__builtin_rintf(v[j][4 + e] * sq) & 255u) << (8 * e); }
                u32x2 w; w.x = lo; w.y = hi; *(u32x2*)(a8row + (j * 64 + lane) * 8) = w; }
            if (lane == 0) *rsq = rstd2 * am * (1.0f / 127.0f); } }
}
template <bool HOLD_F32, bool OUT_F32, bool Q8 = false>
DEV void thin_phase(const Ctx& C, const bf16* mix, const void* hold, void* hnew, const float* gpost, float* RS, signed char* A8 = nullptr, float* RSQ = nullptr) {
    const int gw = C.vcu * NWAVES + C.wave, NGW = C.G * NWAVES;
    for (int r = gw; r < SEQ; r += NGW) thin_row<HOLD_F32, OUT_F32, Q8>(mix + (size_t)r * DM, (const char*)hold + (size_t)r * DM * (HOLD_F32 ? 4 : 2), (char*)hnew + (size_t)r * DM * (OUT_F32 ? 4 : 2), gpost, RS + r, C.lane,
                                                                          Q8 ? A8 + (size_t)r * DM : nullptr, Q8 ? RSQ + r : nullptr);
}
DEV void xnorm_phase(const Ctx& C, const float* xin, bf16* abuf, signed char* a8, float* rsq) {
    const int gw = C.vcu * NWAVES + C.wave, NGW = C.G * NWAVES;
    for (int r = gw; r < SEQ; r += NGW) { const float* xr = xin + (size_t)r * DM; bf16* ar = abuf + (size_t)r * DM; float v[8][8]; float ss = 0.f, am = 0.f;
#pragma unroll
        for (int j = 0; j < 8; ++j) { const int c0 = (j * 64 + C.lane) * 8; const f32x4 h0 = *(const f32x4*)(xr + c0), h1 = *(const f32x4*)(xr + c0 + 4);
            v[j][0] = h0.x; v[j][1] = h0.y; v[j][2] = h0.z; v[j][3] = h0.w; v[j][4] = h1.x; v[j][5] = h1.y; v[j][6] = h1.z; v[j][7] = h1.w;
#pragma unroll
            for (int e = 0; e < 8; ++e) { ss += v[j][e] * v[j][e]; am = fmaxf(am, fabsf(v[j][e])); } }
        const float rstd = 1.0f / sqrtf(wave_sum(ss) * (1.0f / DM) + EPS);
        am = fmaxf(wave_max(am), 1e-30f); const float sq = 127.0f / am;
#pragma unroll
        for (int j = 0; j < 8; ++j) { float o[8]; unsigned lo = 0u, hi = 0u;
#pragma unroll
            for (int e = 0; e < 8; ++e) o[e] = v[j][e] * rstd;
            *(u32x4*)(ar + (j * 64 + C.lane) * 8) = pack8(o);
#pragma unroll
            for (int e = 0; e < 4; ++e) { lo |= ((unsigned)(int)__builtin_rintf(v[j][e] * sq) & 255u) << (8 * e); hi |= ((unsigned)(int)__builtin_rintf(v[j][4 + e] * sq) & 255u) << (8 * e); }
            u32x2 w; w.x = lo; w.y = hi; *(u32x2*)(a8 + (size_t)r * DM + (j * 64 + C.lane) * 8) = w; }
        if (C.lane == 0) rsq[r] = rstd * am * (1.0f / 127.0f); }
}

DEV void dt_gemm(const Ctx& C, const bf16* __restrict__ A, const bf16* __restrict__ Bt, float* __restrict__ out) {
    const int r16 = C.lane & 15, kq = C.lane >> 4; LAS float* part = (LAS float*)C.lds;
    for (int rb = C.vcu; rb < SEQ / 32; rb += C.G) {
        const bf16* a0 = A + (size_t)(rb * 32 + r16) * DM + C.wave * 512 + kq * 8; const bf16* a1 = a0 + (size_t)16 * DM;
        const bf16* b0 = Bt + (size_t)r16 * DM + C.wave * 512 + kq * 8;
        f32x4 acc[2][8];
#pragma unroll
        for (int m = 0; m < 2; ++m)
#pragma unroll
            for (int n = 0; n < 8; ++n) acc[m][n] = (f32x4){0.f, 0.f, 0.f, 0.f};
#pragma unroll 2
        for (int ks = 0; ks < 16; ++ks) {
            const bf16x8 fa0 = *(const bf16x8*)(a0 + ks * 32), fa1 = *(const bf16x8*)(a1 + ks * 32); bf16x8 fb[8];
#pragma unroll
            for (int n = 0; n < 8; ++n) fb[n] = *(const bf16x8*)(b0 + (size_t)(16 * n) * DM + ks * 32);
#pragma unroll
            for (int n = 0; n < 8; ++n) { acc[0][n] = __builtin_amdgcn_mfma_f32_16x16x32_bf16(fa0, fb[n], acc[0][n], 0, 0, 0); acc[1][n] = __builtin_amdgcn_mfma_f32_16x16x32_bf16(fa1, fb[n], acc[1][n], 0, 0, 0); }
        }
#pragma unroll
        for (int m = 0; m < 2; ++m)
#pragma unroll
            for (int n = 0; n < 8; ++n)
#pragma unroll
                for (int r = 0; r < 4; ++r) part[(C.wave * 32 + m * 16 + kq * 4 + r) * 128 + n * 16 + r16] = acc[m][n][r];
        __syncthreads();
#pragma unroll
        for (int i = 0; i < 2; ++i) { const int e = (C.tid + 512 * i) * 4;
            f32x4 sum = *(const LAS f32x4*)(part + e);
#pragma unroll
            for (int w = 1; w < 8; ++w) sum += *(const LAS f32x4*)(part + w * 4096 + e);
            *(f32x4*)(out + (size_t)rb * 32 * 128 + e) = sum; }
        __syncthreads();
    }
}

DEV void ssd_prep(const Ctx& C, const float* __restrict__ dtraw, const float* __restrict__ dtbias, const float* __restrict__ alog, float* __restrict__ DT, float* __restrict__ ACUM) {
    LAS float* segsum = (LAS float*)C.lds;
    for (int c = C.vcu; c < NCHUNK; c += C.G) {
        const int h = C.tid & 127, seg = C.tid >> 7; const float bias = dtbias[h], Aneg = -__expf(alog[h]);
        const size_t o0 = (size_t)(c * CHUNK + seg * 32) * NHEAD + h;
        float xr[32];
#pragma unroll
        for (int i = 0; i < 32; ++i) xr[i] = dtraw[o0 + (size_t)i * NHEAD];
        float run = 0.f;
#pragma unroll
        for (int i = 0; i < 32; ++i) { const float xx = xr[i] + bias; const float dt = fmaxf(xx, 0.f) + log1pf(__expf(-fabsf(xx))); DT[o0 + (size_t)i * NHEAD] = dt; run += dt * Aneg; xr[i] = run; }
        segsum[seg * 128 + h] = run;
        __syncthreads();
        float pre = 0.f;
#pragma unroll
        for (int k = 0; k < 3; ++k) pre += (k < seg) ? segsum[k * 128 + h] : 0.f;
#pragma unroll
        for (int i = 0; i < 32; ++i) ACUM[o0 + (size_t)i * NHEAD] = xr[i] + pre;
        __syncthreads();
    }
}

#define MFMA32(a, b, c) __builtin_amdgcn_mfma_f32_32x32x16_bf16((a), (b), (c), 0, 0, 0)
constexpr int LROW = 272;
DEV void transpose8x8(const u32x4 (&r)[8], u32x4 (&o)[8]) {
#pragma unroll
    for (int c2 = 0; c2 < 4; ++c2) {
        const unsigned a0 = r[0][c2], a1 = r[1][c2], a2 = r[2][c2], a3 = r[3][c2], a4 = r[4][c2], a5 = r[5][c2], a6 = r[6][c2], a7 = r[7][c2];
        o[2 * c2].x = __builtin_amdgcn_perm(a1, a0, 0x05040100u); o[2 * c2].y = __builtin_amdgcn_perm(a3, a2, 0x05040100u); o[2 * c2].z = __builtin_amdgcn_perm(a5, a4, 0x05040100u); o[2 * c2].w = __builtin_amdgcn_perm(a7, a6, 0x05040100u);
        o[2 * c2 + 1].x = __builtin_amdgcn_perm(a1, a0, 0x07060302u); o[2 * c2 + 1].y = __builtin_amdgcn_perm(a3, a2, 0x07060302u); o[2 * c2 + 1].z = __builtin_amdgcn_perm(a5, a4, 0x07060302u); o[2 * c2 + 1].w = __builtin_amdgcn_perm(a7, a6, 0x07060302u); }
}
DEV void conv8x8(const bf16* __restrict__ ZX, size_t t0, int ch0, const float* __restrict__ cw, const float* __restrict__ cb, u32x4 (&r)[8]) {
    const bf16* src = ZX + DINNER + ch0;
    u32x4 raw[11];
#pragma unroll
    for (int k = 0; k < 3; ++k) raw[k] = t0 ? *(const u32x4*)(src + (t0 - 3 + k) * NZX) : (u32x4){0u, 0u, 0u, 0u};
#pragma unroll
    for (int k = 0; k < 8; ++k) raw[3 + k] = *(const u32x4*)(src + (t0 + k) * NZX);
    float w[4][8], b[8];
#pragma unroll
    for (int k = 0; k < 4; ++k) { const f32x4 a = *(const f32x4*)(cw + k * CONVD + ch0), bq = *(const f32x4*)(cw + k * CONVD + ch0 + 4); w[k][0] = a.x; w[k][1] = a.y; w[k][2] = a.z; w[k][3] = a.w; w[k][4] = bq.x; w[k][5] = bq.y; w[k][6] = bq.z; w[k][7] = bq.w; }
    { const f32x4 a = *(const f32x4*)(cb + ch0), bq = *(const f32x4*)(cb + ch0 + 4); b[0] = a.x; b[1] = a.y; b[2] = a.z; b[3] = a.w; b[4] = bq.x; b[5] = bq.y; b[6] = bq.z; b[7] = bq.w; }
    float x3[8], x2[8], x1[8]; unpack8(raw[0], x3); unpack8(raw[1], x2); unpack8(raw[2], x1);
#pragma unroll
    for (int k = 0; k < 8; ++k) { float x0[8], o[8]; unpack8(raw[3 + k], x0);
#pragma unroll
        for (int e = 0; e < 8; ++e) { o[e] = silu_f(b[e] + w[0][e] * x3[e] + w[1][e] * x2[e] + w[2][e] * x1[e] + w[3][e] * x0[e]); x3[e] = x2[e]; x2[e] = x1[e]; x1[e] = x0[e]; }
        r[k] = pack8(o); }
}
DEV void ssd_states_unit(const Ctx& C, int c, int g, const bf16* __restrict__ ZX, const float* __restrict__ cw, const float* __restrict__ cb, const float* __restrict__ DT, const float* __restrict__ ACUM, bf16* __restrict__ S) {
    LAS unsigned char* BT = C.lds; LAS unsigned char* XW = C.lds + 34816; LAS float* wtab = (LAS float*)(C.lds + 104448);
    const int tid = C.tid, lane = C.lane, wave = C.wave, hh = lane >> 5, l31 = lane & 31;
    const size_t row0 = (size_t)c * CHUNK;
    for (int idx = tid; idx < 2048; idx += 512) { const int r = idx & 15, s = idx >> 4, h = g * HPG + r;
        const float alast = ACUM[(row0 + 127) * NHEAD + h]; const size_t o = (row0 + s) * NHEAD + h;
        wtab[r * 128 + s] = DT[o] * __expf(alast - ACUM[o]); }
    if (tid < 256) {
        const int so = tid & 15, oct = tid >> 4;
        u32x4 r[8], o[8];
        conv8x8(ZX, row0 + so * 8, DINNER + g * DSTATE + oct * 8, cw, cb, r);
        transpose8x8(r, o);
#pragma unroll
        for (int cc = 0; cc < 8; ++cc) *(LAS u32x4*)(BT + (oct * 8 + cc) * LROW + so * 16) = o[cc]; }
    __syncthreads();
    for (int q = 0; q < 4; ++q) {
        {
            const int so = tid & 15, oct = tid >> 4, r = 4 * q + (oct >> 3);
            u32x4 rr[8], o[8];
            conv8x8(ZX, row0 + so * 8, g * 1024 + q * 256 + oct * 8, cw, cb, rr);
            const f32x4 w0 = *(const LAS f32x4*)(wtab + r * 128 + so * 8), w1 = *(const LAS f32x4*)(wtab + r * 128 + so * 8 + 4);
            transpose8x8(rr, o);
#pragma unroll
            for (int cc = 0; cc < 8; ++cc) { float f[8]; unpack8(o[cc], f);
                u32x4 w; w.x = pk2(f[0] * w0.x, f[1] * w0.y); w.y = pk2(f[2] * w0.z, f[3] * w0.w); w.z = pk2(f[4] * w1.x, f[5] * w1.y); w.w = pk2(f[6] * w1.z, f[7] * w1.w);
                *(LAS u32x4*)(XW + (oct * 8 + cc) * LROW + so * 16) = w; } }
        __syncthreads();
        const int rq = wave >> 1, ph = wave & 1;
        f32x16 acc[4];
#pragma unroll
        for (int nt = 0; nt < 4; ++nt)
#pragma unroll
            for (int e = 0; e < 16; ++e) acc[nt][e] = 0.f;
        const LAS unsigned char* xrow = XW + (rq * 64 + ph * 32 + l31) * LROW + hh * 16;
        const LAS unsigned char* brow = BT + l31 * LROW + hh * 16;
#pragma unroll
        for (int ks = 0; ks < 8; ++ks) { const bf16x8 xb = *(const LAS bf16x8*)(xrow + ks * 32);
#pragma unroll
            for (int nt = 0; nt < 4; ++nt) { const bf16x8 a = *(const LAS bf16x8*)(brow + nt * 32 * LROW + ks * 32); acc[nt] = MFMA32(a, xb, acc[nt]); } }
        const int h = g * HPG + 4 * q + rq;
        bf16* dst = S + ((((size_t)c * NHEAD + h) * 2 + ph) * 8) * 512 + lane * 8;
#pragma unroll
        for (int nt = 0; nt < 4; ++nt)
#pragma unroll
            for (int s2 = 0; s2 < 2; ++s2) { u32x4 w; w.x = pk2(acc[nt][8 * s2 + 0], acc[nt][8 * s2 + 1]); w.y = pk2(acc[nt][8 * s2 + 2], acc[nt][8 * s2 + 3]); w.z = pk2(acc[nt][8 * s2 + 4], acc[nt][8 * s2 + 5]); w.w = pk2(acc[nt][8 * s2 + 6], acc[nt][8 * s2 + 7]);
                *(u32x4*)(dst + (2 * nt + s2) * 512) = w; }
        __syncthreads();
    }
}
DEV void ssd_scan(const Ctx& C, const bf16* __restrict__ S, const float* __restrict__ ACUM, bf16* __restrict__ ST) {
    const int gtid = C.vcu * (NWAVES * 64) + C.tid, nthr = C.G * NWAVES * 64;
    constexpr size_t CSTRIDE = (size_t)NHEAD * HDIM * DSTATE;
    for (int idx = gtid; idx < NHEAD * HDIM * DSTATE / 8; idx += nthr) {
        const int h = idx >> 10; const size_t base = (size_t)idx * 8;
        float run[8];
#pragma unroll
        for (int e = 0; e < 8; ++e) run[e] = 0.f;
#pragma unroll 1
        for (int cb = 0; cb < NCHUNK; cb += 16) { u32x4 raw[16]; float dec[16];
#pragma unroll
            for (int k = 0; k < 16; ++k) { raw[k] = __builtin_nontemporal_load((const u32x4*)(S + (cb + k) * CSTRIDE + base)); dec[k] = ACUM[((size_t)(cb + k) * CHUNK + 127) * NHEAD + h]; }
#pragma unroll
            for (int k = 0; k < 16; ++k) { float sv[8]; unpack8(raw[k], sv); const float d = __expf(dec[k]);
                *(u32x4*)(ST + (cb + k) * CSTRIDE + base) = pack8(run);
#pragma unroll
                for (int e = 0; e < 8; ++e) run[e] = run[e] * d + sv[e]; } }
    }
}
DEV void ssd_groupnorm_g(bf16* Y, size_t r0, int g, int wave, int lane) {
    for (int rr = wave; rr < CHUNK; rr += NWAVES) { bf16* p = Y + (r0 + rr) * DINNER + g * 1024 + lane * 16;
        float a[8], b[8]; unpack8(*(const u32x4*)p, a); unpack8(*(const u32x4*)(p + 8), b); float ss = 0.f;
#pragma unroll
        for (int e = 0; e < 8; ++e) ss += a[e] * a[e] + b[e] * b[e];
        const float rstd = 1.0f / sqrtf(wave_sum(ss) * (1.0f / 1024.0f) + SSM_EPS);
#pragma unroll
        for (int e = 0; e < 8; ++e) { a[e] *= rstd; b[e] *= rstd; }
        *(u32x4*)p = pack8(a); *(u32x4*)(p + 8) = pack8(b); }
}
constexpr int YROW = 528;
DEV void ssd_out_unit(const Ctx& C, int c, int g, const float* __restrict__ cw, const float* __restrict__ cb, const bf16* __restrict__ ZX, const float* __restrict__ DT, const float* __restrict__ ACUM,
                      const bf16* __restrict__ ST, const float* __restrict__ dskip, bf16* __restrict__ Y) {
    LAS unsigned char* CM = C.lds; LAS unsigned char* BM = C.lds + 34816; LAS unsigned char* XT = C.lds + 69632;
    LAS float* atab = (LAS float*)(C.lds + 139264); LAS float* dtab = (LAS float*)(C.lds + 147456); LAS float* ttab = (LAS float*)(C.lds + 155648);
    const int tid0 = C.tid, lane = C.lane, wave = C.wave, hh = lane >> 5, l31 = lane & 31;
    const size_t row0 = (size_t)c * CHUNK;
    { const int tid = tid0;
    {
        const int isc = tid >> 8, so = tid & 15, oct = (tid >> 4) & 15; u32x4 r[8];
        conv8x8(ZX, row0 + so * 8, DINNER + isc * NGRP * DSTATE + g * DSTATE + oct * 8, cw, cb, r);
        LAS unsigned char* dstm = isc ? CM : BM;
#pragma unroll
        for (int j = 0; j < 8; ++j) *(LAS u32x4*)(dstm + (so * 8 + j) * LROW + oct * 16) = r[j]; }
    for (int idx = tid; idx < 2048; idx += 512) { const int r = idx & 15, s = idx >> 4; const size_t o = (row0 + s) * NHEAD + g * HPG + r; atab[r * 128 + s] = ACUM[o]; dtab[r * 128 + s] = DT[o]; } }
    __syncthreads();
    {
        const int lt = wave >> 1, st0 = 2 * (wave & 1);
        f32x16 cb[2];
#pragma unroll
        for (int t = 0; t < 2; ++t)
#pragma unroll
            for (int e = 0; e < 16; ++e) cb[t][e] = 0.f;
        const LAS unsigned char* arow = CM + (lt * 32 + l31) * LROW + hh * 16;
        const LAS unsigned char* brow = BM + (st0 * 32 + l31) * LROW + hh * 16;
#pragma unroll
        for (int ks = 0; ks < 8; ++ks) { const bf16x8 a = *(const LAS bf16x8*)(arow + ks * 32);
#pragma unroll
            for (int t = 0; t < 2; ++t) { const bf16x8 b = *(const LAS bf16x8*)(brow + t * 32 * LROW + ks * 32); cb[t] = MFMA32(a, b, cb[t]); } }
        __syncthreads();
#pragma unroll
        for (int t = 0; t < 2; ++t)
#pragma unroll
            for (int e = 0; e < 16; ++e) { const int l = lt * 32 + (e & 3) + 8 * (e >> 2) + 4 * hh, s = (st0 + t) * 32 + l31;
                *(LAS unsigned short*)(BM + l * LROW + s * 2) = f2bf(cb[t][e]); }
    }
    __syncthreads();
    float ssq[8];
#pragma unroll
    for (int i = 0; i < 8; ++i) ssq[i] = 0.f;
    for (int q = 0; q < 4; ++q) {
        int tid = tid0; asm volatile("" : "+v"(tid));
        const int ch = tid & 31, lrow = tid >> 5;
        const int rq = wave >> 1, r = 4 * q + rq, h = g * HPG + r; const float Dk = dskip[h];
        const bf16* stp = ST + (((size_t)c * NHEAD + h) * 2 * 8) * 512 + lane * 8;
        bf16x8 sb[8][2];
        {
            const int so = tid & 15, oct = tid >> 4;
            u32x4 rr[8], o[8];
            conv8x8(ZX, row0 + so * 8, g * 1024 + q * 256 + oct * 8, cw, cb, rr);
            transpose8x8(rr, o);
#pragma unroll
            for (int cc = 0; cc < 8; ++cc) *(LAS u32x4*)(XT + (oct * 8 + cc) * LROW + so * 16) = o[cc]; }
#ifdef P4_FACT
        { const int rl = tid >> 7, s_ = tid & 127, rr_ = (4 * q + rl) * 128;
          ttab[rl * 128 + s_] = __expf(atab[rr_ + (s_ | 7)] - atab[rr_ + s_]) * dtab[rr_ + s_]; }
#endif
        asm volatile("" ::: "memory");
#pragma unroll
        for (int ks = 0; ks < 8; ++ks) { sb[ks][0] = *(const bf16x8*)(stp + ks * 512); sb[ks][1] = *(const bf16x8*)(stp + (8 + ks) * 512); }
        __syncthreads();
        const int lt0 = (wave & 1) ? 1 : 0, lt1 = (wave & 1) ? 2 : 3;
        const int l0 = lt0 * 32 + l31, l1 = lt1 * 32 + l31;
        const float al0 = atab[r * 128 + l0], al1 = atab[r * 128 + l1]; const float eal0 = __expf(al0), eal1 = __expf(al1);
        f32x16 acc[2][2];
#pragma unroll
        for (int li = 0; li < 2; ++li)
#pragma unroll
            for (int pt = 0; pt < 2; ++pt)
#pragma unroll
                for (int e = 0; e < 16; ++e) acc[li][pt][e] = 0.f;
#pragma unroll
        for (int ks = 0; ks < 8; ++ks) {
            const bf16x8 b0 = sb[ks][0], b1 = sb[ks][1];
            float f[8]; { const u32x2 c0 = *(const LAS u32x2*)(CM + l0 * LROW + ks * 32 + hh * 8), c1 = *(const LAS u32x2*)(CM + l0 * LROW + ks * 32 + 16 + hh * 8); u32x4 cw; cw.x = c0.x; cw.y = c0.y; cw.z = c1.x; cw.w = c1.y; unpack8(cw, f); }
#pragma unroll
            for (int j = 0; j < 8; ++j) f[j] *= eal0;
            const bf16x8 a0 = __builtin_bit_cast(bf16x8, pack8(f));
            { const u32x2 c0 = *(const LAS u32x2*)(CM + l1 * LROW + ks * 32 + hh * 8), c1 = *(const LAS u32x2*)(CM + l1 * LROW + ks * 32 + 16 + hh * 8); u32x4 cw; cw.x = c0.x; cw.y = c0.y; cw.z = c1.x; cw.w = c1.y; unpack8(cw, f); }
#pragma unroll
            for (int j = 0; j < 8; ++j) f[j] *= eal1;
            const bf16x8 a1 = __builtin_bit_cast(bf16x8, pack8(f));
            acc[0][0] = MFMA32(a0, b0, acc[0][0]); acc[0][1] = MFMA32(a0, b1, acc[0][1]); acc[1][0] = MFMA32(a1, b0, acc[1][0]); acc[1][1] = MFMA32(a1, b1, acc[1][1]); }
#ifdef P4_FACT
        for (int ks = 0; ks < 2 * lt1 + 2; ++ks) { const int s0 = ks * 16 + hh * 8;
            const bf16x8 b0 = *(const LAS bf16x8*)(XT + (rq * 64 + l31) * LROW + s0 * 2), b1 = *(const LAS bf16x8*)(XT + (rq * 64 + 32 + l31) * LROW + s0 * 2);
            float f[8];
            if (ks < 2 * lt1) {
                const f32x4 t0 = *(const LAS f32x4*)(ttab + rq * 128 + s0), t1 = *(const LAS f32x4*)(ttab + rq * 128 + s0 + 4); const float aref = atab[r * 128 + s0 + 7];
                const float tt[8] = {t0.x, t0.y, t0.z, t0.w, t1.x, t1.y, t1.z, t1.w};
                const float E1 = __expf(al1 - aref);
                unpack8(*(const LAS u32x4*)(BM + l1 * LROW + s0 * 2), f);
#pragma unroll
                for (int j = 0; j < 8; ++j) f[j] = f[j] * (E1 * tt[j]);
                const bf16x8 a1 = __builtin_bit_cast(bf16x8, pack8(f));
                acc[1][0] = MFMA32(a1, b0, acc[1][0]); acc[1][1] = MFMA32(a1, b1, acc[1][1]);
                if (ks < 2 * lt0) {
                    const float E0 = __expf(al0 - aref);
                    unpack8(*(const LAS u32x4*)(BM + l0 * LROW + s0 * 2), f);
#pragma unroll
                    for (int j = 0; j < 8; ++j) f[j] = f[j] * (E0 * tt[j]);
                    const bf16x8 a0 = __builtin_bit_cast(bf16x8, pack8(f));
                    acc[0][0] = MFMA32(a0, b0, acc[0][0]); acc[0][1] = MFMA32(a0, b1, acc[0][1]); }
                else if (ks < 2 * lt0 + 2) {
                    const f32x4 q0 = *(const LAS f32x4*)(atab + r * 128 + s0), q1 = *(const LAS f32x4*)(atab + r * 128 + s0 + 4), d0 = *(const LAS f32x4*)(dtab + r * 128 + s0), d1 = *(const LAS f32x4*)(dtab + r * 128 + s0 + 4);
                    const float as[8] = {q0.x, q0.y, q0.z, q0.w, q1.x, q1.y, q1.z, q1.w}, ds[8] = {d0.x, d0.y, d0.z, d0.w, d1.x, d1.y, d1.z, d1.w};
                    unpack8(*(const LAS u32x4*)(BM + l0 * LROW + s0 * 2), f);
#pragma unroll
                    for (int j = 0; j < 8; ++j) { f[j] = (s0 + j <= l0) ? f[j] * __expf(al0 - as[j]) * ds[j] : 0.f; if (s0 + j == l0) f[j] += Dk; }
                    const bf16x8 a0 = __builtin_bit_cast(bf16x8, pack8(f));
                    acc[0][0] = MFMA32(a0, b0, acc[0][0]); acc[0][1] = MFMA32(a0, b1, acc[0][1]); } }
            else {
                const f32x4 q0 = *(const LAS f32x4*)(atab + r * 128 + s0), q1 = *(const LAS f32x4*)(atab + r * 128 + s0 + 4), d0 = *(const LAS f32x4*)(dtab + r * 128 + s0), d1 = *(const LAS f32x4*)(dtab + r * 128 + s0 + 4);
                const float as[8] = {q0.x, q0.y, q0.z, q0.w, q1.x, q1.y, q1.z, q1.w}, ds[8] = {d0.x, d0.y, d0.z, d0.w, d1.x, d1.y, d1.z, d1.w};
                unpack8(*(const LAS u32x4*)(BM + l1 * LROW + s0 * 2), f);
#pragma unroll
                for (int j = 0; j < 8; ++j) { f[j] = (s0 + j <= l1) ? f[j] * __expf(al1 - as[j]) * ds[j] : 0.f; if (s0 + j == l1) f[j] += Dk; }
                const bf16x8 a1 = __builtin_bit_cast(bf16x8, pack8(f));
                acc[1][0] = MFMA32(a1, b0, acc[1][0]); acc[1][1] = MFMA32(a1, b1, acc[1][1]); } }
#else
        for (int ks = 0; ks < 2 * lt1 + 2; ++ks) { const int s0 = ks * 16 + hh * 8;
            const bf16x8 b0 = *(const LAS bf16x8*)(XT + (rq * 64 + l31) * LROW + s0 * 2), b1 = *(const LAS bf16x8*)(XT + (rq * 64 + 32 + l31) * LROW + s0 * 2);
            const f32x4 q0 = *(const LAS f32x4*)(atab + r * 128 + s0), q1 = *(const LAS f32x4*)(atab + r * 128 + s0 + 4), d0 = *(const LAS f32x4*)(dtab + r * 128 + s0), d1 = *(const LAS f32x4*)(dtab + r * 128 + s0 + 4);
            const float as[8] = {q0.x, q0.y, q0.z, q0.w, q1.x, q1.y, q1.z, q1.w}, ds[8] = {d0.x, d0.y, d0.z, d0.w, d1.x, d1.y, d1.z, d1.w};
            float f[8]; unpack8(*(const LAS u32x4*)(BM + l1 * LROW + s0 * 2), f);
#pragma unroll
            for (int j = 0; j < 8; ++j) { f[j] = (s0 + j <= l1) ? f[j] * __expf(al1 - as[j]) * ds[j] : 0.f; if (s0 + j == l1) f[j] += Dk; }
            const bf16x8 a1 = __builtin_bit_cast(bf16x8, pack8(f));
            acc[1][0] = MFMA32(a1, b0, acc[1][0]); acc[1][1] = MFMA32(a1, b1, acc[1][1]);
            if (ks < 2 * lt0 + 2) {
                unpack8(*(const LAS u32x4*)(BM + l0 * LROW + s0 * 2), f);
#pragma unroll
                for (int j = 0; j < 8; ++j) { f[j] = (s0 + j <= l0) ? f[j] * __expf(al0 - as[j]) * ds[j] : 0.f; if (s0 + j == l0) f[j] += Dk; }
                const bf16x8 a0 = __builtin_bit_cast(bf16x8, pack8(f));
                acc[0][0] = MFMA32(a0, b0, acc[0][0]); acc[0][1] = MFMA32(a0, b1, acc[0][1]); } }
#endif
        __syncthreads();
#pragma unroll
        for (int li = 0; li < 2; ++li)
#pragma unroll
            for (int pt = 0; pt < 2; ++pt)
#pragma unroll
                for (int e = 0; e < 16; ++e) { const int le = (li ? lt1 : lt0) * 32 + (e & 3) + 8 * (e >> 2) + 4 * hh;
                    *(LAS unsigned short*)(XT + le * YROW + (rq * 64 + pt * 32 + l31) * 2) = f2bf(acc[li][pt][e]); }
        __syncthreads();
#pragma unroll
        for (int i = 0; i < 8; ++i) { const int l = lrow + 16 * i; const size_t colg = (size_t)g * 1024 + q * 256 + ch * 8;
            float ys[8], zs[8]; unpack8(*(const LAS u32x4*)(XT + l * YROW + ch * 16), ys); unpack8(__builtin_nontemporal_load((const u32x4*)(ZX + (row0 + l) * NZX + colg)), zs);
#pragma unroll
            for (int j = 0; j < 8; ++j) ys[j] = ys[j] * silu_f(zs[j]);
            const u32x4 w = pack8(ys); *(u32x4*)(Y + (row0 + l) * DINNER + colg) = w; unpack8(w, ys);
            float s = 0.f;
#pragma unroll
            for (int j = 0; j < 8; ++j) s += ys[j] * ys[j];
            ssq[i] += s; }
        __syncthreads();
    }
    asm volatile("s_waitcnt vmcnt(0)" ::: "memory");
    int tid = tid0; asm volatile("" : "+v"(tid));
    const int ch = tid & 31, lrow = tid >> 5;
#pragma unroll
    for (int i = 0; i < 8; ++i) { float s = ssq[i]; s += __shfl_xor(s, 1); s += __shfl_xor(s, 2); s += __shfl_xor(s, 4); s += __shfl_xor(s, 8); s += __shfl_xor(s, 16); ssq[i] = 1.0f / sqrtf(s * (1.0f / 1024.0f) + SSM_EPS); }
#pragma unroll
    for (int qp = 0; qp < 2; ++qp) { u32x4 raw[2][8];
#pragma unroll
        for (int q2 = 0; q2 < 2; ++q2)
#pragma unroll
            for (int i = 0; i < 8; ++i) raw[q2][i] = *(const u32x4*)(Y + (row0 + lrow + 16 * i) * DINNER + (size_t)g * 1024 + (2 * qp + q2) * 256 + ch * 8);
#pragma unroll
        for (int q2 = 0; q2 < 2; ++q2)
#pragma unroll
            for (int i = 0; i < 8; ++i) { float v[8]; unpack8(raw[q2][i], v);
#pragma unroll
                for (int j = 0; j < 8; ++j) v[j] *= ssq[i];
                *(u32x4*)(Y + (row0 + lrow + 16 * i) * DINNER + (size_t)g * 1024 + (2 * qp + q2) * 256 + ch * 8) = pack8(v); } }
}

DEV int t5_bucket(int rel) { if (rel < 16) return rel; const int v = 16 + (int)(logf((float)rel * (1.0f / 16.0f)) / logf(8.0f) * 16.0f); return v < 31 ? v : 31; }

constexpr int KROW = 144;
constexpr int VROW = 528;
DEV void attn_unit(const Ctx& C, int qb, int g, const bf16* __restrict__ Q, const bf16* __restrict__ KV, bf16* __restrict__ O, const float* __restrict__ sinks, const float* __restrict__ relb) {
    LAS unsigned char* KT = C.lds; LAS unsigned char* VT = C.lds + 36864; LAS float* btab = (LAS float*)(C.lds + 70656);
    const int tid = C.tid, lane = C.lane, wave = C.wave, hh = lane >> 5, l31 = lane & 31;
#pragma unroll
    for (int i = 0; i < 4; ++i) { const int task = tid + 512 * i, ch = task & 7, kr = task >> 3; const int row = (qb - 1) * 128 + kr;
        u32x4 kv = {0u, 0u, 0u, 0u}, vv = {0u, 0u, 0u, 0u};
        if (row >= 0) { const bf16* src = KV + (size_t)row * 1024 + g * 64 + ch * 8; kv = *(const u32x4*)src; vv = *(const u32x4*)(src + 512); }
        *(LAS u32x4*)(KT + kr * KROW + ch * 16) = kv;
        LAS unsigned short* vd = (LAS unsigned short*)(VT + (ch * 8) * VROW + kr * 2);
        vd[0 * (VROW / 2)] = (unsigned short)(vv.x & 0xffffu); vd[1 * (VROW / 2)] = (unsigned short)(vv.x >> 16); vd[2 * (VROW / 2)] = (unsigned short)(vv.y & 0xffffu); vd[3 * (VROW / 2)] = (unsigned short)(vv.y >> 16);
        vd[4 * (VROW / 2)] = (unsigned short)(vv.z & 0xffffu); vd[5 * (VROW / 2)] = (unsigned short)(vv.z >> 16); vd[6 * (VROW / 2)] = (unsigned short)(vv.w & 0xffffu); vd[7 * (VROW / 2)] = (unsigned short)(vv.w >> 16); }
    for (int idx = tid; idx < 1024; idx += 512) { const int w = idx >> 7, rel = idx & 127; btab[idx] = relb[t5_bucket(rel) * 64 + g * 8 + w]; }
    __syncthreads();
    const int hq = g * 8 + wave; const float sink = sinks[hq];
    for (int qt = 0; qt < 4; ++qt) {
        const size_t qrow = (size_t)qb * 128 + qt * 32 + l31;
        bf16x8 qf[4];
#pragma unroll
        for (int ks = 0; ks < 4; ++ks) qf[ks] = *(const bf16x8*)(Q + qrow * DM + hq * 64 + ks * 16 + hh * 8);
        f32x16 sc[5];
#pragma unroll
        for (int i = 0; i < 5; ++i) {
#pragma unroll
            for (int e = 0; e < 16; ++e) sc[i][e] = 0.f;
#pragma unroll
            for (int ks = 0; ks < 4; ++ks) { const bf16x8 a = *(const LAS bf16x8*)(KT + ((qt + i) * 32 + l31) * KROW + ks * 32 + hh * 16); sc[i] = MFMA32(a, qf[ks], sc[i]); } }
        float mx = -3.0e38f;
#pragma unroll
        for (int i = 0; i < 5; ++i)
#pragma unroll
            for (int e = 0; e < 16; ++e) { const int kl = (e & 3) + 8 * (e >> 2) + 4 * hh;
                const int rel = l31 - kl + 128 - 32 * i; const int key = (qt + i) * 32 + kl;
                const bool valid = (rel >= 0) && (rel < 128) && (qb > 0 || key >= 128);
                const float s = sc[i][e] + btab[wave * 128 + (rel & 127)];
                sc[i][e] = valid ? s : -3.0e38f; mx = fmaxf(mx, sc[i][e]); }
        mx = fmaxf(mx, __shfl_xor(mx, 32)); mx = fmaxf(mx, sink);
        float lsum = 0.f;
#pragma unroll
        for (int i = 0; i < 5; ++i)
#pragma unroll
            for (int e = 0; e < 16; ++e) { const float p = (sc[i][e] > -1.0e38f) ? __expf(sc[i][e] - mx) : 0.f; sc[i][e] = p; lsum += p; }
        lsum += __shfl_xor(lsum, 32);
        const float inv = 1.0f / (lsum + __expf(sink - mx));
        f32x16 oa[2];
#pragma unroll
        for (int dt = 0; dt < 2; ++dt)
#pragma unroll
            for (int e = 0; e < 16; ++e) oa[dt][e] = 0.f;
#pragma unroll
        for (int i = 0; i < 5; ++i)
#pragma unroll
            for (int s2 = 0; s2 < 2; ++s2) {
                asm volatile("" ::: "memory");
                u32x4 pw; pw.x = pk2(sc[i][8 * s2 + 0], sc[i][8 * s2 + 1]); pw.y = pk2(sc[i][8 * s2 + 2], sc[i][8 * s2 + 3]); pw.z = pk2(sc[i][8 * s2 + 4], sc[i][8 * s2 + 5]); pw.w = pk2(sc[i][8 * s2 + 6], sc[i][8 * s2 + 7]);
                const bf16x8 pb = __builtin_bit_cast(bf16x8, pw);
#pragma unroll
                for (int dt = 0; dt < 2; ++dt) { const LAS unsigned char* vp = VT + (dt * 32 + l31) * VROW + ((qt + i) * 32 + 16 * s2 + 4 * hh) * 2;
                    const u32x2 v0 = *(const LAS u32x2*)vp, v1 = *(const LAS u32x2*)(vp + 16);
                    u32x4 aw; aw.x = v0.x; aw.y = v0.y; aw.z = v1.x; aw.w = v1.y;
                    oa[dt] = MFMA32(__builtin_bit_cast(bf16x8, aw), pb, oa[dt]); } }
        bf16* op = O + qrow * DM + hq * 64 + 4 * hh;
#pragma unroll
        for (int dt = 0; dt < 2; ++dt)
#pragma unroll
            for (int g4 = 0; g4 < 4; ++g4) { u32x2 w; w.x = pk2(oa[dt][4 * g4] * inv, oa[dt][4 * g4 + 1] * inv); w.y = pk2(oa[dt][4 * g4 + 2] * inv, oa[dt][4 * g4 + 3] * inv);
                *(u32x2*)(op + dt * 32 + 8 * g4) = w; }
    }
    __syncthreads();
}

#ifndef REP_PRO
#define REP_PRO 1
#endif
#ifndef REP_GEMM_IN
#define REP_GEMM_IN 1
#endif
#ifndef REP_GEMM_OUT
#define REP_GEMM_OUT 1
#endif
#ifndef REP_GEMM_UP
#define REP_GEMM_UP 1
#endif
#ifndef REP_GEMM_DN
#define REP_GEMM_DN 1
#endif
#ifndef REP_GEMM_KVQ
#define REP_GEMM_KVQ 1
#endif
#ifndef REP_GEMM_O
#define REP_GEMM_O 1
#endif
#ifndef REP_PREP
#define REP_PREP 1
#endif
#ifndef REP_P2
#define REP_P2 1
#endif
#ifndef REP_P3
#define REP_P3 1
#endif
#ifndef REP_P4
#define REP_P4 1
#endif
#ifndef REP_THIN
#define REP_THIN 1
#endif
#ifndef REP_CONV
#define REP_CONV 1
#endif
#ifndef REP_ATT
#define REP_ATT 1
#endif
struct Args { const float* in[26]; float* out; unsigned char* ws; };
enum { I_X = 0, I_NMPRE, I_NMPOST, I_NFPRE, I_NFPOST, I_WIN, I_SCW, I_SCB, I_DTB, I_ALOG, I_D, I_SNORM, I_WOUT, I_KVN, I_WKV, I_BKV, I_WQ, I_BQ, I_SINK, I_WO, I_BO, I_RELB, I_WUP, I_FCW, I_FCB, I_WDN };

#ifndef GEMM_ALIGN
#define GEMM_ALIGN true
#endif
#ifndef GEMM_SP2
#define GEMM_SP2 true
#endif
#define IDLE_SLOT(n_units, W_, K_, N_, gain_, WT_, lo_, hi_) do { const int ex_ = (n_units) % C.G; \
    const int iw_ = ex_ > 0 ? ((int)blockIdx.x - ex_) * NWAVES + C.wave : (int)blockIdx.x * NWAVES + C.wave, in_ = ex_ > 0 ? (C.G - ex_) * NWAVES : C.G * NWAVES;     \
    if (iw_ >= 0) tr_matrix(C, (W_), (K_), (N_), (gain_), (WT_), 0, iw_, in_, (lo_), (hi_)); } while (0)
#define RUN_GEMM_I8(EpiT, Aptr, Btptr, N_, K8_, Eobj) do { pg8::Gemm g_{(const pg8::bf16_t*)(Aptr), (const pg8::bf16_t*)(Btptr), SEQ, (N_), (K8_) / 2}; pg8::StaticOrder S_; S_.init(SEQ, (N_), C.G, (int)blockIdx.x); \
    pg8::gemm_phase<EpiT, pg8::StaticOrder, GEMM_ALIGN, GEMM_SP2, true>(C.lds, g_, S_, Eobj); } while (0)
#define RUN_GEMM(EpiT, Aptr, Btptr, N_, K_, Eobj) do { pg8::Gemm g_{(const pg8::bf16_t*)(Aptr), (const pg8::bf16_t*)(Btptr), SEQ, (N_), (K_)}; pg8::StaticOrder S_; S_.init(SEQ, (N_), C.G, (int)blockIdx.x); \
    pg8::gemm_phase<EpiT, pg8::StaticOrder, GEMM_ALIGN, GEMM_SP2>(C.lds, g_, S_, Eobj); } while (0)

__global__ void __launch_bounds__(NWAVES * 64, 2) mk_fwd(Args args) {
    extern __shared__ __attribute__((aligned(16))) unsigned char lds_raw[];
    Ctx C; C.lds = (LAS unsigned char*)lds_raw; C.tid = threadIdx.x; C.lane = C.tid & 63; C.wave = __builtin_amdgcn_readfirstlane(C.tid >> 6);
    C.G = gridDim.x; { const int bx = blockIdx.x; C.vcu = (C.G % 8 == 0) ? (bx % 8) * (C.G / 8) + bx / 8 : bx; }
    volatile LAS unsigned* MISC = (volatile LAS unsigned*)(C.lds + MISC_OFF);
    if (C.tid < 64) MISC[C.tid] = 0u;
    __syncthreads();
    unsigned char* ws = args.ws;
    gu32* ctl = (gu32*)(ws + WS_CTL);
    XcdBarrier bar = xcd_barrier_post((unsigned*)(ctl + CW_BAR), MISC + 8);
#define GRID_BAR() xcd_barrier(bar)
    const float* x = args.in[I_X]; float* out = args.out;
    bf16* Win_bc = (bf16*)(ws + WS_WIN + 64 * MiB);     bf16* Wout_t = (bf16*)(ws + WS_WOUT); bf16* Wkvq_t = (bf16*)(ws + WS_WKVQ); bf16* Wo_t = (bf16*)(ws + WS_WO);
    bf16* Abuf = (bf16*)(ws + WS_A); bf16* MIX = (bf16*)(ws + WS_MIX);
    float* DTRAW = (float*)(ws + WS_DTRAW); float* DT = (float*)(ws + WS_DT); float* ACUM = (float*)(ws + WS_ACUM);
    bf16* ZX = (bf16*)(ws + WS_ZX); bf16* Y = (bf16*)(ws + WS_Y);
    bf16* Sbuf = (bf16*)(ws + WS_S); bf16* STb = (bf16*)(ws + WS_ST);
    bf16* ACT = (bf16*)(ws + WS_ACT); float* HALO = (float*)(ws + WS_HALO); float* RS = (float*)(ws + WS_RS); float* RSQ = (float*)(ws + WS_RSQ); float* CMAX = (float*)(ws + WS_CMAX); signed char* A8 = (signed char*)(ws + WS_A8);
    bf16* Qb = (bf16*)(ws + WS_Q); bf16* KVb = (bf16*)(ws + WS_KV); bf16* Ob = (bf16*)(ws + WS_O);

#define PHASE(rep, ...) do { __VA_ARGS__; GRID_BAR(); if constexpr ((rep) > 1) { __VA_ARGS__; GRID_BAR(); } } while (0)
    PHASE(REP_PRO,
#if defined(ZHI8) && defined(TRWIDE)
        tr_wide<true>(C, args.in[I_WIN], DM, QCOL0, args.in[I_NMPRE], Win_bc, 0, NIN);
        tr_wide<true>(C, args.in[I_WIN] + 2 * DINNER, DM, NIN - 2 * DINNER, args.in[I_NMPRE], Win_bc, QCOL0, NIN);
#elif defined(ZHI8) && defined(BCI8)
        tr_matrix(C, args.in[I_WIN], DM, QCOL0, args.in[I_NMPRE], Win_bc, 0, -1, 0, 0, 20, NIN);
        tr_matrix(C, args.in[I_WIN] + NZX, DM, NIN - NZX, args.in[I_NMPRE], Win_bc, QCOL0, -1, 0, 0, 20, NIN);
#elif defined(ZHI8)
        tr_matrix(C, args.in[I_WIN], DM, QCOL0, args.in[I_NMPRE], Win_bc, 0, -1, 0, 0, 20, NIN);
        tr_matrix(C, args.in[I_WIN] + 2 * DINNER, DM, NIN - 2 * DINNER, args.in[I_NMPRE], Win_bc, QCOL0, -1, 0, 0, 20, NIN);
#elif defined(XBCI8)
        tr_matrix(C, args.in[I_WIN], DM, DINNER, args.in[I_NMPRE], Win_bc, 0, -1, 0, 0, 20, NIN);
        tr_matrix(C, args.in[I_WIN] + NZX, DM, NIN - NZX, args.in[I_NMPRE], Win_bc, DINNER, -1, 0, 0, 20, NIN);
#elif defined(ZXI8)
        tr_matrix(C, args.in[I_WIN] + 2 * DINNER, DM, NIN - 2 * DINNER, args.in[I_NMPRE], Win_bc, 0, -1, 0, 0, 20, NIN);
#else
        tr_matrix(C, args.in[I_WIN], DM, DINNER, args.in[I_NMPRE], Win_bc, 0, -1, 0, 0, 20, NIN);
        tr_matrix(C, args.in[I_WIN] + 2 * DINNER, DM, NIN - 2 * DINNER, args.in[I_NMPRE], Win_bc, DINNER, -1, 0, 0, 20, NIN);
#endif
#ifdef TRWIDE
        tr_wide<true>(C, args.in[I_WOUT], DINNER, DM, args.in[I_SNORM], Wout_t, 0, DM);
#else
        tr_matrix(C, args.in[I_WOUT], DINNER, DM, args.in[I_SNORM], Wout_t, 0);
#endif
#ifndef TRWIDE
        tr_matrix(C, args.in[I_WDN], DFF, DM, nullptr, (bf16*)(ws + WS_WDN0), 0, -1, 0, 0, 9);
#endif
#ifdef TRWIDE
        tr_wide<true>(C, args.in[I_WKV], DM, 1024, args.in[I_KVN], Wkvq_t, 0, 1024);
        tr_wide<true>(C, args.in[I_WQ], DM, DM, args.in[I_NMPRE] + DM, Wkvq_t, 1024, DM);
        tr_matrix(C, args.in[I_WDN], DFF, DM, nullptr, (bf16*)(ws + WS_WDN0), 0, -1, 0, 0, 9);
#else
        tr_matrix(C, args.in[I_WKV], DM, 1024, args.in[I_KVN], Wkvq_t, 0);
        tr_matrix(C, args.in[I_WQ], DM, DM, args.in[I_NMPRE] + DM, Wkvq_t, 1024);
#endif
        xnorm_phase(C, x, Abuf, (signed char*)MIX, RSQ);
        __syncthreads();
#ifdef QWIDE
        w_quant_wide<QWIDE>(C, args.in[I_WIN] + QCOL0, args.in[I_NMPRE], args.in[I_WUP], args.in[I_NFPRE], CMAX, (signed char*)(ws + WS_WIN), (signed char*)(ws + WS_WUP0), (signed char*)(ws + WS_WUP1), (unsigned*)(ctl + CW_QCNT)));
#elif defined(QPIPE)
        w_quant_pipe(C, args.in[I_WIN] + QCOL0, args.in[I_NMPRE], args.in[I_WUP], args.in[I_NFPRE], CMAX, (signed char*)(ws + WS_WIN), (signed char*)(ws + WS_WUP0), (signed char*)(ws + WS_WUP1), (unsigned*)(ctl + CW_QCNT)));
#else
        { constexpr int T_IN = NZI8 / 16, T_UP = NUP / 16;
          for (int t = C.vcu; t < T_IN + 2 * T_UP; t += C.G) {
              if (t < T_IN) w_quant_half<false, NIN>(C, args.in[I_WIN] + QCOL0, args.in[I_NMPRE], CMAX + 2 * NUP, (signed char*)(ws + WS_WIN), (unsigned*)(ctl + CW_QCNT) + (t >> 1), t);
              else { const int u = t - T_IN, L = u >= T_UP ? 1 : 0;
                  w_quant_half<true, NUP>(C, args.in[I_WUP] + (size_t)L * DM * NUP, args.in[I_NFPRE] + L * DM, CMAX + L * NUP, (signed char*)(ws + (L ? WS_WUP1 : WS_WUP0)), (unsigned*)(ctl + CW_QCNT) + (t >> 1), u - L * T_UP); } } });
#endif

#ifdef ZHI8
    PHASE(REP_GEMM_IN, { pg8::EpiOutI8 E{(pg8::bf16_t*)(ZX + QCOL0), NZX, nullptr, 1.0f, RSQ, CMAX + 2 * NUP}; RUN_GEMM_I8(pg8::EpiOutI8, (signed char*)MIX, ws + WS_WIN, NZI8, DM, E); }
#ifdef BCI8
        { pg8::EpiOut E{(pg8::bf16_t*)ZX, NZX, nullptr, 1.0f, nullptr, nullptr}; RUN_GEMM(pg8::EpiOut, Abuf, Win_bc, NBC, DM, E); }
#else
        { pg8::EpiZBC E{{(pg8::bf16_t*)ZX, NZX, nullptr, 1.0f, nullptr, nullptr}}; RUN_GEMM(pg8::EpiZBC, Abuf, Win_bc, NBC, DM, E); }
#endif
#elif defined(XBCI8)
    PHASE(REP_GEMM_IN, { pg8::EpiOutI8 E{(pg8::bf16_t*)(ZX + DINNER), NZX, nullptr, 1.0f, RSQ, CMAX + 2 * NUP}; RUN_GEMM_I8(pg8::EpiOutI8, (signed char*)MIX, ws + WS_WIN, NZI8, DM, E); }
        { pg8::EpiOut E{(pg8::bf16_t*)ZX, NZX, nullptr, 1.0f, nullptr, nullptr}; RUN_GEMM(pg8::EpiOut, Abuf, Win_bc, NBC, DM, E); }
#elif defined(ZXI8)
    PHASE(REP_GEMM_IN, { pg8::EpiOutI8 E{(pg8::bf16_t*)ZX, NZX, nullptr, 1.0f, RSQ, CMAX + 2 * NUP}; RUN_GEMM_I8(pg8::EpiOutI8, (signed char*)MIX, ws + WS_WIN, NZI8, DM, E); }
        { pg8::EpiOut E{(pg8::bf16_t*)(ZX + NZI8), NZX, nullptr, 1.0f, nullptr, nullptr}; RUN_GEMM(pg8::EpiOut, Abuf, Win_bc, NBC, DM, E); }
#else
    PHASE(REP_GEMM_IN, { pg8::EpiOutI8 E{(pg8::bf16_t*)(ZX + DINNER), NZX, nullptr, 1.0f, RSQ, CMAX + 2 * NUP}; RUN_GEMM_I8(pg8::EpiOutI8, (signed char*)MIX, ws + WS_WIN, NZI8, DM, E); }
        { pg8::EpiZBC E{{(pg8::bf16_t*)ZX, NZX, nullptr, 1.0f, nullptr, nullptr}}; RUN_GEMM(pg8::EpiZBC, Abuf, Win_bc, NBC, DM, E); }
#endif
        dt_gemm(C, Abuf, Win_bc + (size_t)NBC * DM, DTRAW));
    PHASE(REP_PREP, ssd_prep(C, DTRAW, args.in[I_DTB], args.in[I_ALOG], DT, ACUM));
    PHASE(REP_P2, for (int u = C.vcu; u < NCHUNK * NGRP; u += C.G) ssd_states_unit(C, u >> 3, u & 7, ZX, args.in[I_SCW], args.in[I_SCB], DT, ACUM, Sbuf));
    PHASE(REP_P3, ssd_scan(C, Sbuf, ACUM, STb));
    PHASE(REP_P4, for (int u = C.vcu; u < NCHUNK * NGRP; u += C.G) ssd_out_unit(C, u >> 3, u & 7, args.in[I_SCW], args.in[I_SCB], ZX, DT, ACUM, STb, args.in[I_D], Y));
    PHASE(REP_GEMM_OUT, { pg8::EpiOut E{(pg8::bf16_t*)MIX, DM, nullptr, 1.0f, nullptr, nullptr}; RUN_GEMM(pg8::EpiOut, Y, Wout_t, DM, DINNER, E); });
    PHASE(REP_THIN, thin_phase<true, false, true>(C, MIX, x, Abuf, args.in[I_NMPOST], RS, A8, RSQ));
    PHASE(REP_GEMM_UP, { pg8::EpiConvGateI8 E{CMAX, (pg8::bf16_t*)ACT, HALO, args.in[I_FCW], args.in[I_FCB], (LAS float*)(C.lds + 131072), DFF, NUP, RSQ}; RUN_GEMM_I8(pg8::EpiConvGateI8, A8, ws + WS_WUP0, NUP, DM, E); }
        IDLE_SLOT((SEQ / 256) * (NUP / 256), args.in[I_WDN], DFF, DM, nullptr, (bf16*)(ws + WS_WDN0), 9, 20));
    PHASE(REP_CONV, ffn_fixup(C, HALO, ACT, args.in[I_FCW], args.in[I_FCB]));
    PHASE(REP_GEMM_DN, { pg8::EpiOut E{(pg8::bf16_t*)MIX, DM, nullptr, 1.0f, nullptr, nullptr}; RUN_GEMM(pg8::EpiOut, ACT, ws + WS_WDN0, DM, DFF, E); });
    PHASE(1, thin_phase<false, false>(C, MIX, Abuf, Abuf, args.in[I_NFPOST], RS));

    PHASE(REP_GEMM_KVQ, { pg8::EpiKVQ E{(pg8::bf16_t*)KVb, (pg8::bf16_t*)Qb, args.in[I_BKV], args.in[I_BQ], 0.125f, RS}; RUN_GEMM(pg8::EpiKVQ, Abuf, Wkvq_t, NKVQ, DM, E); }
        IDLE_SLOT((SEQ / 256) * (NKVQ / 256), args.in[I_WO], DM, DM, nullptr, Wo_t, 0, 20);
        IDLE_SLOT((SEQ / 256) * (NKVQ / 256), args.in[I_WDN] + (size_t)DFF * DM, DFF, DM, nullptr, (bf16*)(ws + WS_WDN1), 0, 12));
    PHASE(REP_ATT, for (int u = C.vcu; u < (SEQ / 128) * 8; u += C.G) attn_unit(C, u >> 3, u & 7, Qb, KVb, Ob, args.in[I_SINK], args.in[I_RELB]));
    PHASE(REP_GEMM_O, { pg8::EpiOut E{(pg8::bf16_t*)MIX, DM, args.in[I_BO], 1.0f, nullptr, nullptr}; RUN_GEMM(pg8::EpiOut, Ob, Wo_t, DM, DM, E); });
    PHASE(1, thin_phase<false, false, true>(C, MIX, Abuf, Abuf, args.in[I_NMPOST] + DM, RS, A8, RSQ));
    PHASE(1, { pg8::EpiConvGateI8 E{CMAX + NUP, (pg8::bf16_t*)ACT, HALO, args.in[I_FCW] + 3 * NUP, args.in[I_FCB] + NUP, (LAS float*)(C.lds + 131072), DFF, NUP, RSQ}; RUN_GEMM_I8(pg8::EpiConvGateI8, A8, ws + WS_WUP1, NUP, DM, E); }
        IDLE_SLOT((SEQ / 256) * (NUP / 256), args.in[I_WDN] + (size_t)DFF * DM, DFF, DM, nullptr, (bf16*)(ws + WS_WDN1), 12, 20));
    PHASE(1, ffn_fixup(C, HALO, ACT, args.in[I_FCW] + 3 * NUP, args.in[I_FCB] + NUP));
    PHASE(1, { pg8::EpiOut E{(pg8::bf16_t*)MIX, DM, nullptr, 1.0f, nullptr, nullptr}; RUN_GEMM(pg8::EpiOut, ACT, ws + WS_WDN1, DM, DFF, E); });
    thin_phase<false, true>(C, MIX, Abuf, out, args.in[I_NFPOST] + DM, RS);
}

extern "C" void kernel_launch(void* const* d_in, const int* in_sizes, int n_in, void* d_out, int out_size, void* d_ws, size_t ws_size, hipStream_t stream) {
    static int grid = 0;
    if (grid == 0) {
        if (n_in != 26 || in_sizes[0] != SEQ * DM || out_size != SEQ * DM || ws_size < WS_END) { fprintf(stderr, "kernel_launch: unexpected shapes: n_in %d in0 %d out %d ws %zu (need %zu)\n", n_in, n_in > 0 ? in_sizes[0] : -1, out_size, ws_size, (size_t)WS_END); grid = -1; return; }
        int dev = 0, cus = 0, per_cu = 0;
        if (hipGetDevice(&dev) != hipSuccess || hipDeviceGetAttribute(&cus, hipDeviceAttributeMultiprocessorCount, dev) != hipSuccess) { fprintf(stderr, "kernel_launch: device query failed\n"); grid = -1; return; }
        if (hipFuncSetAttribute((const void*)mk_fwd, hipFuncAttributeMaxDynamicSharedMemorySize, LDS_BYTES) != hipSuccess) { fprintf(stderr, "kernel_launch: hipFuncSetAttribute failed\n"); grid = -1; return; }
        if (hipOccupancyMaxActiveBlocksPerMultiprocessor(&per_cu, (const void*)mk_fwd, NWAVES * 64, LDS_BYTES) != hipSuccess || per_cu < 1) fprintf(stderr, "kernel_launch: occupancy query reports %d\n", per_cu);
        (void)hipGetLastError();
        grid = cus;
    }
    if (grid < 0) return;
    if (hipMemsetAsync((char*)d_ws + WS_CTL, 0, CTL_ZERO_BYTES, stream) != hipSuccess) { fprintf(stderr, "kernel_launch: memset failed\n"); return; }
    Args a{};
    for (int i = 0; i < 26; ++i) a.in[i] = (const float*)d_in[i];
    a.out = (float*)d_out; a.ws = (unsigned char*)d_ws;
    hipLaunchKernelGGL(mk_fwd, dim3(grid), dim3(NWAVES * 64), LDS_BYTES, stream, a);
    const hipError_t le = hipPeekAtLastError();
    if (le != hipSuccess) fprintf(stderr, "kernel_launch: launch failed: %s\n", hipGetErrorName(le));
}
```

```cpp
#define ZHI8 1
#define PG8_ZB_TILES 16
#define PG8_ZB_SHIFT 48
#define QI8 1
#include <hip/hip_runtime.h>
#include <cstdio>
#include <cstdint>
#ifndef PG8_WGM
#define PG8_WGM 8
#endif
namespace pg8 {
#define PG8_LAS __attribute__((address_space(3)))
typedef unsigned short bf16_t;
typedef short bf16x8 __attribute__((ext_vector_type(8)));
typedef float f32x4 __attribute__((ext_vector_type(4)));
typedef unsigned u32x4 __attribute__((ext_vector_type(4)));
constexpr int BM = 256, BK = 64, HALF = 128, HTB = HALF * BK * 2  , STAGE_BYTES = 8 * HTB, NXCD = 8, WGM = PG8_WGM;

__host__ __device__ __forceinline__ int lds_byte(int r, int c) { const int st = (r >> 4) * 2 + (c >> 5), rr = r & 15, cc = c & 31, ob = rr * 64 + cc * 2; return st * 1024 + (ob ^ (((ob >> 9) & 1) << 5)); }
__host__ __device__ __forceinline__ void stage_rc(int b, int& R, int& C) { const int st = b / 1024, sb = b % 1024, swz = sb ^ (((sb >> 9) & 1) << 5); R = (st >> 1) * 16 + swz / 64; C = (st & 1) * 32 + (swz % 64) / 2; }
__host__ __device__ __forceinline__ int perm32(int rho) { const int n = rho >> 4, i = rho & 15; return 8 * (i >> 2) + 4 * n + (i & 3); }

struct Unit { int pm, pn; };
struct Gemm { const bf16_t* A; const bf16_t* Bt; int M, N, K; };

struct StaticOrder {
    int nM, nN, nwg, G, c;
    __host__ __device__ void init(int M, int N, int G_, int c_) { nM = M / BM; nN = N / BM; nwg = nM * nN; G = G_; c = c_; }
    __host__ __device__ bool next(int i, Unit& u) const {
        const long L = (long)i * G + c; if (L >= nwg) return false;
        int wgid = (int)L; { const int q = nwg / NXCD, r = nwg % NXCD, xcd = wgid % NXCD, off = wgid / NXCD; wgid = (xcd < r ? xcd * (q + 1) : r * (q + 1) + (xcd - r) * q) + off; }
        const int nig = WGM * nN, gid = wgid / nig, fm = gid * WGM, gsz = (nM - fm) < WGM ? (nM - fm) : WGM;
        u.pm = fm + ((wgid % nig) % gsz); u.pn = (wgid % nig) / gsz; return true;
    }
    __device__ __forceinline__ void a_ready(const Unit&) const {}
    __device__ __forceinline__ void done(const Unit&) const {}
};

typedef __bf16 bf16v2_t __attribute__((ext_vector_type(2)));
typedef float f32x2_t __attribute__((ext_vector_type(2)));
typedef unsigned u32x2 __attribute__((ext_vector_type(2)));
__device__ __forceinline__ unsigned cvt_pk_bf16(float lo, float hi) { bf16v2_t v = __builtin_convertvector((f32x2_t){lo, hi}, bf16v2_t); return __builtin_bit_cast(unsigned, v); }

template <bool I8> struct EpiOutT {
    static constexpr bool PERM = true, AFTER_DRAIN = false;
    bf16_t* O; int ldc; const float* bias; float scale; const float* rowscale; const float* colmax;
    __device__ __forceinline__ void operator()(const f32x4 (&acc)[2][2][4][2], const Unit& u, int wr, int wc, int fr, int fq) const {
        const int row0 = u.pm * BM + wr * 64 + fr; const int col0 = u.pn * BM + wc * 32 + 8 * fq;
        float rs[2][4];
#pragma unroll
        for (int ai = 0; ai < 2; ++ai)
#pragma unroll
            for (int m = 0; m < 4; ++m) rs[ai][m] = rowscale ? rowscale[row0 + ai * HALF + m * 16] : 1.0f;
        f32x4 bv[2][2];
#pragma unroll
        for (int bj = 0; bj < 2; ++bj)
#pragma unroll
            for (int n = 0; n < 2; ++n) bv[bj][n] = bias ? *(const f32x4*)(bias + col0 + bj * HALF + 4 * n) : (f32x4){0.f, 0.f, 0.f, 0.f};
#pragma unroll
        for (int ai = 0; ai < 2; ++ai)
#pragma unroll
            for (int m = 0; m < 4; ++m) { bf16_t* rowp = O + (size_t)(row0 + ai * HALF + m * 16) * ldc + col0;
#pragma unroll
                for (int bj = 0; bj < 2; ++bj) { f32x4 a0 = acc[ai][bj][m][0], a1 = acc[ai][bj][m][1];
                    if constexpr (I8) { typedef int v4i_t __attribute__((ext_vector_type(4)));
                        a0 = __builtin_convertvector(__builtin_bit_cast(v4i_t, a0), f32x4) * (*(const f32x4*)(colmax + col0 + bj * HALF) * (1.0f / 127.0f));
                        a1 = __builtin_convertvector(__builtin_bit_cast(v4i_t, a1), f32x4) * (*(const f32x4*)(colmax + col0 + bj * HALF + 4) * (1.0f / 127.0f)); }
                    f32x4 v0 = (a0 * rs[ai][m] + bv[bj][0]) * scale, v1 = (a1 * rs[ai][m] + bv[bj][1]) * scale;
                    u32x4 w; w.x = cvt_pk_bf16(v0[0], v0[1]); w.y = cvt_pk_bf16(v0[2], v0[3]); w.z = cvt_pk_bf16(v1[0], v1[1]); w.w = cvt_pk_bf16(v1[2], v1[3]);
                    *(u32x4*)(rowp + bj * HALF) = w; } }
    }
};
typedef EpiOutT<false> EpiOut; typedef EpiOutT<true> EpiOutI8;
#ifndef PG8_ZB_TILES
#define PG8_ZB_TILES 32
#define PG8_ZB_SHIFT 32
#endif
struct EpiZBC {
    static constexpr bool PERM = true, AFTER_DRAIN = false;
    EpiOut e;
    __device__ __forceinline__ void operator()(const f32x4 (&acc)[2][2][4][2], const Unit& u, int wr, int wc, int fr, int fq) const { Unit v = u; if (u.pn >= PG8_ZB_TILES) v.pn = u.pn + PG8_ZB_SHIFT; e(acc, v, wr, wc, fr, fq); }
};
struct EpiKVQ {
    static constexpr bool PERM = true, AFTER_DRAIN = false;
    bf16_t* KV; bf16_t* Q; const float* bkv; const float* bq; float qscale; const float* rowscale;
    __device__ __forceinline__ void operator()(const f32x4 (&acc)[2][2][4][2], const Unit& u, int wr, int wc, int fr, int fq) const {
        const bool isq = u.pn >= 4;
        EpiOut e; Unit v = u; e.rowscale = rowscale; e.colmax = nullptr;
        if (isq) { e.O = Q; e.ldc = 4096; e.bias = bq; e.scale = qscale; v.pn = u.pn - 4; }
        else     { e.O = KV; e.ldc = 1024; e.bias = bkv; e.scale = 1.0f; }
        e(acc, v, wr, wc, fr, fq);
    }
};
__device__ __forceinline__ float dpp_ror1(float v) { return __builtin_bit_cast(float, __builtin_amdgcn_update_dpp(0, __builtin_bit_cast(int, v), 0x121, 0xf, 0xf, false)); }
__device__ __forceinline__ float dpp_ror2(float v) { return __builtin_bit_cast(float, __builtin_amdgcn_update_dpp(0, __builtin_bit_cast(int, v), 0x122, 0xf, 0xf, false)); }
template <bool I8> struct EpiConvGateT {
    static constexpr bool PERM = true, AFTER_DRAIN = false; const float* colmax;
    bf16_t* ACT; float* HALO; const float* cw; const float* cb; PG8_LAS float* xch; int dff, nup; const float* rowscale;
    __device__ __forceinline__ void operator()(const f32x4 (&acc_in)[2][2][4][2], const Unit& u, int wr, int wc, int fr, int fq) const {
        const int cbase = u.pn * 128 + wc * 32 + 8 * fq;
        f32x4 (&acc)[2][2][4][2] = const_cast<f32x4 (&)[2][2][4][2]>(acc_in);
#pragma unroll
        for (int ai = 0; ai < 2; ++ai)
#pragma unroll
            for (int m = 0; m < 4; ++m) { const float rsv = rowscale[u.pm * BM + ai * HALF + wr * 64 + m * 16 + fr];
#pragma unroll
                for (int bj = 0; bj < 2; ++bj)
#pragma unroll
                    for (int n = 0; n < 2; ++n) {
                        if constexpr (I8) { typedef int v4i_t __attribute__((ext_vector_type(4))); const f32x4 cs = *(const f32x4*)(colmax + bj * dff + cbase + 4 * n) * (1.0f / 127.0f);
                            acc[ai][bj][m][n] = __builtin_convertvector(__builtin_bit_cast(v4i_t, acc[ai][bj][m][n]), f32x4) * cs * rsv; }
                        else acc[ai][bj][m][n] = acc[ai][bj][m][n] * rsv; } }
        if (fr >= 14) {
#pragma unroll
            for (int ai = 0; ai < 2; ++ai)
#pragma unroll
                for (int bj = 0; bj < 2; ++bj)
#pragma unroll
                    for (int n = 0; n < 2; ++n) *(PG8_LAS f32x4*)(xch + (((((ai * 2 + wr) * 4 + wc) * 2 + (fr - 14)) * 2 + bj) * 32 + fq * 8 + n * 4)) = acc[ai][bj][3][n];
        }
        if (wr == 0 && fr < 2) {
#pragma unroll
            for (int bj = 0; bj < 2; ++bj)
#pragma unroll
                for (int n = 0; n < 2; ++n) *(f32x4*)(HALO + (size_t)(u.pm * 4 + fr) * nup + bj * dff + cbase + 4 * n) = acc[0][bj][0][n];
        }
        if (wr == 1 && fr >= 14) {
#pragma unroll
            for (int bj = 0; bj < 2; ++bj)
#pragma unroll
                for (int n = 0; n < 2; ++n) *(f32x4*)(HALO + (size_t)(u.pm * 4 + fr - 12) * nup + bj * dff + cbase + 4 * n) = acc[1][bj][3][n];
        }
        asm volatile("s_waitcnt lgkmcnt(0)" ::: "memory"); __builtin_amdgcn_s_barrier(); asm volatile("" ::: "memory");
        u32x2 ow[2][4];
#pragma unroll
        for (int n = 0; n < 2; ++n) {
            asm volatile("" ::: "memory");
            f32x4 w[2][3], b[2];
#pragma unroll
            for (int bj = 0; bj < 2; ++bj) {
#pragma unroll
                for (int k = 0; k < 3; ++k) w[bj][k] = *(const f32x4*)(cw + (size_t)k * nup + bj * dff + cbase + 4 * n);
                b[bj] = *(const f32x4*)(cb + bj * dff + cbase + 4 * n); }
#pragma unroll
            for (int ai = 0; ai < 2; ++ai) {
                const int pai = (wr == 1) ? ai : 0, pwr = (wr == 1) ? 0 : 1;
                f32x4 x14[2], x15[2];
#pragma unroll
                for (int bj = 0; bj < 2; ++bj) { x14[bj] = *(const PG8_LAS f32x4*)(xch + (((((pai * 2 + pwr) * 4 + wc) * 2 + 0) * 2 + bj) * 32 + fq * 8 + n * 4));
                                                 x15[bj] = *(const PG8_LAS f32x4*)(xch + (((((pai * 2 + pwr) * 4 + wc) * 2 + 1) * 2 + bj) * 32 + fq * 8 + n * 4)); }
#pragma unroll
                for (int m = 0; m < 4; ++m) {
                    f32x4 cv[2];
#pragma unroll
                    for (int bj = 0; bj < 2; ++bj) {
                        const f32x4 cur = acc[ai][bj][m][n]; f32x4 p1, p2;
#pragma unroll
                        for (int j = 0; j < 4; ++j) {
                            const float c1 = dpp_ror1(cur[j]), c2 = dpp_ror2(cur[j]); float q1, q2;
                            if (m == 0) { q1 = x15[bj][j]; q2 = (fr == 1) ? x15[bj][j] : x14[bj][j]; }
                            else { const float pv = acc[ai][bj][m > 0 ? m - 1 : 0][n][j]; q1 = dpp_ror1(pv); q2 = dpp_ror2(pv); }
                            p1[j] = (fr >= 1) ? c1 : q1; p2[j] = (fr >= 2) ? c2 : q2; }
                        cv[bj] = b[bj] + w[bj][0] * p2 + w[bj][1] * p1 + w[bj][2] * cur; }
                    float o[4];
#pragma unroll
                    for (int j = 0; j < 4; ++j) o[j] = cv[0][j] * __builtin_amdgcn_rcpf(1.0f + __expf(-cv[0][j])) * cv[1][j];
                    u32x2 pkd; pkd.x = cvt_pk_bf16(o[0], o[1]); pkd.y = cvt_pk_bf16(o[2], o[3]);
                    if (n == 0) ow[ai][m] = pkd;
                    else { u32x4 wv; wv.x = ow[ai][m].x; wv.y = ow[ai][m].y; wv.z = pkd.x; wv.w = pkd.y;
                        *(u32x4*)(ACT + (size_t)(u.pm * BM + ai * HALF + wr * 64 + m * 16 + fr) * dff + cbase) = wv; } }
            }
        }
    }
};
typedef EpiConvGateT<false> EpiConvGate; typedef EpiConvGateT<true> EpiConvGateI8;

typedef int pg8_v4i __attribute__((ext_vector_type(4)));
template <bool I8> __device__ __forceinline__ f32x4 mma16(const bf16x8 b, const bf16x8 a, const f32x4 c) {
    if constexpr (I8) return __builtin_bit_cast(f32x4, __builtin_amdgcn_mfma_i32_16x16x64_i8(__builtin_bit_cast(pg8_v4i, b), __builtin_bit_cast(pg8_v4i, a), __builtin_bit_cast(pg8_v4i, c), 0, 0, 0));
    else return __builtin_amdgcn_mfma_f32_16x16x32_bf16(b, a, c, 0, 0, 0);
}
template <class Epi, class Sched, bool ALIGN_EPI = false, bool SP2 = false, bool I8 = false>
__device__ __forceinline__ void gemm_phase(PG8_LAS unsigned char* lds, const Gemm g, const Sched& S, const Epi& E) {
    int tid_l = threadIdx.x; asm volatile("" : "+v"(tid_l));
    const int tid = tid_l, wid = __builtin_amdgcn_readfirstlane(tid >> 6), lane = tid & 63, wr = wid >> 2, wc = wid & 3, fr = lane & 15, fq = lane >> 4;
    const int K = g.K, nt = K / BK;
    unsigned voffA[2], voffB[2];
#pragma unroll
    for (int i = 0; i < 2; ++i) { int R, C; stage_rc(tid * 16 + i * 8192, R, C); const int Rb = Epi::PERM ? ((R & ~31) + perm32(R & 31)) : R;
        voffA[i] = (unsigned)(R * K + C) * 2u; voffB[i] = (unsigned)(Rb * K + C) * 2u; }
    const size_t kstep = (size_t)(BK * 2);
    const size_t hstep = (size_t)HALF * K * 2;
    const size_t tstep = 2 * hstep;
    const unsigned ldsw = (unsigned)wid * 1024u;
    const int aoff = lds_byte(wr * 64 + fr, fq * 8), boff = lds_byte(wc * 32 + fr, fq * 8);
#define PG8_SA(b, h) (((b) * 2 + (h)) * HTB)
#define PG8_SB(b, h) ((4 + (b) * 2 + (h)) * HTB)
#define PG8_STAGE(bufoff, gbase, voff) do { _Pragma("unroll") for (int _i = 0; _i < 2; ++_i) \
        __builtin_amdgcn_global_load_lds((const unsigned*)((const char*)(gbase) + (voff)[_i]), (PG8_LAS unsigned*)(lds + (bufoff) + ldsw + _i * 8192), 16, 0, 0); } while (0)
#define PG8_LDA(dst, b, h) do { _Pragma("unroll") for (int m = 0; m < 4; ++m) _Pragma("unroll") for (int k = 0; k < 2; ++k) dst[m][k] = *(const PG8_LAS bf16x8*)(lds + PG8_SA(b, h) + aoff + m * 2048 + k * 1024); } while (0)
#define PG8_LDB(dst, b, h) do { _Pragma("unroll") for (int n = 0; n < 2; ++n) _Pragma("unroll") for (int k = 0; k < 2; ++k) dst[n][k] = *(const PG8_LAS bf16x8*)(lds + PG8_SB(b, h) + boff + n * 2048 + k * 1024); } while (0)
#define PG8_MMA(ai, bj, At, Bt) do { __builtin_amdgcn_s_setprio(1); _Pragma("unroll") for (int m = 0; m < 4; ++m) _Pragma("unroll") for (int n = 0; n < 2; ++n) _Pragma("unroll") for (int k = 0; k < 2; ++k) \
        acc[ai][bj][m][n] = mma16<I8>(Bt[n][k], At[m][k], acc[ai][bj][m][n]); __builtin_amdgcn_s_setprio(0); } while (0)
#define PG8_WAIT_V(n) asm volatile("s_waitcnt vmcnt(" #n ")" ::: "memory")
#define PG8_WAIT_L(n) asm volatile("s_waitcnt lgkmcnt(" #n ")" ::: "memory")
#define PG8_BAR __builtin_amdgcn_s_barrier()
#define PG8_SCHED __builtin_amdgcn_sched_barrier(0)
    Unit cur, nxt; int ui = 0;
    if (!S.next(0, cur)) return;
    f32x4 acc[2][2][4][2];
#pragma unroll
    for (int a = 0; a < 2; ++a)
#pragma unroll
        for (int b = 0; b < 2; ++b)
#pragma unroll
            for (int m = 0; m < 4; ++m)
#pragma unroll
                for (int n = 0; n < 2; ++n) acc[a][b][m][n] = (f32x4){0.f, 0.f, 0.f, 0.f};
    bf16x8 At[4][2], B0[2][2], B1[2][2];
    const char* cA = (const char*)g.A + (size_t)cur.pm * tstep; const char* cB = (const char*)g.Bt + (size_t)cur.pn * tstep;
    S.a_ready(cur);
    if constexpr (SP2) {
        PG8_STAGE(PG8_SB(0, 0), cB, voffB); PG8_STAGE(PG8_SB(0, 1), cB + hstep, voffB); PG8_STAGE(PG8_SA(0, 0), cA, voffA); PG8_STAGE(PG8_SA(0, 1), cA + hstep, voffA);
        if (wr == 1) PG8_BAR;
        PG8_WAIT_V(2); PG8_BAR;
        PG8_STAGE(PG8_SB(1, 0), cB + kstep, voffB); PG8_STAGE(PG8_SA(1, 0), cA + kstep, voffA); PG8_STAGE(PG8_SB(1, 1), cB + hstep + kstep, voffB);
        PG8_WAIT_V(6); PG8_BAR;
    } else {
        PG8_STAGE(PG8_SB(0, 0), cB, voffB); PG8_STAGE(PG8_SA(0, 0), cA, voffA); PG8_STAGE(PG8_SB(0, 1), cB + hstep, voffB); PG8_STAGE(PG8_SA(0, 1), cA + hstep, voffA);
        if (wr == 1) PG8_BAR;
        PG8_WAIT_V(4); PG8_BAR;
        PG8_STAGE(PG8_SB(1, 0), cB + kstep, voffB); PG8_STAGE(PG8_SA(1, 0), cA + kstep, voffA); PG8_STAGE(PG8_SB(1, 1), cB + hstep + kstep, voffB);
        PG8_WAIT_V(6); PG8_BAR;
    }
    for (;;) {
        const bool has_next = S.next(ui + 1, nxt);
        const char* nA = has_next ? (const char*)g.A + (size_t)nxt.pm * tstep : cA; const char* nB = has_next ? (const char*)g.Bt + (size_t)nxt.pn * tstep : cB;
        for (int t = 0; t < nt; t += 2) {
            const bool last = (t == nt - 2);
            const char* a1 = cA + (size_t)(t + 1) * kstep;
            const char* a2 = last ? nA : cA + (size_t)(t + 2) * kstep; const char* b2 = last ? nB : cB + (size_t)(t + 2) * kstep;
            const char* a3 = a2 + kstep; const char* b3 = b2 + kstep;
            if (last && has_next) S.a_ready(nxt);
            if constexpr (SP2) {
            PG8_LDB(B0, 0, 0); PG8_LDB(B1, 0, 1); PG8_SCHED; PG8_LDA(At, 0, 0); PG8_STAGE(PG8_SA(1, 1), a1 + hstep, voffA);
            PG8_WAIT_V(8); PG8_WAIT_L(0); PG8_BAR; PG8_MMA(0, 0, At, B0); PG8_MMA(0, 1, At, B1); PG8_BAR; PG8_SCHED;
            PG8_LDA(At, 0, 1); PG8_STAGE(PG8_SB(0, 0), b2, voffB); PG8_STAGE(PG8_SB(0, 1), b2 + hstep, voffB); PG8_STAGE(PG8_SA(0, 0), a2, voffA);
            PG8_WAIT_V(8); PG8_WAIT_L(0); PG8_BAR; PG8_MMA(1, 0, At, B0); PG8_MMA(1, 1, At, B1); PG8_BAR; PG8_SCHED;
            PG8_LDB(B0, 1, 0); PG8_LDB(B1, 1, 1); PG8_SCHED; PG8_LDA(At, 1, 0); PG8_STAGE(PG8_SA(0, 1), a2 + hstep, voffA);
            PG8_WAIT_V(8); PG8_WAIT_L(0); PG8_BAR; PG8_MMA(0, 0, At, B0); PG8_MMA(0, 1, At, B1); PG8_BAR; PG8_SCHED;
            PG8_LDA(At, 1, 1); PG8_STAGE(PG8_SB(1, 0), b3, voffB); PG8_STAGE(PG8_SB(1, 1), b3 + hstep, voffB); PG8_STAGE(PG8_SA(1, 0), a3, voffA);
            PG8_WAIT_V(8); PG8_WAIT_L(0); PG8_BAR; PG8_MMA(1, 0, At, B0); PG8_MMA(1, 1, At, B1); PG8_BAR; PG8_SCHED;
            } else {
            PG8_LDB(B0, 0, 0); PG8_SCHED; PG8_LDA(At, 0, 0); PG8_STAGE(PG8_SA(1, 1), a1 + hstep, voffA);
            PG8_WAIT_L(8); PG8_BAR; PG8_WAIT_L(0); PG8_MMA(0, 0, At, B0); PG8_BAR; PG8_SCHED;
            PG8_LDB(B1, 0, 1); PG8_STAGE(PG8_SB(0, 0), b2, voffB);
            PG8_BAR; PG8_WAIT_L(0); PG8_MMA(0, 1, At, B1); PG8_BAR;
            PG8_LDA(At, 0, 1); PG8_STAGE(PG8_SA(0, 0), a2, voffA);
            PG8_BAR; PG8_WAIT_L(0); PG8_MMA(1, 0, At, B0); PG8_BAR; PG8_SCHED;
            PG8_STAGE(PG8_SB(0, 1), b2 + hstep, voffB);
            PG8_WAIT_V(6); PG8_BAR; PG8_MMA(1, 1, At, B1); PG8_BAR;
            PG8_LDB(B0, 1, 0); PG8_SCHED; PG8_LDA(At, 1, 0); PG8_STAGE(PG8_SA(0, 1), a2 + hstep, voffA);
            PG8_WAIT_L(8); PG8_BAR; PG8_WAIT_L(0); PG8_MMA(0, 0, At, B0); PG8_BAR; PG8_SCHED;
            PG8_LDB(B1, 1, 1); PG8_STAGE(PG8_SB(1, 0), b3, voffB);
            PG8_BAR; PG8_WAIT_L(0); PG8_MMA(0, 1, At, B1); PG8_BAR;
            PG8_LDA(At, 1, 1); PG8_STAGE(PG8_SA(1, 0), a3, voffA);
            PG8_BAR; PG8_WAIT_L(0); PG8_MMA(1, 0, At, B0); PG8_BAR; PG8_SCHED;
            PG8_STAGE(PG8_SB(1, 1), b3 + hstep, voffB);
            PG8_WAIT_V(6); PG8_BAR; PG8_MMA(1, 1, At, B1); PG8_BAR;
            }
        }
        if constexpr (ALIGN_EPI) { if (wr == 0) PG8_BAR; }
        if constexpr (!Epi::AFTER_DRAIN) { E(acc, cur, wr, wc, fr, fq); S.done(cur); }
        if (!has_next) break;
#pragma unroll
        for (int a = 0; a < 2; ++a)
#pragma unroll
            for (int b = 0; b < 2; ++b)
#pragma unroll
                for (int m = 0; m < 4; ++m)
#pragma unroll
                    for (int n = 0; n < 2; ++n) acc[a][b][m][n] = (f32x4){0.f, 0.f, 0.f, 0.f};
        cur = nxt; cA = nA; cB = nB; ++ui;
        if constexpr (ALIGN_EPI) { if (wr == 1) PG8_BAR; }
    }
    PG8_WAIT_V(0);
    if constexpr (!ALIGN_EPI) { if (wr == 0) PG8_BAR; }
    PG8_BAR;
    if constexpr (Epi::AFTER_DRAIN) { E.fused(acc, cur, wr, wc, fr, fq, lds, wid, lane); S.done(cur); }
#undef PG8_SA
#undef PG8_SB
#undef PG8_STAGE
#undef PG8_LDA
#undef PG8_LDB
#undef PG8_MMA
#undef PG8_WAIT_V
#undef PG8_WAIT_L
#undef PG8_BAR
#undef PG8_SCHED
}
}
#define GAS __attribute__((address_space(1)))
#define LAS __attribute__((address_space(3)))
typedef unsigned short bf16;
typedef unsigned v4u __attribute__((ext_vector_type(4)));
typedef float f32x4 __attribute__((ext_vector_type(4)));
typedef short bf16x8 __attribute__((ext_vector_type(8)));
typedef GAS unsigned gu32;
typedef GAS unsigned long long gu64;
#define RLX_AGENT __ATOMIC_RELAXED, __HIP_MEMORY_SCOPE_AGENT
#define LDS_WAIT() asm volatile("s_waitcnt lgkmcnt(0)" ::: "memory")
#define VM_WAIT() asm volatile("s_waitcnt vmcnt(0)" ::: "memory")
__device__ __forceinline__ unsigned long long rt() { return __builtin_amdgcn_s_memrealtime(); }

#define XB_TMO      128
#define XB_XCNT(j)  (256  + 64 * (j))
#define XB_XSUB(j)  (1280 + 64 * (j))
#define XB_XGEN(j)  (2304 + 64 * (j))
#define XB_TOP      3328
#define XB_TOPGEN   3392
#define XCD_BAR_WORDS 3456
#define XB_SPIN_CAP (1u << 18)

__device__ __forceinline__ unsigned xb_ld(unsigned* p)              { return __hip_atomic_load(p, __ATOMIC_RELAXED, __HIP_MEMORY_SCOPE_AGENT); }
__device__ __forceinline__ unsigned xb_add(unsigned* p, unsigned v) { return __hip_atomic_fetch_add(p, v, __ATOMIC_RELAXED, __HIP_MEMORY_SCOPE_AGENT); }
__device__ __forceinline__ unsigned xb_xcc_id() { return (unsigned)__builtin_amdgcn_s_getreg((3 << 11) | 20) & 0xFu; }
#define XB_SPIN(cond, bar) do { unsigned _sp = 0; while (cond) { __builtin_amdgcn_s_sleep(1); \
    if ((++_sp & 255u) == 0u) { if (xb_ld(&(bar)[XB_TMO])) break; if (_sp > XB_SPIN_CAP) { atomicAdd(&(bar)[XB_TMO], 1u); break; } } } } while (0)

struct XcdBarrier {
    unsigned* bar; unsigned x;
    volatile LAS unsigned* st;
};

__device__ __forceinline__ XcdBarrier xcd_barrier_post(unsigned* bar, volatile LAS unsigned* st) {
    XcdBarrier b; b.bar = bar; b.x = xb_xcc_id(); b.st = st;
    if (threadIdx.x == 0) (void)xb_add(&bar[XB_XCNT(b.x)], 1u);
    return b;
}
__device__ __forceinline__ void xcd_barrier_complete(unsigned* bar, unsigned x, unsigned& nloc, unsigned& nx) {
    const unsigned G = gridDim.x * gridDim.y * gridDim.z;
    unsigned sum, cnt, mine, sp = 0u;
    for (;;) {
        sum = 0u; cnt = 0u; mine = 0u;
#pragma unroll
        for (unsigned j = 0; j < 16; ++j) { const unsigned c = xb_ld(&bar[XB_XCNT(j)]); sum += c; cnt += (c > 0u) ? 1u : 0u; mine = (j == x) ? c : mine; }
        if (sum == G) break;
        __builtin_amdgcn_s_sleep(1);
        if ((++sp & 255u) == 0u) { if (xb_ld(&bar[XB_TMO])) break; if (sp > XB_SPIN_CAP) { atomicAdd(&bar[XB_TMO], 1u); break; } }
    }
    nloc = mine > 0u ? mine : 1u; nx = cnt > 0u ? cnt : 1u;
}

__device__ __forceinline__ void xcd_barrier(const XcdBarrier& b) {
    asm volatile("s_waitcnt vmcnt(0)" ::: "memory");
    __syncthreads();
    if (threadIdx.x == 0) {
        unsigned* bar = b.bar;
        __builtin_amdgcn_s_waitcnt(0);
        unsigned nloc = b.st[0], nx = b.st[1];
        if (nloc == 0u) { xcd_barrier_complete(bar, b.x, nloc, nx); b.st[0] = nloc; b.st[1] = nx; }
        const unsigned old = xb_add(&bar[XB_XSUB(b.x)], 1u);
        const unsigned gen = old / nloc;
        if (old + 1u == (gen + 1u) * nloc) {
            __builtin_amdgcn_fence(__ATOMIC_RELEASE, "agent");
            asm volatile("s_waitcnt vmcnt(0)" ::: "memory");
            const unsigned og = xb_add(&bar[XB_TOP], 1u);
            const unsigned tg = og / nx;
            if (og + 1u == (tg + 1u) * nx) xb_add(&bar[XB_TOPGEN], 1u);
            else XB_SPIN(xb_ld(&bar[XB_TOPGEN]) == tg, bar);
            __builtin_amdgcn_fence(__ATOMIC_ACQUIRE, "agent");
            xb_add(&bar[XB_XGEN(b.x)], 1u);
            asm volatile("s_waitcnt vmcnt(0)" ::: "memory");
        } else {
            XB_SPIN(xb_ld(&bar[XB_XGEN(b.x)]) == gen, bar);
            __builtin_amdgcn_fence(__ATOMIC_ACQUIRE, "agent");
            asm volatile("s_waitcnt vmcnt(0)" ::: "memory");
        }
    }
    __syncthreads();
}


constexpr int SEQ = 8192, DM = 4096, DINNER = 8192, NHEAD = 128, HDIM = 64, NGRP = 8, HPG = 16, DSTATE = 128;
constexpr int CONVD = 10240, NZX = 18432, NIN = 18560, DFF = 11008, NUP = 22016, NKVQ = 5120;
constexpr int CHUNK = 128, NCHUNK = 64;
#ifdef ZHI8
#ifndef ZHI8_Q0
#define ZHI8_Q0 4096
#endif
#ifdef BCI8
constexpr int NZI8 = NZX - ZHI8_Q0, NBC = NZX - NZI8;
#else
constexpr int NZI8 = 16384 - ZHI8_Q0, NBC = NZX - NZI8;
#endif
#elif defined(XBCI8)
constexpr int NZI8 = 10240, NBC = NZX - NZI8;
#elif defined(ZXI8)
constexpr int NZI8 = 16384, NBC = NZX - NZI8;
#else
constexpr int NZI8 = 8192, NBC = NZX - NZI8;
#endif
#ifdef ZHI8
constexpr int QCOL0 = ZHI8_Q0;
#elif defined(ZXI8)
constexpr int QCOL0 = 0;
#else
constexpr int QCOL0 = DINNER;
#endif
constexpr float EPS = 1e-6f, SSM_EPS = 1e-5f;
constexpr int NWAVES = 8;

constexpr size_t MiB = 1u << 20;
constexpr size_t WS_CTL = 0, CTL_ZERO_BYTES = 1 * MiB;
constexpr size_t WS_WIN = 1 * MiB;
constexpr size_t WS_WOUT = 146 * MiB;
constexpr size_t WS_WUP0 = 210 * MiB;
constexpr size_t WS_WUP1 = 382 * MiB;
constexpr size_t WS_WDN0 = 554 * MiB;
constexpr size_t WS_WDN1 = 640 * MiB;
constexpr size_t WS_WKVQ = 726 * MiB;
constexpr size_t WS_WO = 766 * MiB;
constexpr size_t WS_A = 798 * MiB;
constexpr size_t WS_MIX = 862 * MiB;
constexpr size_t WS_DTRAW = 926 * MiB;
constexpr size_t WS_DT = 930 * MiB;
constexpr size_t WS_ACUM = 934 * MiB;
constexpr size_t WS_HALO = WS_DTRAW;
constexpr size_t WS_RS = 937 * MiB;
constexpr size_t WS_RSQ = 937 * MiB + 65536;
constexpr size_t WS_CMAX = 512 * 1024;
constexpr size_t WS_BIG = 938 * MiB;
constexpr size_t WS_A8 = WS_BIG;
constexpr size_t WS_ZX = WS_BIG;
constexpr size_t WS_S = WS_BIG + 448 * MiB;
constexpr size_t WS_ST = WS_BIG + 704 * MiB;
constexpr size_t WS_Y = WS_BIG + 832 * MiB;
constexpr size_t WS_ACT = WS_BIG + 344 * MiB;
constexpr size_t WS_Q = WS_BIG;
constexpr size_t WS_KV = WS_BIG + 64 * MiB;
constexpr size_t WS_O = WS_BIG + 80 * MiB;
constexpr size_t WS_END = WS_BIG + 960 * MiB;
constexpr int CW_BAR = 4096;

constexpr int LDS_BYTES = 163840;
constexpr int MISC_OFF = LDS_BYTES - 256;

typedef float f32x4 __attribute__((ext_vector_type(4)));
typedef float f32x16 __attribute__((ext_vector_type(16)));
typedef short bf16x8 __attribute__((ext_vector_type(8)));
typedef short bf16x4 __attribute__((ext_vector_type(4)));
typedef unsigned u32x4 __attribute__((ext_vector_type(4)));
typedef unsigned u32x2 __attribute__((ext_vector_type(2)));
#define DEV __device__ __forceinline__
DEV unsigned pk2(float lo, float hi) { return pg8::cvt_pk_bf16(lo, hi); }
DEV float bf_lo(unsigned w) { return __builtin_bit_cast(float, w << 16); }
DEV float bf_hi(unsigned w) { return __builtin_bit_cast(float, w & 0xffff0000u); }
DEV float bf2f(bf16 b) { return __builtin_bit_cast(float, ((unsigned)b) << 16); }
DEV bf16 f2bf(float f) { return (bf16)(pk2(f, 0.f) & 0xffffu); }
DEV float silu_f(float v) { return v * __builtin_amdgcn_rcpf(1.0f + __expf(-v)); }
DEV float wave_sum(float v) {
#pragma unroll
    for (int o = 1; o < 64; o <<= 1) v += __shfl_xor(v, o);
    return v;
}
DEV void unpack8(const u32x4 w, float (&f)[8]) { f[0] = bf_lo(w.x); f[1] = bf_hi(w.x); f[2] = bf_lo(w.y); f[3] = bf_hi(w.y); f[4] = bf_lo(w.z); f[5] = bf_hi(w.z); f[6] = bf_lo(w.w); f[7] = bf_hi(w.w); }
DEV u32x4 pack8(const float (&f)[8]) { u32x4 w; w.x = pk2(f[0], f[1]); w.y = pk2(f[2], f[3]); w.z = pk2(f[4], f[5]); w.w = pk2(f[6], f[7]); return w; }

struct Ctx { LAS unsigned char* lds; int tid, lane, wave, vcu, G; };

struct TrTile { f32x4 v[16]; float g[16]; };
DEV void tr_load(TrTile& t, const float* __restrict__ W, int N, const float* __restrict__ gain, int k0, int n0, int lane) {
    const int kr = lane >> 4, nc = (lane & 15) * 4;
#pragma unroll
    for (int i = 0; i < 16; ++i) { const int kk = 4 * i + kr; t.v[i] = __builtin_nontemporal_load((const f32x4*)(W + (size_t)(k0 + kk) * N + n0 + nc));     t.g[i] = gain ? gain[k0 + kk] : 1.0f; }
}
DEV void tr_store(const TrTile& t, bf16* __restrict__ WT, int K, int row_off, int k0, int n0, LAS float* scr, int lane) {
    const int kr = lane >> 4, nc = (lane & 15) * 4;
#pragma unroll
    for (int i = 0; i < 16; ++i) { const int kk = 4 * i + kr; LAS float* s = scr + kk * 65 + nc; s[0] = t.v[i].x * t.g[i]; s[1] = t.v[i].y * t.g[i]; s[2] = t.v[i].z * t.g[i]; s[3] = t.v[i].w * t.g[i]; }
    asm volatile("s_waitcnt lgkmcnt(0)" ::: "memory");
    const int c = lane & 7;
#pragma unroll
    for (int j = 0; j < 8; ++j) { const int n = 8 * j + (lane >> 3); const LAS float* s = scr + (8 * c) * 65 + n;
        u32x4 o; o.x = pk2(s[0 * 65], s[1 * 65]); o.y = pk2(s[2 * 65], s[3 * 65]); o.z = pk2(s[4 * 65], s[5 * 65]); o.w = pk2(s[6 * 65], s[7 * 65]);
        __builtin_nontemporal_store(o, (u32x4*)(WT + (size_t)(row_off + n0 + n) * K + k0 + 8 * c)); }
    asm volatile("s_waitcnt lgkmcnt(0)" ::: "memory");
}
DEV int tr_row_up(int n0) { const int isv = n0 >= DFF ? 1 : 0, m0 = n0 - isv * DFF; return (m0 >> 7) * 256 + isv * 128 + (m0 & 127); }
template <bool UPMAP = false>
DEV void tr_matrix(const Ctx& C, const float* W, int K, int N, const float* gain, bf16* WT, int row_off, int gw_in = -1, int NGW_in = 0, int part_lo = 0, int part_hi = 20, int ldW = 0) {
    LAS float* scr = (LAS float*)(C.lds + C.wave * 16640);
    const int gw = gw_in < 0 ? C.vcu * NWAVES + C.wave : gw_in, NGW = gw_in < 0 ? C.G * NWAVES : NGW_in;
    const int ld = ldW ? ldW : N; const int nblk = N / 64, items_all = (K / 64) * nblk;
    const int it_lo = (int)((long)items_all * part_lo / 20), items = (int)((long)items_all * part_hi / 20);
    if (it_lo + gw >= items) return;
    TrTile cur, nxt;
    { const int kb = (it_lo + gw) / nblk, nb = (it_lo + gw) - kb * nblk; tr_load(cur, W, ld, gain, kb * 64, nb * 64, C.lane); }
    for (int it = it_lo + gw; it < items; it += NGW) { const int kb = it / nblk, nb = it - kb * nblk; const int n0 = nb * 64; int ro = row_off;
        if (UPMAP) { const int isv = n0 >= DFF ? 1 : 0, m0 = n0 - isv * DFF; ro = (m0 >> 7) * 256 + isv * 128 + (m0 & 127) - n0; }
        const int it2 = it + NGW; const bool more = it2 < items;
        if (more) { const int kb2 = it2 / nblk, nb2 = it2 - kb2 * nblk; tr_load(nxt, W, ld, gain, kb2 * 64, nb2 * 64, C.lane); }
        tr_store(cur, WT, K, ro, kb * 64, n0, scr, C.lane);
        if (more) cur = nxt; }
}
template <bool HAS_GAIN>
DEV void tr_wide(const Ctx& C, const float* __restrict__ W, int K, int N, const float* __restrict__ gain, bf16* __restrict__ WT, int row_off, int ld) {
    constexpr int TN = 128, TK = 256, TPB = TK * 2 + 16;
    LAS unsigned char* T = C.lds;
    const int tid = C.tid, quad = tid & 31, rsub = tid >> 5;
    const int nblk = N / TN, items = (K / TK) * nblk;
    int it = C.vcu; if (it >= items) return;
    f32x4 cur[16], nxt[16];
    { const int kb = it / nblk, nb = it - kb * nblk; const float* src = W + (size_t)(kb * TK) * ld + nb * TN + quad * 4;
#pragma unroll
      for (int i = 0; i < 16; ++i) cur[i] = __builtin_nontemporal_load((const f32x4*)(src + (size_t)(4 * (rsub + 16 * (i >> 2)) + (i & 3)) * ld)); }
    for (;;) {
        const int kb = it / nblk, nb = it - kb * nblk, k0 = kb * TK, n0 = nb * TN;
        const int it2 = it + C.G; const bool more = it2 < items;
        if (more) { const int kb2 = it2 / nblk, nb2 = it2 - kb2 * nblk; const float* src = W + (size_t)(kb2 * TK) * ld + nb2 * TN + quad * 4;
#pragma unroll
            for (int i = 0; i < 16; ++i) nxt[i] = __builtin_nontemporal_load((const f32x4*)(src + (size_t)(4 * (rsub + 16 * (i >> 2)) + (i & 3)) * ld)); }
#pragma unroll
        for (int j = 0; j < 4; ++j) { const int rbl = rsub + 16 * j; f32x4 g4 = {1.f, 1.f, 1.f, 1.f}; if constexpr (HAS_GAIN) g4 = *(const f32x4*)(gain + k0 + 4 * rbl);
            LAS unsigned char* tp = T + (quad * 4) * TPB + 16 * ((rbl >> 1) ^ (quad & 7)) + 8 * (rbl & 1);
#pragma unroll
            for (int c = 0; c < 4; ++c) { u32x2 w; w.x = pk2(cur[4 * j + 0][c] * g4.x, cur[4 * j + 1][c] * g4.y); w.y = pk2(cur[4 * j + 2][c] * g4.z, cur[4 * j + 3][c] * g4.w);
                *(LAS u32x2*)(tp + c * TPB) = w; } }
        __syncthreads();
#pragma unroll 4
        for (int j = 0; j < 8; ++j) { const int id = tid + 512 * j, n = id >> 5, ch = id & 31;
            __builtin_nontemporal_store(*(const LAS u32x4*)(T + n * TPB + 16 * (ch ^ ((n >> 2) & 7))), (u32x4*)(WT + (size_t)(row_off + n0 + n) * K + k0 + ch * 8)); }
        __syncthreads();
        if (!more) break;
#pragma unroll
        for (int i = 0; i < 16; ++i) cur[i] = nxt[i];
        it = it2;
    }
}
DEV void w_colmax(const Ctx& C, const float* __restrict__ W, int K, int N, const float* __restrict__ gain, float* __restrict__ cmax, int ld) {
    const int gw = C.vcu * NWAVES + C.wave, NGW = C.G * NWAVES; const int ncb = N / 256, items = (K / 64) * ncb;
    for (int it = gw; it < items; it += NGW) { const int kb = it / ncb, nb = it - kb * ncb; const float* src = W + (size_t)(kb * 64) * ld + nb * 256 + C.lane * 4;
        f32x4 mx = {0.f, 0.f, 0.f, 0.f};
#pragma unroll 1
        for (int k0 = 0; k0 < 64; k0 += 16) { f32x4 v[16];
#pragma unroll
            for (int i = 0; i < 16; ++i) v[i] = __builtin_nontemporal_load((const f32x4*)(src + (size_t)(k0 + i) * ld));
#pragma unroll
            for (int i = 0; i < 16; ++i) { const float gk = gain[kb * 64 + k0 + i]; mx.x = fmaxf(mx.x, fabsf(v[i].x * gk)); mx.y = fmaxf(mx.y, fabsf(v[i].y * gk)); mx.z = fmaxf(mx.z, fabsf(v[i].z * gk)); mx.w = fmaxf(mx.w, fabsf(v[i].w * gk)); } }
        unsigned* dst = (unsigned*)(cmax + nb * 256 + C.lane * 4);
        atomicMax(dst + 0, __float_as_uint(mx.x)); atomicMax(dst + 1, __float_as_uint(mx.y)); atomicMax(dst + 2, __float_as_uint(mx.z)); atomicMax(dst + 3, __float_as_uint(mx.w)); }
}
template <bool UPMAP>
DEV void w_quant(const Ctx& C, const float* __restrict__ W, int K, int N, const float* __restrict__ gain, const float* __restrict__ cmax, signed char* __restrict__ WQ, int ld) {
    LAS float* scr = (LAS float*)(C.lds + C.wave * 16640);
    const int gw = C.vcu * NWAVES + C.wave, NGW = C.G * NWAVES; const int nblk = N / 64, items = (K / 64) * nblk, lane = C.lane;
    for (int it = gw; it < items; it += NGW) { const int kb = it / nblk, nb = it - kb * nblk, k0 = kb * 64, n0 = nb * 64;
        const int kr = lane >> 4, nc = (lane & 15) * 4; f32x4 v[16]; float gk[16];
#pragma unroll
        for (int i = 0; i < 16; ++i) v[i] = __builtin_nontemporal_load((const f32x4*)(W + (size_t)(k0 + 4 * i + kr) * ld + n0 + nc));
#pragma unroll
        for (int i = 0; i < 16; ++i) gk[i] = gain[k0 + 4 * i + kr];
        const f32x4 cm = *(const f32x4*)(cmax + n0 + nc); const f32x4 sc = {cm.x > 0.f ? 127.0f / cm.x : 0.f, cm.y > 0.f ? 127.0f / cm.y : 0.f, cm.z > 0.f ? 127.0f / cm.z : 0.f, cm.w > 0.f ? 127.0f / cm.w : 0.f};
#pragma unroll
        for (int i = 0; i < 16; ++i) { LAS float* sp = scr + (4 * i + kr) * 65 + nc; sp[0] = v[i].x * gk[i] * sc.x; sp[1] = v[i].y * gk[i] * sc.y; sp[2] = v[i].z * gk[i] * sc.z; sp[3] = v[i].w * gk[i] * sc.w; }
        asm volatile("s_waitcnt lgkmcnt(0)" ::: "memory");
        const int c = lane & 3, drow0 = UPMAP ? tr_row_up(n0) : n0;
#pragma unroll
        for (int j = 0; j < 4; ++j) { const int n = 16 * j + (lane >> 2); const LAS float* sp = scr + (16 * c) * 65 + n; u32x4 o;
#pragma unroll
            for (int d = 0; d < 4; ++d) { unsigned w = 0u;
#pragma unroll
                for (int b = 0; b < 4; ++b) w |= ((unsigned)(int)__builtin_rintf(sp[(4 * d + b) * 65]) & 255u) << (8 * b);
                o[d] = w; }
            __builtin_nontemporal_store(o, (u32x4*)(WQ + (size_t)(drow0 + n) * K + k0 + 16 * c)); }
        asm volatile("s_waitcnt lgkmcnt(0)" ::: "memory"); }
}
template <bool UPMAP>
DEV void w_quant_stripe(const Ctx& C, const float* __restrict__ W, int N, const float* __restrict__ gain, float* __restrict__ cmax, signed char* __restrict__ WQ, int ld) {
    constexpr int K = 4096, TP = 4112;
    LAS unsigned char* T = C.lds; LAS float* red = (LAS float*)(C.lds + 32 * TP); LAS float* cm = red + 64 * 32;
    const int tid = C.tid, quad = tid & 7, rsub = tid >> 3;
    for (int st = C.vcu; st < N / 32; st += C.G) { const int n0 = st * 32; const float* src = W + n0 + quad * 4;
        f32x4 mx = {0.f, 0.f, 0.f, 0.f};
#pragma unroll 1
        for (int b = 0; b < 2; ++b) { f32x4 v[32];
#pragma unroll
            for (int i = 0; i < 32; ++i) v[i] = *(const f32x4*)(src + (size_t)(rsub + 64 * (32 * b + i)) * ld);
#pragma unroll
            for (int i = 0; i < 32; ++i) { const float gk = gain[rsub + 64 * (32 * b + i)]; mx.x = fmaxf(mx.x, fabsf(v[i].x * gk)); mx.y = fmaxf(mx.y, fabsf(v[i].y * gk)); mx.z = fmaxf(mx.z, fabsf(v[i].z * gk)); mx.w = fmaxf(mx.w, fabsf(v[i].w * gk)); } }
        *(LAS f32x4*)(red + rsub * 32 + quad * 4) = mx;
        __syncthreads();
        if (tid < 32) { float m = 0.f;
#pragma unroll 8
            for (int r = 0; r < 64; ++r) m = fmaxf(m, red[r * 32 + tid]);
            cm[tid] = m; cmax[n0 + tid] = m; }
        __syncthreads();
        const f32x4 cq = *(const LAS f32x4*)(cm + quad * 4);
        const f32x4 sc = {cq.x > 0.f ? 127.0f / cq.x : 0.f, cq.y > 0.f ? 127.0f / cq.y : 0.f, cq.z > 0.f ? 127.0f / cq.z : 0.f, cq.w > 0.f ? 127.0f / cq.w : 0.f};
#pragma unroll 1
        for (int b = 0; b < 2; ++b) { f32x4 v[32];
#pragma unroll
            for (int i = 0; i < 32; ++i) v[i] = *(const f32x4*)(src + (size_t)(4 * (rsub + 64 * (8 * b + (i >> 2))) + (i & 3)) * ld);
#pragma unroll
            for (int j = 0; j < 8; ++j) { const int rb = rsub + 64 * (8 * b + j); unsigned w0 = 0u, w1 = 0u, w2 = 0u, w3 = 0u;
#pragma unroll
                for (int r = 0; r < 4; ++r) { const float gk = gain[4 * rb + r]; const f32x4 x = v[4 * j + r];
                    w0 |= ((unsigned)(int)__builtin_rintf(x.x * gk * sc.x) & 255u) << (8 * r); w1 |= ((unsigned)(int)__builtin_rintf(x.y * gk * sc.y) & 255u) << (8 * r);
                    w2 |= ((unsigned)(int)__builtin_rintf(x.z * gk * sc.z) & 255u) << (8 * r); w3 |= ((unsigned)(int)__builtin_rintf(x.w * gk * sc.w) & 255u) << (8 * r); }
                LAS unsigned char* tp = T + (quad * 4) * TP + 4 * rb;
                *(LAS unsigned*)(tp) = w0; *(LAS unsigned*)(tp + TP) = w1; *(LAS unsigned*)(tp + 2 * TP) = w2; *(LAS unsigned*)(tp + 3 * TP) = w3; } }
        __syncthreads();
        const int drow0 = UPMAP ? tr_row_up(n0) : n0;
#pragma unroll 4
        for (int j = 0; j < 16; ++j) { const int id = tid + 512 * j, col = id >> 8, ch = id & 255;
            __builtin_nontemporal_store(*(const LAS u32x4*)(T + col * TP + ch * 16), (u32x4*)(WQ + (size_t)(drow0 + col) * K + ch * 16)); }
        __syncthreads();
    }
}
constexpr int CW_QCNT = 65536;
template <bool UPMAP, int LD>
DEV void w_quant_half(const Ctx& C, const float* __restrict__ W, const float* __restrict__ gain, float* __restrict__ cmax, signed char* __restrict__ WQ, unsigned* cnt, int tt) {
    constexpr int K = 4096, KH = 2048, TP = 2064;
    LAS unsigned char* T = C.lds; LAS float* red = (LAS float*)(C.lds + 32 * TP); LAS float* cm = red + 64 * 32;
    const int tid = C.tid, quad = tid & 7, rsub = tid >> 3;
    const int st = tt >> 1, half = tt & 1, n0 = st * 32; const float* src = W + n0 + quad * 4;
    f32x4 v[32];
#pragma unroll
    for (int i = 0; i < 32; ++i) v[i] = __builtin_nontemporal_load((const f32x4*)(src + (size_t)(4 * (rsub + 64 * (8 * half + (i >> 2))) + (i & 3)) * LD));
    f32x4 mx = {0.f, 0.f, 0.f, 0.f};
#pragma unroll
    for (int j = 0; j < 8; ++j) { const f32x4 g4 = *(const f32x4*)(gain + 4 * (rsub + 64 * (8 * half + j)));
#pragma unroll
        for (int r = 0; r < 4; ++r) { f32x4 x = v[4 * j + r] * g4[r]; v[4 * j + r] = x;
            mx.x = fmaxf(mx.x, fabsf(x.x)); mx.y = fmaxf(mx.y, fabsf(x.y)); mx.z = fmaxf(mx.z, fabsf(x.z)); mx.w = fmaxf(mx.w, fabsf(x.w)); } }
    *(LAS f32x4*)(red + rsub * 32 + quad * 4) = mx;
    __syncthreads();
    if (tid < 64) {
        if (tid < 32) { float m = 0.f;
#pragma unroll 8
            for (int r = 0; r < 64; ++r) m = fmaxf(m, red[r * 32 + tid]);
            const unsigned old = __hip_atomic_fetch_max((unsigned*)cmax + n0 + tid, __builtin_bit_cast(unsigned, m), __ATOMIC_RELAXED, __HIP_MEMORY_SCOPE_AGENT);
            asm volatile("" :: "v"(old)); }
        asm volatile("s_waitcnt vmcnt(0)" ::: "memory");
        if (tid == 0) { (void)xb_add(cnt, 1u); unsigned sp = 0u;
            while (xb_ld(cnt) < 2u) { __builtin_amdgcn_s_sleep(1); if (++sp > (1u << 20)) break; } }
        asm volatile("" ::: "memory");
        if (tid < 32) cm[tid] = __builtin_bit_cast(float, xb_ld((unsigned*)cmax + n0 + tid));
    }
    __syncthreads();
    const f32x4 cq = *(const LAS f32x4*)(cm + quad * 4);
    const f32x4 sc = {cq.x > 0.f ? 127.0f / cq.x : 0.f, cq.y > 0.f ? 127.0f / cq.y : 0.f, cq.z > 0.f ? 127.0f / cq.z : 0.f, cq.w > 0.f ? 127.0f / cq.w : 0.f};
#pragma unroll
    for (int j = 0; j < 8; ++j) { const int rbl = rsub + 64 * j; unsigned w0 = 0u, w1 = 0u, w2 = 0u, w3 = 0u;
#pragma unroll
        for (int r = 0; r < 4; ++r) { const f32x4 x = v[4 * j + r];
            w0 |= ((unsigned)(int)__builtin_rintf(x.x * sc.x) & 255u) << (8 * r); w1 |= ((unsigned)(int)__builtin_rintf(x.y * sc.y) & 255u) << (8 * r);
            w2 |= ((unsigned)(int)__builtin_rintf(x.z * sc.z) & 255u) << (8 * r); w3 |= ((unsigned)(int)__builtin_rintf(x.w * sc.w) & 255u) << (8 * r); }
        LAS unsigned char* tp = T + (quad * 4) * TP + 4 * rbl;
        *(LAS unsigned*)(tp) = w0; *(LAS unsigned*)(tp + TP) = w1; *(LAS unsigned*)(tp + 2 * TP) = w2; *(LAS unsigned*)(tp + 3 * TP) = w3; }
    __syncthreads();
    const int drow0 = UPMAP ? tr_row_up(n0) : n0;
#pragma unroll 4
    for (int j = 0; j < 8; ++j) { const int id = tid + 512 * j, col = id >> 7, ch = id & 127;
        __builtin_nontemporal_store(*(const LAS u32x4*)(T + col * TP + ch * 16), (u32x4*)(WQ + (size_t)(drow0 + col) * K + half * KH + ch * 16)); }
    __syncthreads();
}
struct QTask { const float* W; const float* gain; float* cmax; signed char* WQ; unsigned* cnt; int ld, up, n0, part; };
DEV void q_load(f32x4 (&v)[16], const QTask& k, int quad, int rsub) {
    const float* src = k.W + k.n0 + quad * 4;
#pragma unroll
    for (int i = 0; i < 16; ++i) v[i] = __builtin_nontemporal_load((const f32x4*)(src + (size_t)(4 * (rsub + 64 * (4 * k.part + (i >> 2))) + (i & 3)) * k.ld));
}
DEV void w_quant_pipe(const Ctx& C, const float* Win, const float* gin, const float* Wup, const float* gup, float* CMAX, signed char* Qin, signed char* Qup0, signed char* Qup1, unsigned* cntb) {
    constexpr int K = 4096, KQ = 1024, TP = 1040, T_IN = NZI8 / 8, T_UP = NUP / 8, T_ALL = T_IN + 2 * T_UP;
    LAS unsigned char* T = C.lds; LAS float* red = (LAS float*)(C.lds + 32 * TP); LAS float* cm = red + 64 * 32;
    const int tid = C.tid, quad = tid & 7, rsub = tid >> 3;
    auto decode = [&](int t, QTask& k) {
        k.cnt = cntb + (t >> 2); k.part = t & 3;
        if (t < T_IN) { k.W = Win; k.gain = gin; k.cmax = CMAX + 2 * NUP; k.WQ = Qin; k.ld = NIN; k.up = 0; k.n0 = (t >> 2) * 32; }
        else { const int u = t - T_IN, L = u >= T_UP ? 1 : 0, tt = u - L * T_UP;
            k.W = Wup + (size_t)L * DM * NUP; k.gain = gup + L * DM; k.cmax = CMAX + L * NUP; k.WQ = L ? Qup1 : Qup0; k.ld = NUP; k.up = 1; k.n0 = (tt >> 2) * 32; } };
    int t = C.vcu; if (t >= T_ALL) return;
    QTask k; decode(t, k);
    f32x4 cur[16], nxt[16];
    q_load(cur, k, quad, rsub);
    for (;;) {
        f32x4 mx = {0.f, 0.f, 0.f, 0.f};
#pragma unroll
        for (int j = 0; j < 4; ++j) { const f32x4 g4 = *(const f32x4*)(k.gain + 4 * (rsub + 64 * (4 * k.part + j)));
#pragma unroll
            for (int r = 0; r < 4; ++r) { f32x4 x = cur[4 * j + r] * g4[r]; cur[4 * j + r] = x;
                mx.x = fmaxf(mx.x, fabsf(x.x)); mx.y = fmaxf(mx.y, fabsf(x.y)); mx.z = fmaxf(mx.z, fabsf(x.z)); mx.w = fmaxf(mx.w, fabsf(x.w)); } }
        *(LAS f32x4*)(red + rsub * 32 + quad * 4) = mx;
        __syncthreads();
        if (tid < 64) {
            if (tid < 32) { float m = 0.f;
#pragma unroll 8
                for (int r = 0; r < 64; ++r) m = fmaxf(m, red[r * 32 + tid]);
                const unsigned old = __hip_atomic_fetch_max((unsigned*)k.cmax + k.n0 + tid, __builtin_bit_cast(unsigned, m), __ATOMIC_RELAXED, __HIP_MEMORY_SCOPE_AGENT);
                asm volatile("" :: "v"(old)); }
            asm volatile("s_waitcnt vmcnt(0)" ::: "memory");
            if (tid == 0) (void)xb_add(k.cnt, 1u);
        }
        const int t2 = t + C.G; const bool has2 = t2 < T_ALL; QTask k2;
        if (has2) { decode(t2, k2); q_load(nxt, k2, quad, rsub); }
        if (tid < 64) {
            if (tid == 0) { unsigned sp = 0u; while (xb_ld(k.cnt) < 4u) { __builtin_amdgcn_s_sleep(1); if (++sp > (1u << 20)) break; } }
            asm volatile("" ::: "memory");
            if (tid < 32) cm[tid] = __builtin_bit_cast(float, xb_ld((unsigned*)k.cmax + k.n0 + tid));
        }
        __syncthreads();
        const f32x4 cq = *(const LAS f32x4*)(cm + quad * 4);
        const f32x4 sc = {cq.x > 0.f ? 127.0f / cq.x : 0.f, cq.y > 0.f ? 127.0f / cq.y : 0.f, cq.z > 0.f ? 127.0f / cq.z : 0.f, cq.w > 0.f ? 127.0f / cq.w : 0.f};
#pragma unroll
        for (int j = 0; j < 4; ++j) { const int rbl = rsub + 64 * j; unsigned w0 = 0u, w1 = 0u, w2 = 0u, w3 = 0u;
#pragma unroll
            for (int r = 0; r < 4; ++r) { const f32x4 x = cur[4 * j + r];
                w0 |= ((unsigned)(int)__builtin_rintf(x.x * sc.x) & 255u) << (8 * r); w1 |= ((unsigned)(int)__builtin_rintf(x.y * sc.y) & 255u) << (8 * r);
                w2 |= ((unsigned)(int)__builtin_rintf(x.z * sc.z) & 255u) << (8 * r); w3 |= ((unsigned)(int)__builtin_rintf(x.w * sc.w) & 255u) << (8 * r); }
            LAS unsigned char* tp = T + (quad * 4) * TP + 4 * rbl;
            *(LAS unsigned*)(tp) = w0; *(LAS unsigned*)(tp + TP) = w1; *(LAS unsigned*)(tp + 2 * TP) = w2; *(LAS unsigned*)(tp + 3 * TP) = w3; }
        __syncthreads();
        const int drow0 = k.up ? tr_row_up(k.n0) : k.n0;
#pragma unroll
        for (int j = 0; j < 4; ++j) { const int id = tid + 512 * j, col = id >> 6, ch = id & 63;
            __builtin_nontemporal_store(*(const LAS u32x4*)(T + col * TP + ch * 16), (u32x4*)(k.WQ + (size_t)(drow0 + col) * K + k.part * KQ + ch * 16)); }
        __syncthreads();
        if (!has2) break;
#pragma unroll
        for (int i = 0; i < 16; ++i) cur[i] = nxt[i];
        k = k2; t = t2;
    }
}
template <int SC>
DEV void w_quant_wide(const Ctx& C, const float* Win, const float* gin, const float* Wup, const float* gup, float* CMAX, signed char* Qin, signed char* Qup0, signed char* Qup1, unsigned* cntb) {
    constexpr int K = 4096, QN = SC / 4, RP = 2048 / SC, KB = 65536 / SC, P = SC / 16, TP = KB + 16, NCH = KB / 16;
    constexpr int T_IN = (NZI8 / SC) * P, T_UP = (NUP / SC) * P, T_ALL = T_IN + 2 * T_UP;
    LAS unsigned char* T = C.lds; LAS float* red = (LAS float*)(C.lds + SC * TP); LAS float* cm = red + RP * SC;
    const int tid = C.tid, quad = tid % QN, rsub = tid / QN;
    for (int t = C.vcu; t < T_ALL; t += C.G) {
        const float* W; const float* gain; float* cmax; signed char* WQ; int ld, up, tt;
        if (t < T_IN) { W = Win; gain = gin; cmax = CMAX + 2 * NUP; WQ = Qin; ld = NIN; up = 0; tt = t; }
        else { const int u = t - T_IN, L = u >= T_UP ? 1 : 0; tt = u - L * T_UP; W = Wup + (size_t)L * DM * NUP; gain = gup + L * DM; cmax = CMAX + L * NUP; WQ = L ? Qup1 : Qup0; ld = NUP; up = 1; }
        const int n0 = (tt / P) * SC, part = tt % P; unsigned* cnt = cntb + t / P;
        const float* src = W + (size_t)(part * KB) * ld + n0 + quad * 4;
        f32x4 v[32];
#pragma unroll
        for (int i = 0; i < 32; ++i) v[i] = __builtin_nontemporal_load((const f32x4*)(src + (size_t)(4 * (rsub + RP * (i >> 2)) + (i & 3)) * ld));
        f32x4 mx = {0.f, 0.f, 0.f, 0.f};
#pragma unroll
        for (int j = 0; j < 8; ++j) { const f32x4 g4 = *(const f32x4*)(gain + part * KB + 4 * (rsub + RP * j));
#pragma unroll
            for (int r = 0; r < 4; ++r) { f32x4 x = v[4 * j + r] * g4[r]; v[4 * j + r] = x;
                mx.x = fmaxf(mx.x, fabsf(x.x)); mx.y = fmaxf(mx.y, fabsf(x.y)); mx.z = fmaxf(mx.z, fabsf(x.z)); mx.w = fmaxf(mx.w, fabsf(x.w)); } }
        *(LAS f32x4*)(red + rsub * SC + quad * 4) = mx;
        __syncthreads();
        if (tid < SC) { float m = 0.f;
#pragma unroll
            for (int r = 0; r < RP; ++r) m = fmaxf(m, red[r * SC + tid]);
            const unsigned old = __hip_atomic_fetch_max((unsigned*)cmax + n0 + tid, __builtin_bit_cast(unsigned, m), __ATOMIC_RELAXED, __HIP_MEMORY_SCOPE_AGENT);
            asm volatile("" :: "v"(old));
            asm volatile("s_waitcnt vmcnt(0)" ::: "memory"); }
        __syncthreads();
        if (tid == 0) { (void)xb_add(cnt, 1u); unsigned sp = 0u; while (xb_ld(cnt) < (unsigned)P) { __builtin_amdgcn_s_sleep(1); if (++sp > (1u << 20)) break; } }
        __syncthreads();
        if (tid < SC) cm[tid] = __builtin_bit_cast(float, xb_ld((unsigned*)cmax + n0 + tid));
        __syncthreads();
        const f32x4 cq = *(const LAS f32x4*)(cm + quad * 4);
        const f32x4 sc = {cq.x > 0.f ? 127.0f / cq.x : 0.f, cq.y > 0.f ? 127.0f / cq.y : 0.f, cq.z > 0.f ? 127.0f / cq.z : 0.f, cq.w > 0.f ? 127.0f / cq.w : 0.f};
#pragma unroll
        for (int j = 0; j < 8; ++j) { const int rbl = rsub + RP * j; unsigned w0 = 0u, w1 = 0u, w2 = 0u, w3 = 0u;
#pragma unroll
            for (int r = 0; r < 4; ++r) { const f32x4 x = v[4 * j + r];
                w0 |= ((unsigned)(int)__builtin_rintf(x.x * sc.x) & 255u) << (8 * r); w1 |= ((unsigned)(int)__builtin_rintf(x.y * sc.y) & 255u) << (8 * r);
                w2 |= ((unsigned)(int)__builtin_rintf(x.z * sc.z) & 255u) << (8 * r); w3 |= ((unsigned)(int)__builtin_rintf(x.w * sc.w) & 255u) << (8 * r); }
            LAS unsigned char* tp = T + (quad * 4) * TP + 16 * ((rbl >> 2) ^ (quad & 7)) + 4 * (rbl & 3);
            *(LAS unsigned*)(tp) = w0; *(LAS unsigned*)(tp + TP) = w1; *(LAS unsigned*)(tp + 2 * TP) = w2; *(LAS unsigned*)(tp + 3 * TP) = w3; }
        __syncthreads();
#pragma unroll 4
        for (int j = 0; j < 8; ++j) { const int id = tid + 512 * j, col = id / NCH, ch = id % NCH; const int nc = n0 + col, drow = up ? tr_row_up(nc) : nc;
            __builtin_nontemporal_store(*(const LAS u32x4*)(T + col * TP + 16 * (ch ^ ((col >> 2) & 7))), (u32x4*)(WQ + (size_t)drow * K + part * KB + ch * 16)); }
        __syncthreads();
    }
}
DEV void ffn_fixup(const Ctx& C, const float* __restrict__ HALO, bf16* __restrict__ ACT, const float* __restrict__ cw, const float* __restrict__ cb) {
    const int gtid = C.vcu * (NWAVES * 64) + C.tid, nthr = C.G * NWAVES * 64;
    constexpr int NCC = DFF / 4, NT = (SEQ / 256) * NCC;
    for (int it = gtid; it < NT; it += nthr) { const int pm = it / NCC, c0 = (it - pm * NCC) * 4;
        f32x4 r[2][4];
#pragma unroll
        for (int bj = 0; bj < 2; ++bj) {
            r[bj][0] = pm ? *(const f32x4*)(HALO + (size_t)((pm - 1) * 4 + 2) * NUP + bj * DFF + c0) : (f32x4){0.f, 0.f, 0.f, 0.f};
            r[bj][1] = pm ? *(const f32x4*)(HALO + (size_t)((pm - 1) * 4 + 3) * NUP + bj * DFF + c0) : (f32x4){0.f, 0.f, 0.f, 0.f};
            r[bj][2] = *(const f32x4*)(HALO + (size_t)(pm * 4 + 0) * NUP + bj * DFF + c0);
            r[bj][3] = *(const f32x4*)(HALO + (size_t)(pm * 4 + 1) * NUP + bj * DFF + c0); }
        f32x4 w[2][3], b[2];
#pragma unroll
        for (int bj = 0; bj < 2; ++bj) {
#pragma unroll
            for (int k = 0; k < 3; ++k) w[bj][k] = *(const f32x4*)(cw + (size_t)k * NUP + bj * DFF + c0);
            b[bj] = *(const f32x4*)(cb + bj * DFF + c0); }
#pragma unroll
        for (int rr = 0; rr < 2; ++rr) {
            const f32x4 G = b[0] + w[0][0] * r[0][rr] + w[0][1] * r[0][rr + 1] + w[0][2] * r[0][rr + 2];
            const f32x4 V = b[1] + w[1][0] * r[1][rr] + w[1][1] * r[1][rr + 1] + w[1][2] * r[1][rr + 2];
            u32x2 o; o.x = pk2(silu_f(G.x) * V.x, silu_f(G.y) * V.y); o.y = pk2(silu_f(G.z) * V.z, silu_f(G.w) * V.w);
            *(u32x2*)(ACT + (size_t)(pm * 256 + rr) * DFF + c0) = o; }
    }
}

DEV float wave_max(float v) {
#pragma unroll
    for (int o = 1; o < 64; o <<= 1) v = fmaxf(v, __shfl_xor(v, o));
    return v;
}
template <bool HOLD_F32, bool OUT_F32, bool Q8 = false>
DEV void thin_row(const bf16* mixrow, const void* holdv, void* hnewv, const float* gpost, float* rs, int lane, signed char* a8row = nullptr, float* rsq = nullptr) {
    float v[8][8];
    float ss = 0.f;
#pragma unroll
    for (int j = 0; j < 8; ++j) { const u32x4 m = *(const u32x4*)(mixrow + (j * 64 + lane) * 8); unpack8(m, v[j]);
#pragma unroll
        for (int e = 0; e < 8; ++e) ss += v[j][e] * v[j][e]; }
    const float rstd = 1.0f / sqrtf(wave_sum(ss) * (1.0f / DM) + EPS);
    float ss2 = 0.f;
#pragma unroll
    for (int j = 0; j < 8; ++j) { const int c0 = (j * 64 + lane) * 8; float h[8];
        if (HOLD_F32) { const f32x4 h0 = *(const f32x4*)((const float*)holdv + c0), h1 = *(const f32x4*)((const float*)holdv + c0 + 4); h[0] = h0.x; h[1] = h0.y; h[2] = h0.z; h[3] = h0.w; h[4] = h1.x; h[5] = h1.y; h[6] = h1.z; h[7] = h1.w; }
        else unpack8(*(const u32x4*)((const bf16*)holdv + c0), h);
        const f32x4 g0 = *(const f32x4*)(gpost + c0), g1 = *(const f32x4*)(gpost + c0 + 4); const float g[8] = {g0.x, g0.y, g0.z, g0.w, g1.x, g1.y, g1.z, g1.w};
#pragma unroll
        for (int e = 0; e < 8; ++e) v[j][e] = h[e] + v[j][e] * rstd * g[e];
        if (OUT_F32) { *(f32x4*)((float*)hnewv + c0) = (f32x4){v[j][0], v[j][1], v[j][2], v[j][3]}; *(f32x4*)((float*)hnewv + c0 + 4) = (f32x4){v[j][4], v[j][5], v[j][6], v[j][7]}; }
        else { const u32x4 w = pack8(v[j]); *(u32x4*)((bf16*)hnewv + c0) = w; float r[8]; unpack8(w, r);
#pragma unroll
            for (int e = 0; e < 8; ++e) ss2 += r[e] * r[e]; } }
    if (!OUT_F32) { const float rstd2 = 1.0f / sqrtf(wave_sum(ss2) * (1.0f / DM) + EPS); if (lane == 0) *rs = rstd2;
        if constexpr (Q8) {
            float am = 0.f;
#pragma unroll
            for (int j = 0; j < 8; ++j)
#pragma unroll
                for (int e = 0; e < 8; ++e) am = fmaxf(am, fabsf(v[j][e]));
            am = fmaxf(wave_max(am), 1e-30f); const float sq = 127.0f / am;
#pragma unroll
            for (int j = 0; j < 8; ++j) { unsigned lo = 0u, hi = 0u;
#pragma unroll
                for (int e = 0; e < 4; ++e) { lo |= ((unsigned)(int)__builtin_rintf(v[j][e] * sq) & 255u) << (8 * e); hi |= ((unsigned)(int)__builtin_rintf(v[j][4 + e] * sq) & 255u) << (8 * e); }
                u32x2 w; w.x = lo; w.y = hi; *(u32x2*)(a8row + (j * 64 + lane) * 8) = w; }
            if (lane == 0) *rsq = rstd2 * am * (1.0f / 127.0f); } }
}
template <bool HOLD_F32, bool OUT_F32, bool Q8 = false>
DEV void thin_phase(const Ctx& C, const bf16* mix, const void* hold, void* hnew, const float* gpost, float* RS, signed char* A8 = nullptr, float* RSQ = nullptr) {
    const int gw = C.vcu * NWAVES + C.wave, NGW = C.G * NWAVES;
    for (int r = gw; r < SEQ; r += NGW) thin_row<HOLD_F32, OUT_F32, Q8>(mix + (size_t)r * DM, (const char*)hold + (size_t)r * DM * (HOLD_F32 ? 4 : 2), (char*)hnew + (size_t)r * DM * (OUT_F32 ? 4 : 2), gpost, RS + r, C.lane,
                                                                          Q8 ? A8 + (size_t)r * DM : nullptr, Q8 ? RSQ + r : nullptr);
}
DEV void xnorm_phase(const Ctx& C, const float* xin, bf16* abuf, signed char* a8, float* rsq) {
    const int gw = C.vcu * NWAVES + C.wave, NGW = C.G * NWAVES;
    for (int r = gw; r < SEQ; r += NGW) { const float* xr = xin + (size_t)r * DM; bf16* ar = abuf + (size_t)r * DM; float v[8][8]; float ss = 0.f, am = 0.f;
#pragma unroll
        for (int j = 0; j < 8; ++j) { const int c0 = (j * 64 + C.lane) * 8; const f32x4 h0 = *(const f32x4*)(xr + c0), h1 = *(const f32x4*)(xr + c0 + 4);
            v[j][0] = h0.x; v[j][1] = h0.y; v[j][2] = h0.z; v[j][3] = h0.w; v[j][4] = h1.x; v[j][5] = h1.y; v[j][6] = h1.z; v[j][7] = h1.w;
#pragma unroll
            for (int e = 0; e < 8; ++e) { ss += v[j][e] * v[j][e]; am = fmaxf(am, fabsf(v[j][e])); } }
        const float rstd = 1.0f / sqrtf(wave_sum(ss) * (1.0f / DM) + EPS);
        am = fmaxf(wave_max(am), 1e-30f); const float sq = 127.0f / am;
#pragma unroll
        for (int j = 0; j < 8; ++j) { float o[8]; unsigned lo = 0u, hi = 0u;
#pragma unroll
            for (int e = 0; e < 8; ++e) o[e] = v[j][e] * rstd;
            *(u32x4*)(ar + (j * 64 + C.lane) * 8) = pack8(o);
#pragma unroll
            for (int e = 0; e < 4; ++e) { lo |= ((unsigned)(int)__builtin_rintf(v[j][e] * sq) & 255u) << (8 * e); hi |= ((unsigned)(int)__builtin_rintf(v[j][4 + e] * sq) & 255u) << (8 * e); }
            u32x2 w; w.x = lo; w.y = hi; *(u32x2*)(a8 + (size_t)r * DM + (j * 64 + C.lane) * 8) = w; }
        if (C.lane == 0) rsq[r] = rstd * am * (1.0f / 127.0f); }
}

DEV void dt_gemm(const Ctx& C, const bf16* __restrict__ A, const bf16* __restrict__ Bt, float* __restrict__ out) {
    const int r16 = C.lane & 15, kq = C.lane >> 4; LAS float* part = (LAS float*)C.lds;
    for (int rb = C.vcu; rb < SEQ / 32; rb += C.G) {
        const bf16* a0 = A + (size_t)(rb * 32 + r16) * DM + C.wave * 512 + kq * 8; const bf16* a1 = a0 + (size_t)16 * DM;
        const bf16* b0 = Bt + (size_t)r16 * DM + C.wave * 512 + kq * 8;
        f32x4 acc[2][8];
#pragma unroll
        for (int m = 0; m < 2; ++m)
#pragma unroll
            for (int n = 0; n < 8; ++n) acc[m][n] = (f32x4){0.f, 0.f, 0.f, 0.f};
#pragma unroll 2
        for (int ks = 0; ks < 16; ++ks) {
            const bf16x8 fa0 = *(const bf16x8*)(a0 + ks * 32), fa1 = *(const bf16x8*)(a1 + ks * 32); bf16x8 fb[8];
#pragma unroll
            for (int n = 0; n < 8; ++n) fb[n] = *(const bf16x8*)(b0 + (size_t)(16 * n) * DM + ks * 32);
#pragma unroll
            for (int n = 0; n < 8; ++n) { acc[0][n] = __builtin_amdgcn_mfma_f32_16x16x32_bf16(fa0, fb[n], acc[0][n], 0, 0, 0); acc[1][n] = __builtin_amdgcn_mfma_f32_16x16x32_bf16(fa1, fb[n], acc[1][n], 0, 0, 0); }
        }
#pragma unroll
        for (int m = 0; m < 2; ++m)
#pragma unroll
            for (int n = 0; n < 8; ++n)
#pragma unroll
                for (int r = 0; r < 4; ++r) part[(C.wave * 32 + m * 16 + kq * 4 + r) * 128 + n * 16 + r16] = acc[m][n][r];
        __syncthreads();
#pragma unroll
        for (int i = 0; i < 2; ++i) { const int e = (C.tid + 512 * i) * 4;
            f32x4 sum = *(const LAS f32x4*)(part + e);
#pragma unroll
            for (int w = 1; w < 8; ++w) sum += *(const LAS f32x4*)(part + w * 4096 + e);
            *(f32x4*)(out + (size_t)rb * 32 * 128 + e) = sum; }
        __syncthreads();
    }
}

DEV void ssd_prep(const Ctx& C, const float* __restrict__ dtraw, const float* __restrict__ dtbias, const float* __restrict__ alog, float* __restrict__ DT, float* __restrict__ ACUM) {
    LAS float* segsum = (LAS float*)C.lds;
    for (int c = C.vcu; c < NCHUNK; c += C.G) {
        const int h = C.tid & 127, seg = C.tid >> 7; const float bias = dtbias[h], Aneg = -__expf(alog[h]);
        const size_t o0 = (size_t)(c * CHUNK + seg * 32) * NHEAD + h;
        float xr[32];
#pragma unroll
        for (int i = 0; i < 32; ++i) xr[i] = dtraw[o0 + (size_t)i * NHEAD];
        float run = 0.f;
#pragma unroll
        for (int i = 0; i < 32; ++i) { const float xx = xr[i] + bias; const float dt = fmaxf(xx, 0.f) + log1pf(__expf(-fabsf(xx))); DT[o0 + (size_t)i * NHEAD] = dt; run += dt * Aneg; xr[i] = run; }
        segsum[seg * 128 + h] = run;
        __syncthreads();
        float pre = 0.f;
#pragma unroll
        for (int k = 0; k < 3; ++k) pre += (k < seg) ? segsum[k * 128 + h] : 0.f;
#pragma unroll
        for (int i = 0; i < 32; ++i) ACUM[o0 + (size_t)i * NHEAD] = xr[i] + pre;
        __syncthreads();
    }
}

#define MFMA32(a, b, c) __builtin_amdgcn_mfma_f32_32x32x16_bf16((a), (b), (c), 0, 0, 0)
constexpr int LROW = 272;
DEV void transpose8x8(const u32x4 (&r)[8], u32x4 (&o)[8]) {
#pragma unroll
    for (int c2 = 0; c2 < 4; ++c2) {
        const unsigned a0 = r[0][c2], a1 = r[1][c2], a2 = r[2][c2], a3 = r[3][c2], a4 = r[4][c2], a5 = r[5][c2], a6 = r[6][c2], a7 = r[7][c2];
        o[2 * c2].x = __builtin_amdgcn_perm(a1, a0, 0x05040100u); o[2 * c2].y = __builtin_amdgcn_perm(a3, a2, 0x05040100u); o[2 * c2].z = __builtin_amdgcn_perm(a5, a4, 0x05040100u); o[2 * c2].w = __builtin_amdgcn_perm(a7, a6, 0x05040100u);
        o[2 * c2 + 1].x = __builtin_amdgcn_perm(a1, a0, 0x07060302u); o[2 * c2 + 1].y = __builtin_amdgcn_perm(a3, a2, 0x07060302u); o[2 * c2 + 1].z = __builtin_amdgcn_perm(a5, a4, 0x07060302u); o[2 * c2 + 1].w = __builtin_amdgcn_perm(a7, a6, 0x07060302u); }
}
DEV void conv8x8(const bf16* __restrict__ ZX, size_t t0, int ch0, const float* __restrict__ cw, const float* __restrict__ cb, u32x4 (&r)[8]) {
    const bf16* src = ZX + DINNER + ch0;
    u32x4 raw[11];
#pragma unroll
    for (int k = 0; k < 3; ++k) raw[k] = t0 ? *(const u32x4*)(src + (t0 - 3 + k) * NZX) : (u32x4){0u, 0u, 0u, 0u};
#pragma unroll
    for (int k = 0; k < 8; ++k) raw[3 + k] = *(const u32x4*)(src + (t0 + k) * NZX);
    float w[4][8], b[8];
#pragma unroll
    for (int k = 0; k < 4; ++k) { const f32x4 a = *(const f32x4*)(cw + k * CONVD + ch0), bq = *(const f32x4*)(cw + k * CONVD + ch0 + 4); w[k][0] = a.x; w[k][1] = a.y; w[k][2] = a.z; w[k][3] = a.w; w[k][4] = bq.x; w[k][5] = bq.y; w[k][6] = bq.z; w[k][7] = bq.w; }
    { const f32x4 a = *(const f32x4*)(cb + ch0), bq = *(const f32x4*)(cb + ch0 + 4); b[0] = a.x; b[1] = a.y; b[2] = a.z; b[3] = a.w; b[4] = bq.x; b[5] = bq.y; b[6] = bq.z; b[7] = bq.w; }
    float x3[8], x2[8], x1[8]; unpack8(raw[0], x3); unpack8(raw[1], x2); unpack8(raw[2], x1);
#pragma unroll
    for (int k = 0; k < 8; ++k) { float x0[8], o[8]; unpack8(raw[3 + k], x0);
#pragma unroll
        for (int e = 0; e < 8; ++e) { o[e] = silu_f(b[e] + w[0][e] * x3[e] + w[1][e] * x2[e] + w[2][e] * x1[e] + w[3][e] * x0[e]); x3[e] = x2[e]; x2[e] = x1[e]; x1[e] = x0[e]; }
        r[k] = pack8(o); }
}
DEV void ssd_states_unit(const Ctx& C, int c, int g, const bf16* __restrict__ ZX, const float* __restrict__ cw, const float* __restrict__ cb, const float* __restrict__ DT, const float* __restrict__ ACUM, bf16* __restrict__ S) {
    LAS unsigned char* BT = C.lds; LAS unsigned char* XW = C.lds + 34816; LAS float* wtab = (LAS float*)(C.lds + 104448);
    const int tid = C.tid, lane = C.lane, wave = C.wave, hh = lane >> 5, l31 = lane & 31;
    const size_t row0 = (size_t)c * CHUNK;
    for (int idx = tid; idx < 2048; idx += 512) { const int r = idx & 15, s = idx >> 4, h = g * HPG + r;
        const float alast = ACUM[(row0 + 127) * NHEAD + h]; const size_t o = (row0 + s) * NHEAD + h;
        wtab[r * 128 + s] = DT[o] * __expf(alast - ACUM[o]); }
    if (tid < 256) {
        const int so = tid & 15, oct = tid >> 4;
        u32x4 r[8], o[8];
        conv8x8(ZX, row0 + so * 8, DINNER + g * DSTATE + oct * 8, cw, cb, r);
        transpose8x8(r, o);
#pragma unroll
        for (int cc = 0; cc < 8; ++cc) *(LAS u32x4*)(BT + (oct * 8 + cc) * LROW + so * 16) = o[cc]; }
    __syncthreads();
    for (int q = 0; q < 4; ++q) {
        {
            const int so = tid & 15, oct = tid >> 4, r = 4 * q + (oct >> 3);
            u32x4 rr[8], o[8];
            conv8x8(ZX, row0 + so * 8, g * 1024 + q * 256 + oct * 8, cw, cb, rr);
            const f32x4 w0 = *(const LAS f32x4*)(wtab + r * 128 + so * 8), w1 = *(const LAS f32x4*)(wtab + r * 128 + so * 8 + 4);
            transpose8x8(rr, o);
#pragma unroll
            for (int cc = 0; cc < 8; ++cc) { float f[8]; unpack8(o[cc], f);
                u32x4 w; w.x = pk2(f[0] * w0.x, f[1] * w0.y); w.y = pk2(f[2] * w0.z, f[3] * w0.w); w.z = pk2(f[4] * w1.x, f[5] * w1.y); w.w = pk2(f[6] * w1.z, f[7] * w1.w);
                *(LAS u32x4*)(XW + (oct * 8 + cc) * LROW + so * 16) = w; } }
        __syncthreads();
        const int rq = wave >> 1, ph = wave & 1;
        f32x16 acc[4];
#pragma unroll
        for (int nt = 0; nt < 4; ++nt)
#pragma unroll
            for (int e = 0; e < 16; ++e) acc[nt][e] = 0.f;
        const LAS unsigned char* xrow = XW + (rq * 64 + ph * 32 + l31) * LROW + hh * 16;
        const LAS unsigned char* brow = BT + l31 * LROW + hh * 16;
#pragma unroll
        for (int ks = 0; ks < 8; ++ks) { const bf16x8 xb = *(const LAS bf16x8*)(xrow + ks * 32);
#pragma unroll
            for (int nt = 0; nt < 4; ++nt) { const bf16x8 a = *(const LAS bf16x8*)(brow + nt * 32 * LROW + ks * 32); acc[nt] = MFMA32(a, xb, acc[nt]); } }
        const int h = g * HPG + 4 * q + rq;
        bf16* dst = S + ((((size_t)c * NHEAD + h) * 2 + ph) * 8) * 512 + lane * 8;
#pragma unroll
        for (int nt = 0; nt < 4; ++nt)
#pragma unroll
            for (int s2 = 0; s2 < 2; ++s2) { u32x4 w; w.x = pk2(acc[nt][8 * s2 + 0], acc[nt][8 * s2 + 1]); w.y = pk2(acc[nt][8 * s2 + 2], acc[nt][8 * s2 + 3]); w.z = pk2(acc[nt][8 * s2 + 4], acc[nt][8 * s2 + 5]); w.w = pk2(acc[nt][8 * s2 + 6], acc[nt][8 * s2 + 7]);
                *(u32x4*)(dst + (2 * nt + s2) * 512) = w; }
        __syncthreads();
    }
}
DEV void ssd_scan(const Ctx& C, const bf16* __restrict__ S, const float* __restrict__ ACUM, bf16* __restrict__ ST) {
    const int gtid = C.vcu * (NWAVES * 64) + C.tid, nthr = C.G * NWAVES * 64;
    constexpr size_t CSTRIDE = (size_t)NHEAD * HDIM * DSTATE;
    for (int idx = gtid; idx < NHEAD * HDIM * DSTATE / 8; idx += nthr) {
        const int h = idx >> 10; const size_t base = (size_t)idx * 8;
        float run[8];
#pragma unroll
        for (int e = 0; e < 8; ++e) run[e] = 0.f;
#pragma unroll 1
        for (int cb = 0; cb < NCHUNK; cb += 16) { u32x4 raw[16]; float dec[16];
#pragma unroll
            for (int k = 0; k < 16; ++k) { raw[k] = __builtin_nontemporal_load((const u32x4*)(S + (cb + k) * CSTRIDE + base)); dec[k] = ACUM[((size_t)(cb + k) * CHUNK + 127) * NHEAD + h]; }
#pragma unroll
            for (int k = 0; k < 16; ++k) { float sv[8]; unpack8(raw[k], sv); const float d = __expf(dec[k]);
                *(u32x4*)(ST + (cb + k) * CSTRIDE + base) = pack8(run);
#pragma unroll
                for (int e = 0; e < 8; ++e) run[e] = run[e] * d + sv[e]; } }
    }
}
DEV void ssd_groupnorm_g(bf16* Y, size_t r0, int g, int wave, int lane) {
    for (int rr = wave; rr < CHUNK; rr += NWAVES) { bf16* p = Y + (r0 + rr) * DINNER + g * 1024 + lane * 16;
        float a[8], b[8]; unpack8(*(const u32x4*)p, a); unpack8(*(const u32x4*)(p + 8), b); float ss = 0.f;
#pragma unroll
        for (int e = 0; e < 8; ++e) ss += a[e] * a[e] + b[e] * b[e];
        const float rstd = 1.0f / sqrtf(wave_sum(ss) * (1.0f / 1024.0f) + SSM_EPS);
#pragma unroll
        for (int e = 0; e < 8; ++e) { a[e] *= rstd; b[e] *= rstd; }
        *(u32x4*)p = pack8(a); *(u32x4*)(p + 8) = pack8(b); }
}
constexpr int YROW = 528;
DEV void ssd_out_unit(const Ctx& C, int c, int g, const float* __restrict__ cw, const float* __restrict__ cb, const bf16* __restrict__ ZX, const float* __restrict__ DT, const float* __restrict__ ACUM,
                      const bf16* __restrict__ ST, const float* __restrict__ dskip, bf16* __restrict__ Y) {
    LAS unsigned char* CM = C.lds; LAS unsigned char* BM = C.lds + 34816; LAS unsigned char* XT = C.lds + 69632;
    LAS float* atab = (LAS float*)(C.lds + 139264); LAS float* dtab = (LAS float*)(C.lds + 147456); LAS float* ttab = (LAS float*)(C.lds + 155648);
    const int tid0 = C.tid, lane = C.lane, wave = C.wave, hh = lane >> 5, l31 = lane & 31;
    const size_t row0 = (size_t)c * CHUNK;
    { const int tid = tid0;
    {
        const int isc = tid >> 8, so = tid & 15, oct = (tid >> 4) & 15; u32x4 r[8];
        conv8x8(ZX, row0 + so * 8, DINNER + isc * NGRP * DSTATE + g * DSTATE + oct * 8, cw, cb, r);
        LAS unsigned char* dstm = isc ? CM : BM;
#pragma unroll
        for (int j = 0; j < 8; ++j) *(LAS u32x4*)(dstm + (so * 8 + j) * LROW + oct * 16) = r[j]; }
    for (int idx = tid; idx < 2048; idx += 512) { const int r = idx & 15, s = idx >> 4; const size_t o = (row0 + s) * NHEAD + g * HPG + r; atab[r * 128 + s] = ACUM[o]; dtab[r * 128 + s] = DT[o]; } }
    __syncthreads();
    {
        const int lt = wave >> 1, st0 = 2 * (wave & 1);
        f32x16 cb[2];
#pragma unroll
        for (int t = 0; t < 2; ++t)
#pragma unroll
            for (int e = 0; e < 16; ++e) cb[t][e] = 0.f;
        const LAS unsigned char* arow = CM + (lt * 32 + l31) * LROW + hh * 16;
        const LAS unsigned char* brow = BM + (st0 * 32 + l31) * LROW + hh * 16;
#pragma unroll
        for (int ks = 0; ks < 8; ++ks) { const bf16x8 a = *(const LAS bf16x8*)(arow + ks * 32);
#pragma unroll
            for (int t = 0; t < 2; ++t) { const bf16x8 b = *(const LAS bf16x8*)(brow + t * 32 * LROW + ks * 32); cb[t] = MFMA32(a, b, cb[t]); } }
        __syncthreads();
#pragma unroll
        for (int t = 0; t < 2; ++t)
#pragma unroll
            for (int e = 0; e < 16; ++e) { const int l = lt * 32 + (e & 3) + 8 * (e >> 2) + 4 * hh, s = (st0 + t) * 32 + l31;
                *(LAS unsigned short*)(BM + l * LROW + s * 2) = f2bf(cb[t][e]); }
    }
    __syncthreads();
    float ssq[8];
#pragma unroll
    for (int i = 0; i < 8; ++i) ssq[i] = 0.f;
    for (int q = 0; q < 4; ++q) {
        int tid = tid0; asm volatile("" : "+v"(tid));
        const int ch = tid & 31, lrow = tid >> 5;
        const int rq = wave >> 1, r = 4 * q + rq, h = g * HPG + r; const float Dk = dskip[h];
        const bf16* stp = ST + (((size_t)c * NHEAD + h) * 2 * 8) * 512 + lane * 8;
        bf16x8 sb[8][2];
        {
            const int so = tid & 15, oct = tid >> 4;
            u32x4 rr[8], o[8];
            conv8x8(ZX, row0 + so * 8, g * 1024 + q * 256 + oct * 8, cw, cb, rr);
            transpose8x8(rr, o);
#pragma unroll
            for (int cc = 0; cc < 8; ++cc) *(LAS u32x4*)(XT + (oct * 8 + cc) * LROW + so * 16) = o[cc]; }
#ifdef P4_FACT
        { const int rl = tid >> 7, s_ = tid & 127, rr_ = (4 * q + rl) * 128;
          ttab[rl * 128 + s_] = __expf(atab[rr_ + (s_ | 7)] - atab[rr_ + s_]) * dtab[rr_ + s_]; }
#endif
        asm volatile("" ::: "memory");
#pragma unroll
        for (int ks = 0; ks < 8; ++ks) { sb[ks][0] = *(const bf16x8*)(stp + ks * 512); sb[ks][1] = *(const bf16x8*)(stp + (8 + ks) * 512); }
        __syncthreads();
        const int lt0 = (wave & 1) ? 1 : 0, lt1 = (wave & 1) ? 2 : 3;
        const int l0 = lt0 * 32 + l31, l1 = lt1 * 32 + l31;
        const float al0 = atab[r * 128 + l0], al1 = atab[r * 128 + l1]; const float eal0 = __expf(al0), eal1 = __expf(al1);
        f32x16 acc[2][2];
#pragma unroll
        for (int li = 0; li < 2; ++li)
#pragma unroll
            for (int pt = 0; pt < 2; ++pt)
#pragma unroll
                for (int e = 0; e < 16; ++e) acc[li][pt][e] = 0.f;
#pragma unroll
        for (int ks = 0; ks < 8; ++ks) {
            const bf16x8 b0 = sb[ks][0], b1 = sb[ks][1];
            float f[8]; { const u32x2 c0 = *(const LAS u32x2*)(CM + l0 * LROW + ks * 32 + hh * 8), c1 = *(const LAS u32x2*)(CM + l0 * LROW + ks * 32 + 16 + hh * 8); u32x4 cw; cw.x = c0.x; cw.y = c0.y; cw.z = c1.x; cw.w = c1.y; unpack8(cw, f); }
#pragma unroll
            for (int j = 0; j < 8; ++j) f[j] *= eal0;
            const bf16x8 a0 = __builtin_bit_cast(bf16x8, pack8(f));
            { const u32x2 c0 = *(const LAS u32x2*)(CM + l1 * LROW + ks * 32 + hh * 8), c1 = *(const LAS u32x2*)(CM + l1 * LROW + ks * 32 + 16 + hh * 8); u32x4 cw; cw.x = c0.x; cw.y = c0.y; cw.z = c1.x; cw.w = c1.y; unpack8(cw, f); }
#pragma unroll
            for (int j = 0; j < 8; ++j) f[j] *= eal1;
            const bf16x8 a1 = __builtin_bit_cast(bf16x8, pack8(f));
            acc[0][0] = MFMA32(a0, b0, acc[0][0]); acc[0][1] = MFMA32(a0, b1, acc[0][1]); acc[1][0] = MFMA32(a1, b0, acc[1][0]); acc[1][1] = MFMA32(a1, b1, acc[1][1]); }
#ifdef P4_FACT
        for (int ks = 0; ks < 2 * lt1 + 2; ++ks) { const int s0 = ks * 16 + hh * 8;
            const bf16x8 b0 = *(const LAS bf16x8*)(XT + (rq * 64 + l31) * LROW + s0 * 2), b1 = *(const LAS bf16x8*)(XT + (rq * 64 + 32 + l31) * LROW + s0 * 2);
            float f[8];
            if (ks < 2 * lt1) {
                const f32x4 t0 = *(const LAS f32x4*)(ttab + rq * 128 + s0), t1 = *(const LAS f32x4*)(ttab + rq * 128 + s0 + 4); const float aref = atab[r * 128 + s0 + 7];
                const float tt[8] = {t0.x, t0.y, t0.z, t0.w, t1.x, t1.y, t1.z, t1.w};
                const float E1 = __expf(al1 - aref);
                unpack8(*(const LAS u32x4*)(BM + l1 * LROW + s0 * 2), f);
#pragma unroll
                for (int j = 0; j < 8; ++j) f[j] = f[j] * (E1 * tt[j]);
                const bf16x8 a1 = __builtin_bit_cast(bf16x8, pack8(f));
                acc[1][0] = MFMA32(a1, b0, acc[1][0]); acc[1][1] = MFMA32(a1, b1, acc[1][1]);
                if (ks < 2 * lt0) {
                    const float E0 = __expf(al0 - aref);
                    unpack8(*(const LAS u32x4*)(BM + l0 * LROW + s0 * 2), f);
#pragma unroll
                    for (int j = 0; j < 8; ++j) f[j] = f[j] * (E0 * tt[j]);
                    const bf16x8 a0 = __builtin_bit_cast(bf16x8, pack8(f));
                    acc[0][0] = MFMA32(a0, b0, acc[0][0]); acc[0][1] = MFMA32(a0, b1, acc[0][1]); }
                else if (ks < 2 * lt0 + 2) {
                    const f32x4 q0 = *(const LAS f32x4*)(atab + r * 128 + s0), q1 = *(const LAS f32x4*)(atab + r * 128 + s0 + 4), d0 = *(const LAS f32x4*)(dtab + r * 128 + s0), d1 = *(const LAS f32x4*)(dtab + r * 128 + s0 + 4);
                    const float as[8] = {q0.x, q0.y, q0.z, q0.w, q1.x, q1.y, q1.z, q1.w}, ds[8] = {d0.x, d0.y, d0.z, d0.w, d1.x, d1.y, d1.z, d1.w};
                    unpack8(*(const LAS u32x4*)(BM + l0 * LROW + s0 * 2), f);
#pragma unroll
                    for (int j = 0; j < 8; ++j) { f[j] = (s0 + j <= l0) ? f[j] * __expf(al0 - as[j]) * ds[j] : 0.f; if (s0 + j == l0) f[j] += Dk; }
                    const bf16x8 a0 = __builtin_bit_cast(bf16x8, pack8(f));
                    acc[0][0] = MFMA32(a0, b0, acc[0][0]); acc[0][1] = MFMA32(a0, b1, acc[0][1]); } }
            else {
                const f32x4 q0 = *(const LAS f32x4*)(atab + r * 128 + s0), q1 = *(const LAS f32x4*)(atab + r * 128 + s0 + 4), d0 = *(const LAS f32x4*)(dtab + r * 128 + s0), d1 = *(const LAS f32x4*)(dtab + r * 128 + s0 + 4);
                const float as[8] = {q0.x, q0.y, q0.z, q0.w, q1.x, q1.y, q1.z, q1.w}, ds[8] = {d0.x, d0.y, d0.z, d0.w, d1.x, d1.y, d1.z, d1.w};
                unpack8(*(const LAS u32x4*)(BM + l1 * LROW + s0 * 2), f);
#pragma unroll
                for (int j = 0; j < 8; ++j) { f[j] = (s0 + j <= l1) ? f[j] * __expf(al1 - as[j]) * ds[j] : 0.f; if (s0 + j == l1) f[j] += Dk; }
                const bf16x8 a1 = __builtin_bit_cast(bf16x8, pack8(f));
                acc[1][0] = MFMA32(a1, b0, acc[1][0]); acc[1][1] = MFMA32(a1, b1, acc[1][1]); } }
#else
        for (int ks = 0; ks < 2 * lt1 + 2; ++ks) { const int s0 = ks * 16 + hh * 8;
            const bf16x8 b0 = *(const LAS bf16x8*)(XT + (rq * 64 + l31) * LROW + s0 * 2), b1 = *(const LAS bf16x8*)(XT + (rq * 64 + 32 + l31) * LROW + s0 * 2);
            const f32x4 q0 = *(const LAS f32x4*)(atab + r * 128 + s0), q1 = *(const LAS f32x4*)(atab + r * 128 + s0 + 4), d0 = *(const LAS f32x4*)(dtab + r * 128 + s0), d1 = *(const LAS f32x4*)(dtab + r * 128 + s0 + 4);
            const float as[8] = {q0.x, q0.y, q0.z, q0.w, q1.x, q1.y, q1.z, q1.w}, ds[8] = {d0.x, d0.y, d0.z, d0.w, d1.x, d1.y, d1.z, d1.w};
            float f[8]; unpack8(*(const LAS u32x4*)(BM + l1 * LROW + s0 * 2), f);
#pragma unroll
            for (int j = 0; j < 8; ++j) { f[j] = (s0 + j <= l1) ? f[j] * __expf(al1 - as[j]) * ds[j] : 0.f; if (s0 + j == l1) f[j] += Dk; }
            const bf16x8 a1 = __builtin_bit_cast(bf16x8, pack8(f));
            acc[1][0] = MFMA32(a1, b0, acc[1][0]); acc[1][1] = MFMA32(a1, b1, acc[1][1]);
            if (ks < 2 * lt0 + 2) {
                unpack8(*(const LAS u32x4*)(BM + l0 * LROW + s0 * 2), f);
#pragma unroll
                for (int j = 0; j < 8; ++j) { f[j] = (s0 + j <= l0) ? f[j] * __expf(al0 - as[j]) * ds[j] : 0.f; if (s0 + j == l0) f[j] += Dk; }
                const bf16x8 a0 = __builtin_bit_cast(bf16x8, pack8(f));
                acc[0][0] = MFMA32(a0, b0, acc[0][0]); acc[0][1] = MFMA32(a0, b1, acc[0][1]); } }
#endif
        __syncthreads();
#pragma unroll
        for (int li = 0; li < 2; ++li)
#pragma unroll
            for (int pt = 0; pt < 2; ++pt)
#pragma unroll
                for (int e = 0; e < 16; ++e) { const int le = (li ? lt1 : lt0) * 32 + (e & 3) + 8 * (e >> 2) + 4 * hh;
                    *(LAS unsigned short*)(XT + le * YROW + (rq * 64 + pt * 32 + l31) * 2) = f2bf(acc[li][pt][e]); }
        __syncthreads();
#pragma unroll
        for (int i = 0; i < 8; ++i) { const int l = lrow + 16 * i; const size_t colg = (size_t)g * 1024 + q * 256 + ch * 8;
            float ys[8], zs[8]; unpack8(*(const LAS u32x4*)(XT + l * YROW + ch * 16), ys); unpack8(__builtin_nontemporal_load((const u32x4*)(ZX + (row0 + l) * NZX + colg)), zs);
#pragma unroll
            for (int j = 0; j < 8; ++j) ys[j] = ys[j] * silu_f(zs[j]);
            const u32x4 w = pack8(ys); *(u32x4*)(Y + (row0 + l) * DINNER + colg) = w; unpack8(w, ys);
            float s = 0.f;
#pragma unroll
            for (int j = 0; j < 8; ++j) s += ys[j] * ys[j];
            ssq[i] += s; }
        __syncthreads();
    }
    asm volatile("s_waitcnt vmcnt(0)" ::: "memory");
    int tid = tid0; asm volatile("" : "+v"(tid));
    const int ch = tid & 31, lrow = tid >> 5;
#pragma unroll
    for (int i = 0; i < 8; ++i) { float s = ssq[i]; s += __shfl_xor(s, 1); s += __shfl_xor(s, 2); s += __shfl_xor(s, 4); s += __shfl_xor(s, 8); s += __shfl_xor(s, 16); ssq[i] = 1.0f / sqrtf(s * (1.0f / 1024.0f) + SSM_EPS); }
#pragma unroll
    for (int qp = 0; qp < 2; ++qp) { u32x4 raw[2][8];
#pragma unroll
        for (int q2 = 0; q2 < 2; ++q2)
#pragma unroll
            for (int i = 0; i < 8; ++i) raw[q2][i] = *(const u32x4*)(Y + (row0 + lrow + 16 * i) * DINNER + (size_t)g * 1024 + (2 * qp + q2) * 256 + ch * 8);
#pragma unroll
        for (int q2 = 0; q2 < 2; ++q2)
#pragma unroll
            for (int i = 0; i < 8; ++i) { float v[8]; unpack8(raw[q2][i], v);
#pragma unroll
                for (int j = 0; j < 8; ++j) v[j] *= ssq[i];
                *(u32x4*)(Y + (row0 + lrow + 16 * i) * DINNER + (size_t)g * 1024 + (2 * qp + q2) * 256 + ch * 8) = pack8(v); } }
}

DEV int t5_bucket(int rel) { if (rel < 16) return rel; const int v = 16 + (int)(logf((float)rel * (1.0f / 16.0f)) / logf(8.0f) * 16.0f); return v < 31 ? v : 31; }

constexpr int KROW = 144;
constexpr int VROW = 528;
DEV void attn_unit(const Ctx& C, int qb, int g, const bf16* __restrict__ Q, const bf16* __restrict__ KV, bf16* __restrict__ O, const float* __restrict__ sinks, const float* __restrict__ relb) {
    LAS unsigned char* KT = C.lds; LAS unsigned char* VT = C.lds + 36864; LAS float* btab = (LAS float*)(C.lds + 70656);
    const int tid = C.tid, lane = C.lane, wave = C.wave, hh = lane >> 5, l31 = lane & 31;
#pragma unroll
    for (int i = 0; i < 4; ++i) { const int task = tid + 512 * i, ch = task & 7, kr = task >> 3; const int row = (qb - 1) * 128 + kr;
        u32x4 kv = {0u, 0u, 0u, 0u}, vv = {0u, 0u, 0u, 0u};
        if (row >= 0) { const bf16* src = KV + (size_t)row * 1024 + g * 64 + ch * 8; kv = *(const u32x4*)src; vv = *(const u32x4*)(src + 512); }
        *(LAS u32x4*)(KT + kr * KROW + ch * 16) = kv;
        LAS unsigned short* vd = (LAS unsigned short*)(VT + (ch * 8) * VROW + kr * 2);
        vd[0 * (VROW / 2)] = (unsigned short)(vv.x & 0xffffu); vd[1 * (VROW / 2)] = (unsigned short)(vv.x >> 16); vd[2 * (VROW / 2)] = (unsigned short)(vv.y & 0xffffu); vd[3 * (VROW / 2)] = (unsigned short)(vv.y >> 16);
        vd[4 * (VROW / 2)] = (unsigned short)(vv.z & 0xffffu); vd[5 * (VROW / 2)] = (unsigned short)(vv.z >> 16); vd[6 * (VROW / 2)] = (unsigned short)(vv.w & 0xffffu); vd[7 * (VROW / 2)] = (unsigned short)(vv.w >> 16); }
    for (int idx = tid; idx < 1024; idx += 512) { const int w = idx >> 7, rel = idx & 127; btab[idx] = relb[t5_bucket(rel) * 64 + g * 8 + w]; }
    __syncthreads();
    const int hq = g * 8 + wave; const float sink = sinks[hq];
    for (int qt = 0; qt < 4; ++qt) {
        const size_t qrow = (size_t)qb * 128 + qt * 32 + l31;
        bf16x8 qf[4];
#pragma unroll
        for (int ks = 0; ks < 4; ++ks) qf[ks] = *(const bf16x8*)(Q + qrow * DM + hq * 64 + ks * 16 + hh * 8);
        f32x16 sc[5];
#pragma unroll
        for (int i = 0; i < 5; ++i) {
#pragma unroll
            for (int e = 0; e < 16; ++e) sc[i][e] = 0.f;
#pragma unroll
            for (int ks = 0; ks < 4; ++ks) { const bf16x8 a = *(const LAS bf16x8*)(KT + ((qt + i) * 32 + l31) * KROW + ks * 32 + hh * 16); sc[i] = MFMA32(a, qf[ks], sc[i]); } }
        float mx = -3.0e38f;
#pragma unroll
        for (int i = 0; i < 5; ++i)
#pragma unroll
            for (int e = 0; e < 16; ++e) { const int kl = (e & 3) + 8 * (e >> 2) + 4 * hh;
                const int rel = l31 - kl + 128 - 32 * i; const int key = (qt + i) * 32 + kl;
                const bool valid = (rel >= 0) && (rel < 128) && (qb > 0 || key >= 128);
                const float s = sc[i][e] + btab[wave * 128 + (rel & 127)];
                sc[i][e] = valid ? s : -3.0e38f; mx = fmaxf(mx, sc[i][e]); }
        mx = fmaxf(mx, __shfl_xor(mx, 32)); mx = fmaxf(mx, sink);
        float lsum = 0.f;
#pragma unroll
        for (int i = 0; i < 5; ++i)
#pragma unroll
            for (int e = 0; e < 16; ++e) { const float p = (sc[i][e] > -1.0e38f) ? __expf(sc[i][e] - mx) : 0.f; sc[i][e] = p; lsum += p; }
        lsum += __shfl_xor(lsum, 32);
        const float inv = 1.0f / (lsum + __expf(sink - mx));
        f32x16 oa[2];
#pragma unroll
        for (int dt = 0; dt < 2; ++dt)
#pragma unroll
            for (int e = 0; e < 16; ++e) oa[dt][e] = 0.f;
#pragma unroll
        for (int i = 0; i < 5; ++i)
#pragma unroll
            for (int s2 = 0; s2 < 2; ++s2) {
                asm volatile("" ::: "memory");
                u32x4 pw; pw.x = pk2(sc[i][8 * s2 + 0], sc[i][8 * s2 + 1]); pw.y = pk2(sc[i][8 * s2 + 2], sc[i][8 * s2 + 3]); pw.z = pk2(sc[i][8 * s2 + 4], sc[i][8 * s2 + 5]); pw.w = pk2(sc[i][8 * s2 + 6], sc[i][8 * s2 + 7]);
                const bf16x8 pb = __builtin_bit_cast(bf16x8, pw);
#pragma unroll
                for (int dt = 0; dt < 2; ++dt) { const LAS unsigned char* vp = VT + (dt * 32 + l31) * VROW + ((qt + i) * 32 + 16 * s2 + 4 * hh) * 2;
                    const u32x2 v0 = *(const LAS u32x2*)vp, v1 = *(const LAS u32x2*)(vp + 16);
                    u32x4 aw; aw.x = v0.x; aw.y = v0.y; aw.z = v1.x; aw.w = v1.y;
                    oa[dt] = MFMA32(__builtin_bit_cast(bf16x8, aw), pb, oa[dt]); } }
        bf16* op = O + qrow * DM + hq * 64 + 4 * hh;
#pragma unroll
        for (int dt = 0; dt < 2; ++dt)
#pragma unroll
            for (int g4 = 0; g4 < 4; ++g4) { u32x2 w; w.x = pk2(oa[dt][4 * g4] * inv, oa[dt][4 * g4 + 1] * inv); w.y = pk2(oa[dt][4 * g4 + 2] * inv, oa[dt][4 * g4 + 3] * inv);
                *(u32x2*)(op + dt * 32 + 8 * g4) = w; }
    }
    __syncthreads();
}

#ifndef REP_PRO
#define REP_PRO 1
#endif
#ifndef REP_GEMM_IN
#define REP_GEMM_IN 1
#endif
#ifndef REP_GEMM_OUT
#define REP_GEMM_OUT 1
#endif
#ifndef REP_GEMM_UP
#define REP_GEMM_UP 1
#endif
#ifndef REP_GEMM_DN
#define REP_GEMM_DN 1
#endif
#ifndef REP_GEMM_KVQ
#define REP_GEMM_KVQ 1
#endif
#ifndef REP_GEMM_O
#define REP_GEMM_O 1
#endif
#ifndef REP_PREP
#define REP_PREP 1
#endif
#ifndef REP_P2
#define REP_P2 1
#endif
#ifndef REP_P3
#define REP_P3 1
#endif
#ifndef REP_P4
#define REP_P4 1
#endif
#ifndef REP_THIN
#define REP_THIN 1
#endif
#ifndef REP_CONV
#define REP_CONV 1
#endif
#ifndef REP_ATT
#define REP_ATT 1
#endif
struct Args { const float* in[26]; float* out; unsigned char* ws; };
enum { I_X = 0, I_NMPRE, I_NMPOST, I_NFPRE, I_NFPOST, I_WIN, I_SCW, I_SCB, I_DTB, I_ALOG, I_D, I_SNORM, I_WOUT, I_KVN, I_WKV, I_BKV, I_WQ, I_BQ, I_SINK, I_WO, I_BO, I_RELB, I_WUP, I_FCW, I_FCB, I_WDN };

#ifndef GEMM_ALIGN
#define GEMM_ALIGN true
#endif
#ifndef GEMM_SP2
#define GEMM_SP2 true
#endif
#define IDLE_SLOT(n_units, W_, K_, N_, gain_, WT_, lo_, hi_) do { const int ex_ = (n_units) % C.G; \
    const int iw_ = ex_ > 0 ? ((int)blockIdx.x - ex_) * NWAVES + C.wave : (int)blockIdx.x * NWAVES + C.wave, in_ = ex_ > 0 ? (C.G - ex_) * NWAVES : C.G * NWAVES;     \
    if (iw_ >= 0) tr_matrix(C, (W_), (K_), (N_), (gain_), (WT_), 0, iw_, in_, (lo_), (hi_)); } while (0)
#define RUN_GEMM_I8(EpiT, Aptr, Btptr, N_, K8_, Eobj) do { pg8::Gemm g_{(const pg8::bf16_t*)(Aptr), (const pg8::bf16_t*)(Btptr), SEQ, (N_), (K8_) / 2}; pg8::StaticOrder S_; S_.init(SEQ, (N_), C.G, (int)blockIdx.x); \
    pg8::gemm_phase<EpiT, pg8::StaticOrder, GEMM_ALIGN, GEMM_SP2, true>(C.lds, g_, S_, Eobj); } while (0)
#define RUN_GEMM(EpiT, Aptr, Btptr, N_, K_, Eobj) do { pg8::Gemm g_{(const pg8::bf16_t*)(Aptr), (const pg8::bf16_t*)(Btptr), SEQ, (N_), (K_)}; pg8::StaticOrder S_; S_.init(SEQ, (N_), C.G, (int)blockIdx.x); \
    pg8::gemm_phase<EpiT, pg8::StaticOrder, GEMM_ALIGN, GEMM_SP2>(C.lds, g_, S_, Eobj); } while (0)

__global__ void __launch_bounds__(NWAVES * 64, 2) mk_fwd(Args args) {
    extern __shared__ __attribute__((aligned(16))) unsigned char lds_raw[];
    Ctx C; C.lds = (LAS unsigned char*)lds_raw; C.tid = threadIdx.x; C.lane = C.tid & 63; C.wave = __builtin_amdgcn_readfirstlane(C.tid >> 6);
    C.G = gridDim.x; { const int bx = blockIdx.x; C.vcu = (C.G % 8 == 0) ? (bx % 8) * (C.G / 8) + bx / 8 : bx; }
    volatile LAS unsigned* MISC = (volatile LAS unsigned*)(C.lds + MISC_OFF);
    if (C.tid < 64) MISC[C.tid] = 0u;
    __syncthreads();
    unsigned char* ws = args.ws;
    gu32* ctl = (gu32*)(ws + WS_CTL);
    XcdBarrier bar = xcd_barrier_post((unsigned*)(ctl + CW_BAR), MISC + 8);
#define GRID_BAR() xcd_barrier(bar)
    const float* x = args.in[I_X]; float* out = args.out;
    bf16* Win_bc = (bf16*)(ws + WS_WIN + 64 * MiB);     bf16* Wout_t = (bf16*)(ws + WS_WOUT); bf16* Wkvq_t = (bf16*)(ws + WS_WKVQ); bf16* Wo_t = (bf16*)(ws + WS_WO);
    bf16* Abuf = (bf16*)(ws + WS_A); bf16* MIX = (bf16*)(ws + WS_MIX);
    float* DTRAW = (float*)(ws + WS_DTRAW); float* DT = (float*)(ws + WS_DT); float* ACUM = (float*)(ws + WS_ACUM);
    bf16* ZX = (bf16*)(ws + WS_ZX); bf16* Y = (bf16*)(ws + WS_Y);
    bf16* Sbuf = (bf16*)(ws + WS_S); bf16* STb = (bf16*)(ws + WS_ST);
    bf16* ACT = (bf16*)(ws + WS_ACT); float* HALO = (float*)(ws + WS_HALO); float* RS = (float*)(ws + WS_RS); float* RSQ = (float*)(ws + WS_RSQ); float* CMAX = (float*)(ws + WS_CMAX); signed char* A8 = (signed char*)(ws + WS_A8);
    bf16* Qb = (bf16*)(ws + WS_Q); bf16* KVb = (bf16*)(ws + WS_KV); bf16* Ob = (bf16*)(ws + WS_O);

#define PHASE(rep, ...) do { __VA_ARGS__; GRID_BAR(); if constexpr ((rep) > 1) { __VA_ARGS__; GRID_BAR(); } } while (0)
    PHASE(REP_PRO,
#if defined(ZHI8) && defined(TRWIDE)
        tr_wide<true>(C, args.in[I_WIN], DM, QCOL0, args.in[I_NMPRE], Win_bc, 0, NIN);
        tr_wide<true>(C, args.in[I_WIN] + 2 * DINNER, DM, NIN - 2 * DINNER, args.in[I_NMPRE], Win_bc, QCOL0, NIN);
#elif defined(ZHI8) && defined(BCI8)
        tr_matrix(C, args.in[I_WIN], DM, QCOL0, args.in[I_NMPRE], Win_bc, 0, -1, 0, 0, 20, NIN);
        tr_matrix(C, args.in[I_WIN] + NZX, DM, NIN - NZX, args.in[I_NMPRE], Win_bc, QCOL0, -1, 0, 0, 20, NIN);
#elif defined(ZHI8)
        tr_matrix(C, args.in[I_WIN], DM, QCOL0, args.in[I_NMPRE], Win_bc, 0, -1, 0, 0, 20, NIN);
        tr_matrix(C, args.in[I_WIN] + 2 * DINNER, DM, NIN - 2 * DINNER, args.in[I_NMPRE], Win_bc, QCOL0, -1, 0, 0, 20, NIN);
#elif defined(XBCI8)
        tr_matrix(C, args.in[I_WIN], DM, DINNER, args.in[I_NMPRE], Win_bc, 0, -1, 0, 0, 20, NIN);
        tr_matrix(C, args.in[I_WIN] + NZX, DM, NIN - NZX, args.in[I_NMPRE], Win_bc, DINNER, -1, 0, 0, 20, NIN);
#elif defined(ZXI8)
        tr_matrix(C, args.in[I_WIN] + 2 * DINNER, DM, NIN - 2 * DINNER, args.in[I_NMPRE], Win_bc, 0, -1, 0, 0, 20, NIN);
#else
        tr_matrix(C, args.in[I_WIN], DM, DINNER, args.in[I_NMPRE], Win_bc, 0, -1, 0, 0, 20, NIN);
        tr_matrix(C, args.in[I_WIN] + 2 * DINNER, DM, NIN - 2 * DINNER, args.in[I_NMPRE], Win_bc, DINNER, -1, 0, 0, 20, NIN);
#endif
#ifdef TRWIDE
        tr_wide<true>(C, args.in[I_WOUT], DINNER, DM, args.in[I_SNORM], Wout_t, 0, DM);
#else
        tr_matrix(C, args.in[I_WOUT], DINNER, DM, args.in[I_SNORM], Wout_t, 0);
#endif
#ifndef TRWIDE
        tr_matrix(C, args.in[I_WDN], DFF, DM, nullptr, (bf16*)(ws + WS_WDN0), 0, -1, 0, 0, 9);
#endif
#ifdef TRWIDE
        tr_wide<true>(C, args.in[I_WKV], DM, 1024, args.in[I_KVN], Wkvq_t, 0, 1024);
        tr_wide<true>(C, args.in[I_WQ], DM, DM, args.in[I_NMPRE] + DM, Wkvq_t, 1024, DM);
        tr_matrix(C, args.in[I_WDN], DFF, DM, nullptr, (bf16*)(ws + WS_WDN0), 0, -1, 0, 0, 9);
#else
        tr_matrix(C, args.in[I_WKV], DM, 1024, args.in[I_KVN], Wkvq_t, 0);
#ifndef QI8
        tr_matrix(C, args.in[I_WQ], DM, DM, args.in[I_NMPRE] + DM, Wkvq_t, 1024);
#endif
#endif
        xnorm_phase(C, x, Abuf, (signed char*)MIX, RSQ);
        __syncthreads();
#ifdef QWIDE
        w_quant_wide<QWIDE>(C, args.in[I_WIN] + QCOL0, args.in[I_NMPRE], args.in[I_WUP], args.in[I_NFPRE], CMAX, (signed char*)(ws + WS_WIN), (signed char*)(ws + WS_WUP0), (signed char*)(ws + WS_WUP1), (unsigned*)(ctl + CW_QCNT)));
#elif defined(QPIPE)
        w_quant_pipe(C, args.in[I_WIN] + QCOL0, args.in[I_NMPRE], args.in[I_WUP], args.in[I_NFPRE], CMAX, (signed char*)(ws + WS_WIN), (signed char*)(ws + WS_WUP0), (signed char*)(ws + WS_WUP1), (unsigned*)(ctl + CW_QCNT)));
#else
#ifdef QI8
        { constexpr int T_IN = NZI8 / 16, T_UP = NUP / 16, T_Q = DM / 16;
          for (int t = C.vcu; t < T_IN + 2 * T_UP + T_Q; t += C.G) {
              if (t < T_IN) w_quant_half<false, NIN>(C, args.in[I_WIN] + QCOL0, args.in[I_NMPRE], CMAX + 2 * NUP, (signed char*)(ws + WS_WIN), (unsigned*)(ctl + CW_QCNT) + (t >> 1), t);
              else if (t < T_IN + 2 * T_UP) { const int u = t - T_IN, L = u >= T_UP ? 1 : 0;
                  w_quant_half<true, NUP>(C, args.in[I_WUP] + (size_t)L * DM * NUP, args.in[I_NFPRE] + L * DM, CMAX + L * NUP, (signed char*)(ws + (L ? WS_WUP1 : WS_WUP0)), (unsigned*)(ctl + CW_QCNT) + (t >> 1), u - L * T_UP); }
              else w_quant_half<false, DM>(C, args.in[I_WQ], args.in[I_NMPRE] + DM, CMAX + 2 * NUP + 16384, (signed char*)(ws + WS_WKVQ + 8 * MiB), (unsigned*)(ctl + CW_QCNT) + (t >> 1), t - T_IN - 2 * T_UP); } });
#else
        { constexpr int T_IN = NZI8 / 16, T_UP = NUP / 16;
          for (int t = C.vcu; t < T_IN + 2 * T_UP; t += C.G) {
              if (t < T_IN) w_quant_half<false, NIN>(C, args.in[I_WIN] + QCOL0, args.in[I_NMPRE], CMAX + 2 * NUP, (signed char*)(ws + WS_WIN), (unsigned*)(ctl + CW_QCNT) + (t >> 1), t);
              else { const int u = t - T_IN, L = u >= T_UP ? 1 : 0;
                  w_quant_half<true, NUP>(C, args.in[I_WUP] + (size_t)L * DM * NUP, args.in[I_NFPRE] + L * DM, CMAX + L * NUP, (signed char*)(ws + (L ? WS_WUP1 : WS_WUP0)), (unsigned*)(ctl + CW_QCNT) + (t >> 1), u - L * T_UP); } } });
#endif
#endif

#ifdef ZHI8
    PHASE(REP_GEMM_IN, { pg8::EpiOutI8 E{(pg8::bf16_t*)(ZX + QCOL0), NZX, nullptr, 1.0f, RSQ, CMAX + 2 * NUP}; RUN_GEMM_I8(pg8::EpiOutI8, (signed char*)MIX, ws + WS_WIN, NZI8, DM, E); }
#ifdef BCI8
        { pg8::EpiOut E{(pg8::bf16_t*)ZX, NZX, nullptr, 1.0f, nullptr, nullptr}; RUN_GEMM(pg8::EpiOut, Abuf, Win_bc, NBC, DM, E); }
#else
        { pg8::EpiZBC E{{(pg8::bf16_t*)ZX, NZX, nullptr, 1.0f, nullptr, nullptr}}; RUN_GEMM(pg8::EpiZBC, Abuf, Win_bc, NBC, DM, E); }
#endif
#elif defined(XBCI8)
    PHASE(REP_GEMM_IN, { pg8::EpiOutI8 E{(pg8::bf16_t*)(ZX + DINNER), NZX, nullptr, 1.0f, RSQ, CMAX + 2 * NUP}; RUN_GEMM_I8(pg8::EpiOutI8, (signed char*)MIX, ws + WS_WIN, NZI8, DM, E); }
        { pg8::EpiOut E{(pg8::bf16_t*)ZX, NZX, nullptr, 1.0f, nullptr, nullptr}; RUN_GEMM(pg8::EpiOut, Abuf, Win_bc, NBC, DM, E); }
#elif defined(ZXI8)
    PHASE(REP_GEMM_IN, { pg8::EpiOutI8 E{(pg8::bf16_t*)ZX, NZX, nullptr, 1.0f, RSQ, CMAX + 2 * NUP}; RUN_GEMM_I8(pg8::EpiOutI8, (signed char*)MIX, ws + WS_WIN, NZI8, DM, E); }
        { pg8::EpiOut E{(pg8::bf16_t*)(ZX + NZI8), NZX, nullptr, 1.0f, nullptr, nullptr}; RUN_GEMM(pg8::EpiOut, Abuf, Win_bc, NBC, DM, E); }
#else
    PHASE(REP_GEMM_IN, { pg8::EpiOutI8 E{(pg8::bf16_t*)(ZX + DINNER), NZX, nullptr, 1.0f, RSQ, CMAX + 2 * NUP}; RUN_GEMM_I8(pg8::EpiOutI8, (signed char*)MIX, ws + WS_WIN, NZI8, DM, E); }
        { pg8::EpiZBC E{{(pg8::bf16_t*)ZX, NZX, nullptr, 1.0f, nullptr, nullptr}}; RUN_GEMM(pg8::EpiZBC, Abuf, Win_bc, NBC, DM, E); }
#endif
        dt_gemm(C, Abuf, Win_bc + (size_t)NBC * DM, DTRAW));
    PHASE(REP_PREP, ssd_prep(C, DTRAW, args.in[I_DTB], args.in[I_ALOG], DT, ACUM));
    PHASE(REP_P2, for (int u = C.vcu; u < NCHUNK * NGRP; u += C.G) ssd_states_unit(C, u >> 3, u & 7, ZX, args.in[I_SCW], args.in[I_SCB], DT, ACUM, Sbuf));
    PHASE(REP_P3, ssd_scan(C, Sbuf, ACUM, STb));
    PHASE(REP_P4, for (int u = C.vcu; u < NCHUNK * NGRP; u += C.G) ssd_out_unit(C, u >> 3, u & 7, args.in[I_SCW], args.in[I_SCB], ZX, DT, ACUM, STb, args.in[I_D], Y));
    PHASE(REP_GEMM_OUT, { pg8::EpiOut E{(pg8::bf16_t*)MIX, DM, nullptr, 1.0f, nullptr, nullptr}; RUN_GEMM(pg8::EpiOut, Y, Wout_t, DM, DINNER, E); });
    PHASE(REP_THIN, thin_phase<true, false, true>(C, MIX, x, Abuf, args.in[I_NMPOST], RS, A8, RSQ));
    PHASE(REP_GEMM_UP, { pg8::EpiConvGateI8 E{CMAX, (pg8::bf16_t*)ACT, HALO, args.in[I_FCW], args.in[I_FCB], (LAS float*)(C.lds + 131072), DFF, NUP, RSQ}; RUN_GEMM_I8(pg8::EpiConvGateI8, A8, ws + WS_WUP0, NUP, DM, E); }
        IDLE_SLOT((SEQ / 256) * (NUP / 256), args.in[I_WDN], DFF, DM, nullptr, (bf16*)(ws + WS_WDN0), 9, 20));
    PHASE(REP_CONV, ffn_fixup(C, HALO, ACT, args.in[I_FCW], args.in[I_FCB]));
    PHASE(REP_GEMM_DN, { pg8::EpiOut E{(pg8::bf16_t*)MIX, DM, nullptr, 1.0f, nullptr, nullptr}; RUN_GEMM(pg8::EpiOut, ACT, ws + WS_WDN0, DM, DFF, E); });
#ifdef QI8
    PHASE(1, thin_phase<false, false, true>(C, MIX, Abuf, Abuf, args.in[I_NFPOST], RS, (signed char*)(ws + WS_BIG + 160 * MiB), RSQ));
#else
    PHASE(1, thin_phase<false, false>(C, MIX, Abuf, Abuf, args.in[I_NFPOST], RS));
#endif

#ifdef QI8
    PHASE(REP_GEMM_KVQ, { pg8::EpiOutI8 E{(pg8::bf16_t*)Qb, DM, args.in[I_BQ], 0.125f, RSQ, CMAX + 2 * NUP + 16384}; RUN_GEMM_I8(pg8::EpiOutI8, (signed char*)(ws + WS_BIG + 160 * MiB), ws + WS_WKVQ + 8 * MiB, DM, DM, E); }
        { pg8::EpiOut E{(pg8::bf16_t*)KVb, 1024, args.in[I_BKV], 1.0f, RS, nullptr}; RUN_GEMM(pg8::EpiOut, Abuf, Wkvq_t, 1024, DM, E); }
        IDLE_SLOT((SEQ / 256) * (1024 / 256), args.in[I_WO], DM, DM, nullptr, Wo_t, 0, 20);
        IDLE_SLOT((SEQ / 256) * (1024 / 256), args.in[I_WDN] + (size_t)DFF * DM, DFF, DM, nullptr, (bf16*)(ws + WS_WDN1), 0, 12));
#else
    PHASE(REP_GEMM_KVQ, { pg8::EpiKVQ E{(pg8::bf16_t*)KVb, (pg8::bf16_t*)Qb, args.in[I_BKV], args.in[I_BQ], 0.125f, RS}; RUN_GEMM(pg8::EpiKVQ, Abuf, Wkvq_t, NKVQ, DM, E); }
        IDLE_SLOT((SEQ / 256) * (NKVQ / 256), args.in[I_WO], DM, DM, nullptr, Wo_t, 0, 20);
        IDLE_SLOT((SEQ / 256) * (NKVQ / 256), args.in[I_WDN] + (size_t)DFF * DM, DFF, DM, nullptr, (bf16*)(ws + WS_WDN1), 0, 12));
#endif
    PHASE(REP_ATT, for (int u = C.vcu; u < (SEQ / 128) * 8; u += C.G) attn_unit(C, u >> 3, u & 7, Qb, KVb, Ob, args.in[I_SINK], args.in[I_RELB]));
    PHASE(REP_GEMM_O, { pg8::EpiOut E{(pg8::bf16_t*)MIX, DM, args.in[I_BO], 1.0f, nullptr, nullptr}; RUN_GEMM(pg8::EpiOut, Ob, Wo_t, DM, DM, E); });
    PHASE(1, thin_phase<false, false, true>(C, MIX, Abuf, Abuf, args.in[I_NMPOST] + DM, RS, A8, RSQ));
    PHASE(1, { pg8::EpiConvGateI8 E{CMAX + NUP, (pg8::bf16_t*)ACT, HALO, args.in[I_FCW] + 3 * NUP, args.in[I_FCB] + NUP, (LAS float*)(C.lds + 131072), DFF, NUP, RSQ}; RUN_GEMM_I8(pg8::EpiConvGateI8, A8, ws + WS_WUP1, NUP, DM, E); }
        IDLE_SLOT((SEQ / 256) * (NUP / 256), args.in[I_WDN] + (size_t)DFF * DM, DFF, DM, nullptr, (bf16*)(ws + WS_WDN1), 12, 20));
    PHASE(1, ffn_fixup(C, HALO, ACT, args.in[I_FCW] + 3 * NUP, args.in[I_FCB] + NUP));
    PHASE(1, { pg8::EpiOut E{(pg8::bf16_t*)MIX, DM, nullptr, 1.0f, nullptr, nullptr}; RUN_GEMM(pg8::EpiOut, ACT, ws + WS_WDN1, DM, DFF, E); });
    thin_phase<false, true>(C, MIX, Abuf, out, args.in[I_NFPOST] + DM, RS);
}

extern "C" void kernel_launch(void* const* d_in, const int* in_sizes, int n_in, void* d_out, int out_size, void* d_ws, size_t ws_size, hipStream_t stream) {
    static int grid = 0;
    if (grid == 0) {
        if (n_in != 26 || in_sizes[0] != SEQ * DM || out_size != SEQ * DM || ws_size < WS_END) { fprintf(stderr, "kernel_launch: unexpected shapes: n_in %d in0 %d out %d ws %zu (need %zu)\n", n_in, n_in > 0 ? in_sizes[0] : -1, out_size, ws_size, (size_t)WS_END); grid = -1; return; }
        int dev = 0, cus = 0, per_cu = 0;
        if (hipGetDevice(&dev) != hipSuccess || hipDeviceGetAttribute(&cus, hipDeviceAttributeMultiprocessorCount, dev) != hipSuccess) { fprintf(stderr, "kernel_launch: device query failed\n"); grid = -1; return; }
        if (hipFuncSetAttribute((const void*)mk_fwd, hipFuncAttributeMaxDynamicSharedMemorySize, LDS_BYTES) != hipSuccess) { fprintf(stderr, "kernel_launch: hipFuncSetAttribute failed\n"); grid = -1; return; }
        if (hipOccupancyMaxActiveBlocksPerMultiprocessor(&per_cu, (const void*)mk_fwd, NWAVES * 64, LDS_BYTES) != hipSuccess || per_cu < 1) fprintf(stderr, "kernel_launch: occupancy query reports %d\n", per_cu);
        (void)hipGetLastError();
        grid = cus;
    }
    if (grid < 0) return;
    if (hipMemsetAsync((char*)d_ws + WS_CTL, 0, CTL_ZERO_BYTES, stream) != hipSuccess) { fprintf(stderr, "kernel_launch: memset failed\n"); return; }
    Args a{};
    for (int i = 0; i < 26; ++i) a.in[i] = (const float*)d_in[i];
    a.out = (float*)d_out; a.ws = (unsigned char*)d_ws;
    hipLaunchKernelGGL(mk_fwd, dim3(grid), dim3(NWAVES * 64), LDS_BYTES, stream, a);
    const hipError_t le = hipPeekAtLastError();
    if (le != hipSuccess) fprintf(stderr, "kernel_launch: launch failed: %s\n", hipGetErrorName(le));
}
```

```cpp
#define ZHI8 1
#define ZHI8_Q0 2048
#define PG8_ZB_TILES 8
#define PG8_ZB_SHIFT 56
#define QI8 1
#include <hip/hip_runtime.h>
#include <cstdio>
#include <cstdint>
#ifndef PG8_WGM
#define PG8_WGM 8
#endif
namespace pg8 {
#define PG8_LAS __attribute__((address_space(3)))
typedef unsigned short bf16_t;
typedef short bf16x8 __attribute__((ext_vector_type(8)));
typedef float f32x4 __attribute__((ext_vector_type(4)));
typedef unsigned u32x4 __attribute__((ext_vector_type(4)));
constexpr int BM = 256, BK = 64, HALF = 128, HTB = HALF * BK * 2  , STAGE_BYTES = 8 * HTB, NXCD = 8, WGM = PG8_WGM;

__host__ __device__ __forceinline__ int lds_byte(int r, int c) { const int st = (r >> 4) * 2 + (c >> 5), rr = r & 15, cc = c & 31, ob = rr * 64 + cc * 2; return st * 1024 + (ob ^ (((ob >> 9) & 1) << 5)); }
__host__ __device__ __forceinline__ void stage_rc(int b, int& R, int& C) { const int st = b / 1024, sb = b % 1024, swz = sb ^ (((sb >> 9) & 1) << 5); R = (st >> 1) * 16 + swz / 64; C = (st & 1) * 32 + (swz % 64) / 2; }
__host__ __device__ __forceinline__ int perm32(int rho) { const int n = rho >> 4, i = rho & 15; return 8 * (i >> 2) + 4 * n + (i & 3); }

struct Unit { int pm, pn; };
struct Gemm { const bf16_t* A; const bf16_t* Bt; int M, N, K; };

struct StaticOrder {
    int nM, nN, nwg, G, c;
    __host__ __device__ void init(int M, int N, int G_, int c_) { nM = M / BM; nN = N / BM; nwg = nM * nN; G = G_; c = c_; }
    __host__ __device__ bool next(int i, Unit& u) const {
        const long L = (long)i * G + c; if (L >= nwg) return false;
        int wgid = (int)L; { const int q = nwg / NXCD, r = nwg % NXCD, xcd = wgid % NXCD, off = wgid / NXCD; wgid = (xcd < r ? xcd * (q + 1) : r * (q + 1) + (xcd - r) * q) + off; }
        const int nig = WGM * nN, gid = wgid / nig, fm = gid * WGM, gsz = (nM - fm) < WGM ? (nM - fm) : WGM;
        u.pm = fm + ((wgid % nig) % gsz); u.pn = (wgid % nig) / gsz; return true;
    }
    __device__ __forceinline__ void a_ready(const Unit&) const {}
    __device__ __forceinline__ void done(const Unit&) const {}
};

typedef __bf16 bf16v2_t __attribute__((ext_vector_type(2)));
typedef float f32x2_t __attribute__((ext_vector_type(2)));
typedef unsigned u32x2 __attribute__((ext_vector_type(2)));
__device__ __forceinline__ unsigned cvt_pk_bf16(float lo, float hi) { bf16v2_t v = __builtin_convertvector((f32x2_t){lo, hi}, bf16v2_t); return __builtin_bit_cast(unsigned, v); }

template <bool I8> struct EpiOutT {
    static constexpr bool PERM = true, AFTER_DRAIN = false;
    bf16_t* O; int ldc; const float* bias; float scale; const float* rowscale; const float* colmax;
    __device__ __forceinline__ void operator()(const f32x4 (&acc)[2][2][4][2], const Unit& u, int wr, int wc, int fr, int fq) const {
        const int row0 = u.pm * BM + wr * 64 + fr; const int col0 = u.pn * BM + wc * 32 + 8 * fq;
        float rs[2][4];
#pragma unroll
        for (int ai = 0; ai < 2; ++ai)
#pragma unroll
            for (int m = 0; m < 4; ++m) rs[ai][m] = rowscale ? rowscale[row0 + ai * HALF + m * 16] : 1.0f;
        f32x4 bv[2][2];
#pragma unroll
        for (int bj = 0; bj < 2; ++bj)
#pragma unroll
            for (int n = 0; n < 2; ++n) bv[bj][n] = bias ? *(const f32x4*)(bias + col0 + bj * HALF + 4 * n) : (f32x4){0.f, 0.f, 0.f, 0.f};
#pragma unroll
        for (int ai = 0; ai < 2; ++ai)
#pragma unroll
            for (int m = 0; m < 4; ++m) { bf16_t* rowp = O + (size_t)(row0 + ai * HALF + m * 16) * ldc + col0;
#pragma unroll
                for (int bj = 0; bj < 2; ++bj) { f32x4 a0 = acc[ai][bj][m][0], a1 = acc[ai][bj][m][1];
                    if constexpr (I8) { typedef int v4i_t __attribute__((ext_vector_type(4)));
                        a0 = __builtin_convertvector(__builtin_bit_cast(v4i_t, a0), f32x4) * (*(const f32x4*)(colmax + col0 + bj * HALF) * (1.0f / 127.0f));
                        a1 = __builtin_convertvector(__builtin_bit_cast(v4i_t, a1), f32x4) * (*(const f32x4*)(colmax + col0 + bj * HALF + 4) * (1.0f / 127.0f)); }
                    f32x4 v0 = (a0 * rs[ai][m] + bv[bj][0]) * scale, v1 = (a1 * rs[ai][m] + bv[bj][1]) * scale;
                    u32x4 w; w.x = cvt_pk_bf16(v0[0], v0[1]); w.y = cvt_pk_bf16(v0[2], v0[3]); w.z = cvt_pk_bf16(v1[0], v1[1]); w.w = cvt_pk_bf16(v1[2], v1[3]);
                    *(u32x4*)(rowp + bj * HALF) = w; } }
    }
};
typedef EpiOutT<false> EpiOut; typedef EpiOutT<true> EpiOutI8;
#ifndef PG8_ZB_TILES
#define PG8_ZB_TILES 32
#define PG8_ZB_SHIFT 32
#endif
struct EpiZBC {
    static constexpr bool PERM = true, AFTER_DRAIN = false;
    EpiOut e;
    __device__ __forceinline__ void operator()(const f32x4 (&acc)[2][2][4][2], const Unit& u, int wr, int wc, int fr, int fq) const { Unit v = u; if (u.pn >= PG8_ZB_TILES) v.pn = u.pn + PG8_ZB_SHIFT; e(acc, v, wr, wc, fr, fq); }
};
struct EpiKVQ {
    static constexpr bool PERM = true, AFTER_DRAIN = false;
    bf16_t* KV; bf16_t* Q; const float* bkv; const float* bq; float qscale; const float* rowscale;
    __device__ __forceinline__ void operator()(const f32x4 (&acc)[2][2][4][2], const Unit& u, int wr, int wc, int fr, int fq) const {
        const bool isq = u.pn >= 4;
        EpiOut e; Unit v = u; e.rowscale = rowscale; e.colmax = nullptr;
        if (isq) { e.O = Q; e.ldc = 4096; e.bias = bq; e.scale = qscale; v.pn = u.pn - 4; }
        else     { e.O = KV; e.ldc = 1024; e.bias = bkv; e.scale = 1.0f; }
        e(acc, v, wr, wc, fr, fq);
    }
};
__device__ __forceinline__ float dpp_ror1(float v) { return __builtin_bit_cast(float, __builtin_amdgcn_update_dpp(0, __builtin_bit_cast(int, v), 0x121, 0xf, 0xf, false)); }
__device__ __forceinline__ float dpp_ror2(float v) { return __builtin_bit_cast(float, __builtin_amdgcn_update_dpp(0, __builtin_bit_cast(int, v), 0x122, 0xf, 0xf, false)); }
template <bool I8> struct EpiConvGateT {
    static constexpr bool PERM = true, AFTER_DRAIN = false; const float* colmax;
    bf16_t* ACT; float* HALO; const float* cw; const float* cb; PG8_LAS float* xch; int dff, nup; const float* rowscale;
    __device__ __forceinline__ void operator()(const f32x4 (&acc_in)[2][2][4][2], const Unit& u, int wr, int wc, int fr, int fq) const {
        const int cbase = u.pn * 128 + wc * 32 + 8 * fq;
        f32x4 (&acc)[2][2][4][2] = const_cast<f32x4 (&)[2][2][4][2]>(acc_in);
#pragma unroll
        for (int ai = 0; ai < 2; ++ai)
#pragma unroll
            for (int m = 0; m < 4; ++m) { const float rsv = rowscale[u.pm * BM + ai * HALF + wr * 64 + m * 16 + fr];
#pragma unroll
                for (int bj = 0; bj < 2; ++bj)
#pragma unroll
                    for (int n = 0; n < 2; ++n) {
                        if constexpr (I8) { typedef int v4i_t __attribute__((ext_vector_type(4))); const f32x4 cs = *(const f32x4*)(colmax + bj * dff + cbase + 4 * n) * (1.0f / 127.0f);
                            acc[ai][bj][m][n] = __builtin_convertvector(__builtin_bit_cast(v4i_t, acc[ai][bj][m][n]), f32x4) * cs * rsv; }
                        else acc[ai][bj][m][n] = acc[ai][bj][m][n] * rsv; } }
        if (fr >= 14) {
#pragma unroll
            for (int ai = 0; ai < 2; ++ai)
#pragma unroll
                for (int bj = 0; bj < 2; ++bj)
#pragma unroll
                    for (int n = 0; n < 2; ++n) *(PG8_LAS f32x4*)(xch + (((((ai * 2 + wr) * 4 + wc) * 2 + (fr - 14)) * 2 + bj) * 32 + fq * 8 + n * 4)) = acc[ai][bj][3][n];
        }
        if (wr == 0 && fr < 2) {
#pragma unroll
            for (int bj = 0; bj < 2; ++bj)
#pragma unroll
                for (int n = 0; n < 2; ++n) *(f32x4*)(HALO + (size_t)(u.pm * 4 + fr) * nup + bj * dff + cbase + 4 * n) = acc[0][bj][0][n];
        }
        if (wr == 1 && fr >= 14) {
#pragma unroll
            for (int bj = 0; bj < 2; ++bj)
#pragma unroll
                for (int n = 0; n < 2; ++n) *(f32x4*)(HALO + (size_t)(u.pm * 4 + fr - 12) * nup + bj * dff + cbase + 4 * n) = acc[1][bj][3][n];
        }
        asm volatile("s_waitcnt lgkmcnt(0)" ::: "memory"); __builtin_amdgcn_s_barrier(); asm volatile("" ::: "memory");
        u32x2 ow[2][4];
#pragma unroll
        for (int n = 0; n < 2; ++n) {
            asm volatile("" ::: "memory");
            f32x4 w[2][3], b[2];
#pragma unroll
            for (int bj = 0; bj < 2; ++bj) {
#pragma unroll
                for (int k = 0; k < 3; ++k) w[bj][k] = *(const f32x4*)(cw + (size_t)k * nup + bj * dff + cbase + 4 * n);
                b[bj] = *(const f32x4*)(cb + bj * dff + cbase + 4 * n); }
#pragma unroll
            for (int ai = 0; ai < 2; ++ai) {
                const int pai = (wr == 1) ? ai : 0, pwr = (wr == 1) ? 0 : 1;
                f32x4 x14[2], x15[2];
#pragma unroll
                for (int bj = 0; bj < 2; ++bj) { x14[bj] = *(const PG8_LAS f32x4*)(xch + (((((pai * 2 + pwr) * 4 + wc) * 2 + 0) * 2 + bj) * 32 + fq * 8 + n * 4));
                                                 x15[bj] = *(const PG8_LAS f32x4*)(xch + (((((pai * 2 + pwr) * 4 + wc) * 2 + 1) * 2 + bj) * 32 + fq * 8 + n * 4)); }
#pragma unroll
                for (int m = 0; m < 4; ++m) {
                    f32x4 cv[2];
#pragma unroll
                    for (int bj = 0; bj < 2; ++bj) {
                        const f32x4 cur = acc[ai][bj][m][n]; f32x4 p1, p2;
#pragma unroll
                        for (int j = 0; j < 4; ++j) {
                            const float c1 = dpp_ror1(cur[j]), c2 = dpp_ror2(cur[j]); float q1, q2;
                            if (m == 0) { q1 = x15[bj][j]; q2 = (fr == 1) ? x15[bj][j] : x14[bj][j]; }
                            else { const float pv = acc[ai][bj][m > 0 ? m - 1 : 0][n][j]; q1 = dpp_ror1(pv); q2 = dpp_ror2(pv); }
                            p1[j] = (fr >= 1) ? c1 : q1; p2[j] = (fr >= 2) ? c2 : q2; }
                        cv[bj] = b[bj] + w[bj][0] * p2 + w[bj][1] * p1 + w[bj][2] * cur; }
                    float o[4];
#pragma unroll
                    for (int j = 0; j < 4; ++j) o[j] = cv[0][j] * __builtin_amdgcn_rcpf(1.0f + __expf(-cv[0][j])) * cv[1][j];
                    u32x2 pkd; pkd.x = cvt_pk_bf16(o[0], o[1]); pkd.y = cvt_pk_bf16(o[2], o[3]);
                    if (n == 0) ow[ai][m] = pkd;
                    else { u32x4 wv; wv.x = ow[ai][m].x; wv.y = ow[ai][m].y; wv.z = pkd.x; wv.w = pkd.y;
                        *(u32x4*)(ACT + (size_t)(u.pm * BM + ai * HALF + wr * 64 + m * 16 + fr) * dff + cbase) = wv; } }
            }
        }
    }
};
typedef EpiConvGateT<false> EpiConvGate; typedef EpiConvGateT<true> EpiConvGateI8;

typedef int pg8_v4i __attribute__((ext_vector_type(4)));
template <bool I8> __device__ __forceinline__ f32x4 mma16(const bf16x8 b, const bf16x8 a, const f32x4 c) {
    if constexpr (I8) return __builtin_bit_cast(f32x4, __builtin_amdgcn_mfma_i32_16x16x64_i8(__builtin_bit_cast(pg8_v4i, b), __builtin_bit_cast(pg8_v4i, a), __builtin_bit_cast(pg8_v4i, c), 0, 0, 0));
    else return __builtin_amdgcn_mfma_f32_16x16x32_bf16(b, a, c, 0, 0, 0);
}
template <class Epi, class Sched, bool ALIGN_EPI = false, bool SP2 = false, bool I8 = false>
__device__ __forceinline__ void gemm_phase(PG8_LAS unsigned char* lds, const Gemm g, const Sched& S, const Epi& E) {
    int tid_l = threadIdx.x; asm volatile("" : "+v"(tid_l));
    const int tid = tid_l, wid = __builtin_amdgcn_readfirstlane(tid >> 6), lane = tid & 63, wr = wid >> 2, wc = wid & 3, fr = lane & 15, fq = lane >> 4;
    const int K = g.K, nt = K / BK;
    unsigned voffA[2], voffB[2];
#pragma unroll
    for (int i = 0; i < 2; ++i) { int R, C; stage_rc(tid * 16 + i * 8192, R, C); const int Rb = Epi::PERM ? ((R & ~31) + perm32(R & 31)) : R;
        voffA[i] = (unsigned)(R * K + C) * 2u; voffB[i] = (unsigned)(Rb * K + C) * 2u; }
    const size_t kstep = (size_t)(BK * 2);
    const size_t hstep = (size_t)HALF * K * 2;
    const size_t tstep = 2 * hstep;
    const unsigned ldsw = (unsigned)wid * 1024u;
    const int aoff = lds_byte(wr * 64 + fr, fq * 8), boff = lds_byte(wc * 32 + fr, fq * 8);
#define PG8_SA(b, h) (((b) * 2 + (h)) * HTB)
#define PG8_SB(b, h) ((4 + (b) * 2 + (h)) * HTB)
#define PG8_STAGE(bufoff, gbase, voff) do { _Pragma("unroll") for (int _i = 0; _i < 2; ++_i) \
        __builtin_amdgcn_global_load_lds((const unsigned*)((const char*)(gbase) + (voff)[_i]), (PG8_LAS unsigned*)(lds + (bufoff) + ldsw + _i * 8192), 16, 0, 0); } while (0)
#define PG8_LDA(dst, b, h) do { _Pragma("unroll") for (int m = 0; m < 4; ++m) _Pragma("unroll") for (int k = 0; k < 2; ++k) dst[m][k] = *(const PG8_LAS bf16x8*)(lds + PG8_SA(b, h) + aoff + m * 2048 + k * 1024); } while (0)
#define PG8_LDB(dst, b, h) do { _Pragma("unroll") for (int n = 0; n < 2; ++n) _Pragma("unroll") for (int k = 0; k < 2; ++k) dst[n][k] = *(const PG8_LAS bf16x8*)(lds + PG8_SB(b, h) + boff + n * 2048 + k * 1024); } while (0)
#define PG8_MMA(ai, bj, At, Bt) do { __builtin_amdgcn_s_setprio(1); _Pragma("unroll") for (int m = 0; m < 4; ++m) _Pragma("unroll") for (int n = 0; n < 2; ++n) _Pragma("unroll") for (int k = 0; k < 2; ++k) \
        acc[ai][bj][m][n] = mma16<I8>(Bt[n][k], At[m][k], acc[ai][bj][m][n]); __builtin_amdgcn_s_setprio(0); } while (0)
#define PG8_WAIT_V(n) asm volatile("s_waitcnt vmcnt(" #n ")" ::: "memory")
#define PG8_WAIT_L(n) asm volatile("s_waitcnt lgkmcnt(" #n ")" ::: "memory")
#define PG8_BAR __builtin_amdgcn_s_barrier()
#define PG8_SCHED __builtin_amdgcn_sched_barrier(0)
    Unit cur, nxt; int ui = 0;
    if (!S.next(0, cur)) return;
    f32x4 acc[2][2][4][2];
#pragma unroll
    for (int a = 0; a < 2; ++a)
#pragma unroll
        for (int b = 0; b < 2; ++b)
#pragma unroll
            for (int m = 0; m < 4; ++m)
#pragma unroll
                for (int n = 0; n < 2; ++n) acc[a][b][m][n] = (f32x4){0.f, 0.f, 0.f, 0.f};
    bf16x8 At[4][2], B0[2][2], B1[2][2];
    const char* cA = (const char*)g.A + (size_t)cur.pm * tstep; const char* cB = (const char*)g.Bt + (size_t)cur.pn * tstep;
    S.a_ready(cur);
    if constexpr (SP2) {
        PG8_STAGE(PG8_SB(0, 0), cB, voffB); PG8_STAGE(PG8_SB(0, 1), cB + hstep, voffB); PG8_STAGE(PG8_SA(0, 0), cA, voffA); PG8_STAGE(PG8_SA(0, 1), cA + hstep, voffA);
        if (wr == 1) PG8_BAR;
        PG8_WAIT_V(2); PG8_BAR;
        PG8_STAGE(PG8_SB(1, 0), cB + kstep, voffB); PG8_STAGE(PG8_SA(1, 0), cA + kstep, voffA); PG8_STAGE(PG8_SB(1, 1), cB + hstep + kstep, voffB);
        PG8_WAIT_V(6); PG8_BAR;
    } else {
        PG8_STAGE(PG8_SB(0, 0), cB, voffB); PG8_STAGE(PG8_SA(0, 0), cA, voffA); PG8_STAGE(PG8_SB(0, 1), cB + hstep, voffB); PG8_STAGE(PG8_SA(0, 1), cA + hstep, voffA);
        if (wr == 1) PG8_BAR;
        PG8_WAIT_V(4); PG8_BAR;
        PG8_STAGE(PG8_SB(1, 0), cB + kstep, voffB); PG8_STAGE(PG8_SA(1, 0), cA + kstep, voffA); PG8_STAGE(PG8_SB(1, 1), cB + hstep + kstep, voffB);
        PG8_WAIT_V(6); PG8_BAR;
    }
    for (;;) {
        const bool has_next = S.next(ui + 1, nxt);
        const char* nA = has_next ? (const char*)g.A + (size_t)nxt.pm * tstep : cA; const char* nB = has_next ? (const char*)g.Bt + (size_t)nxt.pn * tstep : cB;
        for (int t = 0; t < nt; t += 2) {
            const bool last = (t == nt - 2);
            const char* a1 = cA + (size_t)(t + 1) * kstep;
            const char* a2 = last ? nA : cA + (size_t)(t + 2) * kstep; const char* b2 = last ? nB : cB + (size_t)(t + 2) * kstep;
            const char* a3 = a2 + kstep; const char* b3 = b2 + kstep;
            if (last && has_next) S.a_ready(nxt);
            if constexpr (SP2) {
            PG8_LDB(B0, 0, 0); PG8_LDB(B1, 0, 1); PG8_SCHED; PG8_LDA(At, 0, 0); PG8_STAGE(PG8_SA(1, 1), a1 + hstep, voffA);
            PG8_WAIT_V(8); PG8_WAIT_L(0); PG8_BAR; PG8_MMA(0, 0, At, B0); PG8_MMA(0, 1, At, B1); PG8_BAR; PG8_SCHED;
            PG8_LDA(At, 0, 1); PG8_STAGE(PG8_SB(0, 0), b2, voffB); PG8_STAGE(PG8_SB(0, 1), b2 + hstep, voffB); PG8_STAGE(PG8_SA(0, 0), a2, voffA);
            PG8_WAIT_V(8); PG8_WAIT_L(0); PG8_BAR; PG8_MMA(1, 0, At, B0); PG8_MMA(1, 1, At, B1); PG8_BAR; PG8_SCHED;
            PG8_LDB(B0, 1, 0); PG8_LDB(B1, 1, 1); PG8_SCHED; PG8_LDA(At, 1, 0); PG8_STAGE(PG8_SA(0, 1), a2 + hstep, voffA);
            PG8_WAIT_V(8); PG8_WAIT_L(0); PG8_BAR; PG8_MMA(0, 0, At, B0); PG8_MMA(0, 1, At, B1); PG8_BAR; PG8_SCHED;
            PG8_LDA(At, 1, 1); PG8_STAGE(PG8_SB(1, 0), b3, voffB); PG8_STAGE(PG8_SB(1, 1), b3 + hstep, voffB); PG8_STAGE(PG8_SA(1, 0), a3, voffA);
            PG8_WAIT_V(8); PG8_WAIT_L(0); PG8_BAR; PG8_MMA(1, 0, At, B0); PG8_MMA(1, 1, At, B1); PG8_BAR; PG8_SCHED;
            } else {
            PG8_LDB(B0, 0, 0); PG8_SCHED; PG8_LDA(At, 0, 0); PG8_STAGE(PG8_SA(1, 1), a1 + hstep, voffA);
            PG8_WAIT_L(8); PG8_BAR; PG8_WAIT_L(0); PG8_MMA(0, 0, At, B0); PG8_BAR; PG8_SCHED;
            PG8_LDB(B1, 0, 1); PG8_STAGE(PG8_SB(0, 0), b2, voffB);
            PG8_BAR; PG8_WAIT_L(0); PG8_MMA(0, 1, At, B1); PG8_BAR;
            PG8_LDA(At, 0, 1); PG8_STAGE(PG8_SA(0, 0), a2, voffA);
            PG8_BAR; PG8_WAIT_L(0); PG8_MMA(1, 0, At, B0); PG8_BAR; PG8_SCHED;
            PG8_STAGE(PG8_SB(0, 1), b2 + hstep, voffB);
            PG8_WAIT_V(6); PG8_BAR; PG8_MMA(1, 1, At, B1); PG8_BAR;
            PG8_LDB(B0, 1, 0); PG8_SCHED; PG8_LDA(At, 1, 0); PG8_STAGE(PG8_SA(0, 1), a2 + hstep, voffA);
            PG8_WAIT_L(8); PG8_BAR; PG8_WAIT_L(0); PG8_MMA(0, 0, At, B0); PG8_BAR; PG8_SCHED;
            PG8_LDB(B1, 1, 1); PG8_STAGE(PG8_SB(1, 0), b3, voffB);
            PG8_BAR; PG8_WAIT_L(0); PG8_MMA(0, 1, At, B1); PG8_BAR;
            PG8_LDA(At, 1, 1); PG8_STAGE(PG8_SA(1, 0), a3, voffA);
            PG8_BAR; PG8_WAIT_L(0); PG8_MMA(1, 0, At, B0); PG8_BAR; PG8_SCHED;
            PG8_STAGE(PG8_SB(1, 1), b3 + hstep, voffB);
            PG8_WAIT_V(6); PG8_BAR; PG8_MMA(1, 1, At, B1); PG8_BAR;
            }
        }
        if constexpr (ALIGN_EPI) { if (wr == 0) PG8_BAR; }
        if constexpr (!Epi::AFTER_DRAIN) { E(acc, cur, wr, wc, fr, fq); S.done(cur); }
        if (!has_next) break;
#pragma unroll
        for (int a = 0; a < 2; ++a)
#pragma unroll
            for (int b = 0; b < 2; ++b)
#pragma unroll
                for (int m = 0; m < 4; ++m)
#pragma unroll
                    for (int n = 0; n < 2; ++n) acc[a][b][m][n] = (f32x4){0.f, 0.f, 0.f, 0.f};
        cur = nxt; cA = nA; cB = nB; ++ui;
        if constexpr (ALIGN_EPI) { if (wr == 1) PG8_BAR; }
    }
    PG8_WAIT_V(0);
    if constexpr (!ALIGN_EPI) { if (wr == 0) PG8_BAR; }
    PG8_BAR;
    if constexpr (Epi::AFTER_DRAIN) { E.fused(acc, cur, wr, wc, fr, fq, lds, wid, lane); S.done(cur); }
#undef PG8_SA
#undef PG8_SB
#undef PG8_STAGE
#undef PG8_LDA
#undef PG8_LDB
#undef PG8_MMA
#undef PG8_WAIT_V
#undef PG8_WAIT_L
#undef PG8_BAR
#undef PG8_SCHED
}
}
#define GAS __attribute__((address_space(1)))
#define LAS __attribute__((address_space(3)))
typedef unsigned short bf16;
typedef unsigned v4u __attribute__((ext_vector_type(4)));
typedef float f32x4 __attribute__((ext_vector_type(4)));
typedef short bf16x8 __attribute__((ext_vector_type(8)));
typedef GAS unsigned gu32;
typedef GAS unsigned long long gu64;
#define RLX_AGENT __ATOMIC_RELAXED, __HIP_MEMORY_SCOPE_AGENT
#define LDS_WAIT() asm volatile("s_waitcnt lgkmcnt(0)" ::: "memory")
#define VM_WAIT() asm volatile("s_waitcnt vmcnt(0)" ::: "memory")
__device__ __forceinline__ unsigned long long rt() { return __builtin_amdgcn_s_memrealtime(); }

#define XB_TMO      128
#define XB_XCNT(j)  (256  + 64 * (j))
#define XB_XSUB(j)  (1280 + 64 * (j))
#define XB_XGEN(j)  (2304 + 64 * (j))
#define XB_TOP      3328
#define XB_TOPGEN   3392
#define XCD_BAR_WORDS 3456
#define XB_SPIN_CAP (1u << 18)

__device__ __forceinline__ unsigned xb_ld(unsigned* p)              { return __hip_atomic_load(p, __ATOMIC_RELAXED, __HIP_MEMORY_SCOPE_AGENT); }
__device__ __forceinline__ unsigned xb_add(unsigned* p, unsigned v) { return __hip_atomic_fetch_add(p, v, __ATOMIC_RELAXED, __HIP_MEMORY_SCOPE_AGENT); }
__device__ __forceinline__ unsigned xb_xcc_id() { return (unsigned)__builtin_amdgcn_s_getreg((3 << 11) | 20) & 0xFu; }
#define XB_SPIN(cond, bar) do { unsigned _sp = 0; while (cond) { __builtin_amdgcn_s_sleep(1); \
    if ((++_sp & 255u) == 0u) { if (xb_ld(&(bar)[XB_TMO])) break; if (_sp > XB_SPIN_CAP) { atomicAdd(&(bar)[XB_TMO], 1u); break; } } } } while (0)

struct XcdBarrier {
    unsigned* bar; unsigned x;
    volatile LAS unsigned* st;
};

__device__ __forceinline__ XcdBarrier xcd_barrier_post(unsigned* bar, volatile LAS unsigned* st) {
    XcdBarrier b; b.bar = bar; b.x = xb_xcc_id(); b.st = st;
    if (threadIdx.x == 0) (void)xb_add(&bar[XB_XCNT(b.x)], 1u);
    return b;
}
__device__ __forceinline__ void xcd_barrier_complete(unsigned* bar, unsigned x, unsigned& nloc, unsigned& nx) {
    const unsigned G = gridDim.x * gridDim.y * gridDim.z;
    unsigned sum, cnt, mine, sp = 0u;
    for (;;) {
        sum = 0u; cnt = 0u; mine = 0u;
#pragma unroll
        for (unsigned j = 0; j < 16; ++j) { const unsigned c = xb_ld(&bar[XB_XCNT(j)]); sum += c; cnt += (c > 0u) ? 1u : 0u; mine = (j == x) ? c : mine; }
        if (sum == G) break;
        __builtin_amdgcn_s_sleep(1);
        if ((++sp & 255u) == 0u) { if (xb_ld(&bar[XB_TMO])) break; if (sp > XB_SPIN_CAP) { atomicAdd(&bar[XB_TMO], 1u); break; } }
    }
    nloc = mine > 0u ? mine : 1u; nx = cnt > 0u ? cnt : 1u;
}

__device__ __forceinline__ void xcd_barrier(const XcdBarrier& b) {
    asm volatile("s_waitcnt vmcnt(0)" ::: "memory");
    __syncthreads();
    if (threadIdx.x == 0) {
        unsigned* bar = b.bar;
        __builtin_amdgcn_s_waitcnt(0);
        unsigned nloc = b.st[0], nx = b.st[1];
        if (nloc == 0u) { xcd_barrier_complete(bar, b.x, nloc, nx); b.st[0] = nloc; b.st[1] = nx; }
        const unsigned old = xb_add(&bar[XB_XSUB(b.x)], 1u);
        const unsigned gen = old / nloc;
        if (old + 1u == (gen + 1u) * nloc) {
            __builtin_amdgcn_fence(__ATOMIC_RELEASE, "agent");
            asm volatile("s_waitcnt vmcnt(0)" ::: "memory");
            const unsigned og = xb_add(&bar[XB_TOP], 1u);
            const unsigned tg = og / nx;
            if (og + 1u == (tg + 1u) * nx) xb_add(&bar[XB_TOPGEN], 1u);
            else XB_SPIN(xb_ld(&bar[XB_TOPGEN]) == tg, bar);
            __builtin_amdgcn_fence(__ATOMIC_ACQUIRE, "agent");
            xb_add(&bar[XB_XGEN(b.x)], 1u);
            asm volatile("s_waitcnt vmcnt(0)" ::: "memory");
        } else {
            XB_SPIN(xb_ld(&bar[XB_XGEN(b.x)]) == gen, bar);
            __builtin_amdgcn_fence(__ATOMIC_ACQUIRE, "agent");
            asm volatile("s_waitcnt vmcnt(0)" ::: "memory");
        }
    }
    __syncthreads();
}


constexpr int SEQ = 8192, DM = 4096, DINNER = 8192, NHEAD = 128, HDIM = 64, NGRP = 8, HPG = 16, DSTATE = 128;
constexpr int CONVD = 10240, NZX = 18432, NIN = 18560, DFF = 11008, NUP = 22016, NKVQ = 5120;
constexpr int CHUNK = 128, NCHUNK = 64;
#ifdef ZHI8
#ifndef ZHI8_Q0
#define ZHI8_Q0 4096
#endif
#ifdef BCI8
constexpr int NZI8 = NZX - ZHI8_Q0, NBC = NZX - NZI8;
#else
constexpr int NZI8 = 16384 - ZHI8_Q0, NBC = NZX - NZI8;
#endif
#elif defined(XBCI8)
constexpr int NZI8 = 10240, NBC = NZX - NZI8;
#elif defined(ZXI8)
constexpr int NZI8 = 16384, NBC = NZX - NZI8;
#else
constexpr int NZI8 = 8192, NBC = NZX - NZI8;
#endif
#ifdef ZHI8
constexpr int QCOL0 = ZHI8_Q0;
#elif defined(ZXI8)
constexpr int QCOL0 = 0;
#else
constexpr int QCOL0 = DINNER;
#endif
constexpr float EPS = 1e-6f, SSM_EPS = 1e-5f;
constexpr int NWAVES = 8;

constexpr size_t MiB = 1u << 20;
constexpr size_t WS_CTL = 0, CTL_ZERO_BYTES = 1 * MiB;
constexpr size_t WS_WIN = 1 * MiB;
constexpr size_t WS_WOUT = 146 * MiB;
constexpr size_t WS_WUP0 = 210 * MiB;
constexpr size_t WS_WUP1 = 382 * MiB;
constexpr size_t WS_WDN0 = 554 * MiB;
constexpr size_t WS_WDN1 = 640 * MiB;
constexpr size_t WS_WKVQ = 726 * MiB;
constexpr size_t WS_WO = 766 * MiB;
constexpr size_t WS_A = 798 * MiB;
constexpr size_t WS_MIX = 862 * MiB;
constexpr size_t WS_DTRAW = 926 * MiB;
constexpr size_t WS_DT = 930 * MiB;
constexpr size_t WS_ACUM = 934 * MiB;
constexpr size_t WS_HALO = WS_DTRAW;
constexpr size_t WS_RS = 937 * MiB;
constexpr size_t WS_RSQ = 937 * MiB + 65536;
constexpr size_t WS_CMAX = 512 * 1024;
constexpr size_t WS_BIG = 938 * MiB;
constexpr size_t WS_A8 = WS_BIG;
constexpr size_t WS_ZX = WS_BIG;
constexpr size_t WS_S = WS_BIG + 448 * MiB;
constexpr size_t WS_ST = WS_BIG + 704 * MiB;
constexpr size_t WS_Y = WS_BIG + 832 * MiB;
constexpr size_t WS_ACT = WS_BIG + 344 * MiB;
constexpr size_t WS_Q = WS_BIG;
constexpr size_t WS_KV = WS_BIG + 64 * MiB;
constexpr size_t WS_O = WS_BIG + 80 * MiB;
constexpr size_t WS_END = WS_BIG + 960 * MiB;
constexpr int CW_BAR = 4096;

constexpr int LDS_BYTES = 163840;
constexpr int MISC_OFF = LDS_BYTES - 256;

typedef float f32x4 __attribute__((ext_vector_type(4)));
typedef float f32x16 __attribute__((ext_vector_type(16)));
typedef short bf16x8 __attribute__((ext_vector_type(8)));
typedef short bf16x4 __attribute__((ext_vector_type(4)));
typedef unsigned u32x4 __attribute__((ext_vector_type(4)));
typedef unsigned u32x2 __attribute__((ext_vector_type(2)));
#define DEV __device__ __forceinline__
DEV unsigned pk2(float lo, float hi) { return pg8::cvt_pk_bf16(lo, hi); }
DEV float bf_lo(unsigned w) { return __builtin_bit_cast(float, w << 16); }
DEV float bf_hi(unsigned w) { return __builtin_bit_cast(float, w & 0xffff0000u); }
DEV float bf2f(bf16 b) { return __builtin_bit_cast(float, ((unsigned)b) << 16); }
DEV bf16 f2bf(float f) { return (bf16)(pk2(f, 0.f) & 0xffffu); }
DEV float silu_f(float v) { return v * __builtin_amdgcn_rcpf(1.0f + __expf(-v)); }
DEV float wave_sum(float v) {
#pragma unroll
    for (int o = 1; o < 64; o <<= 1) v += __shfl_xor(v, o);
    return v;
}
DEV void unpack8(const u32x4 w, float (&f)[8]) { f[0] = bf_lo(w.x); f[1] = bf_hi(w.x); f[2] = bf_lo(w.y); f[3] = bf_hi(w.y); f[4] = bf_lo(w.z); f[5] = bf_hi(w.z); f[6] = bf_lo(w.w); f[7] = bf_hi(w.w); }
DEV u32x4 pack8(const float (&f)[8]) { u32x4 w; w.x = pk2(f[0], f[1]); w.y = pk2(f[2], f[3]); w.z = pk2(f[4], f[5]); w.w = pk2(f[6], f[7]); return w; }

struct Ctx { LAS unsigned char* lds; int tid, lane, wave, vcu, G; };

struct TrTile { f32x4 v[16]; float g[16]; };
DEV void tr_load(TrTile& t, const float* __restrict__ W, int N, const float* __restrict__ gain, int k0, int n0, int lane) {
    const int kr = lane >> 4, nc = (lane & 15) * 4;
#pragma unroll
    for (int i = 0; i < 16; ++i) { const int kk = 4 * i + kr; t.v[i] = __builtin_nontemporal_load((const f32x4*)(W + (size_t)(k0 + kk) * N + n0 + nc));     t.g[i] = gain ? gain[k0 + kk] : 1.0f; }
}
DEV void tr_store(const TrTile& t, bf16* __restrict__ WT, int K, int row_off, int k0, int n0, LAS float* scr, int lane) {
    const int kr = lane >> 4, nc = (lane & 15) * 4;
#pragma unroll
    for (int i = 0; i < 16; ++i) { const int kk = 4 * i + kr; LAS float* s = scr + kk * 65 + nc; s[0] = t.v[i].x * t.g[i]; s[1] = t.v[i].y * t.g[i]; s[2] = t.v[i].z * t.g[i]; s[3] = t.v[i].w * t.g[i]; }
    asm volatile("s_waitcnt lgkmcnt(0)" ::: "memory");
    const int c = lane & 7;
#pragma unroll
    for (int j = 0; j < 8; ++j) { const int n = 8 * j + (lane >> 3); const LAS float* s = scr + (8 * c) * 65 + n;
        u32x4 o; o.x = pk2(s[0 * 65], s[1 * 65]); o.y = pk2(s[2 * 65], s[3 * 65]); o.z = pk2(s[4 * 65], s[5 * 65]); o.w = pk2(s[6 * 65], s[7 * 65]);
        __builtin_nontemporal_store(o, (u32x4*)(WT + (size_t)(row_off + n0 + n) * K + k0 + 8 * c)); }
    asm volatile("s_waitcnt lgkmcnt(0)" ::: "memory");
}
DEV int tr_row_up(int n0) { const int isv = n0 >= DFF ? 1 : 0, m0 = n0 - isv * DFF; return (m0 >> 7) * 256 + isv * 128 + (m0 & 127); }
template <bool UPMAP = false>
DEV void tr_matrix(const Ctx& C, const float* W, int K, int N, const float* gain, bf16* WT, int row_off, int gw_in = -1, int NGW_in = 0, int part_lo = 0, int part_hi = 20, int ldW = 0) {
    LAS float* scr = (LAS float*)(C.lds + C.wave * 16640);
    const int gw = gw_in < 0 ? C.vcu * NWAVES + C.wave : gw_in, NGW = gw_in < 0 ? C.G * NWAVES : NGW_in;
    const int ld = ldW ? ldW : N; const int nblk = N / 64, items_all = (K / 64) * nblk;
    const int it_lo = (int)((long)items_all * part_lo / 20), items = (int)((long)items_all * part_hi / 20);
    if (it_lo + gw >= items) return;
    TrTile cur, nxt;
    { const int kb = (it_lo + gw) / nblk, nb = (it_lo + gw) - kb * nblk; tr_load(cur, W, ld, gain, kb * 64, nb * 64, C.lane); }
    for (int it = it_lo + gw; it < items; it += NGW) { const int kb = it / nblk, nb = it - kb * nblk; const int n0 = nb * 64; int ro = row_off;
        if (UPMAP) { const int isv = n0 >= DFF ? 1 : 0, m0 = n0 - isv * DFF; ro = (m0 >> 7) * 256 + isv * 128 + (m0 & 127) - n0; }
        const int it2 = it + NGW; const bool more = it2 < items;
        if (more) { const int kb2 = it2 / nblk, nb2 = it2 - kb2 * nblk; tr_load(nxt, W, ld, gain, kb2 * 64, nb2 * 64, C.lane); }
        tr_store(cur, WT, K, ro, kb * 64, n0, scr, C.lane);
        if (more) cur = nxt; }
}
template <bool HAS_GAIN>
DEV void tr_wide(const Ctx& C, const float* __restrict__ W, int K, int N, const float* __restrict__ gain, bf16* __restrict__ WT, int row_off, int ld) {
    constexpr int TN = 128, TK = 256, TPB = TK * 2 + 16;
    LAS unsigned char* T = C.lds;
    const int tid = C.tid, quad = tid & 31, rsub = tid >> 5;
    const int nblk = N / TN, items = (K / TK) * nblk;
    int it = C.vcu; if (it >= items) return;
    f32x4 cur[16], nxt[16];
    { const int kb = it / nblk, nb = it - kb * nblk; const float* src = W + (size_t)(kb * TK) * ld + nb * TN + quad * 4;
#pragma unroll
      for (int i = 0; i < 16; ++i) cur[i] = __builtin_nontemporal_load((const f32x4*)(src + (size_t)(4 * (rsub + 16 * (i >> 2)) + (i & 3)) * ld)); }
    for (;;) {
        const int kb = it / nblk, nb = it - kb * nblk, k0 = kb * TK, n0 = nb * TN;
        const int it2 = it + C.G; const bool more = it2 < items;
        if (more) { const int kb2 = it2 / nblk, nb2 = it2 - kb2 * nblk; const float* src = W + (size_t)(kb2 * TK) * ld + nb2 * TN + quad * 4;
#pragma unroll
            for (int i = 0; i < 16; ++i) nxt[i] = __builtin_nontemporal_load((const f32x4*)(src + (size_t)(4 * (rsub + 16 * (i >> 2)) + (i & 3)) * ld)); }
#pragma unroll
        for (int j = 0; j < 4; ++j) { const int rbl = rsub + 16 * j; f32x4 g4 = {1.f, 1.f, 1.f, 1.f}; if constexpr (HAS_GAIN) g4 = *(const f32x4*)(gain + k0 + 4 * rbl);
            LAS unsigned char* tp = T + (quad * 4) * TPB + 16 * ((rbl >> 1) ^ (quad & 7)) + 8 * (rbl & 1);
#pragma unroll
            for (int c = 0; c < 4; ++c) { u32x2 w; w.x = pk2(cur[4 * j + 0][c] * g4.x, cur[4 * j + 1][c] * g4.y); w.y = pk2(cur[4 * j + 2][c] * g4.z, cur[4 * j + 3][c] * g4.w);
                *(LAS u32x2*)(tp + c * TPB) = w; } }
        __syncthreads();
#pragma unroll 4
        for (int j = 0; j < 8; ++j) { const int id = tid + 512 * j, n = id >> 5, ch = id & 31;
            __builtin_nontemporal_store(*(const LAS u32x4*)(T + n * TPB + 16 * (ch ^ ((n >> 2) & 7))), (u32x4*)(WT + (size_t)(row_off + n0 + n) * K + k0 + ch * 8)); }
        __syncthreads();
        if (!more) break;
#pragma unroll
        for (int i = 0; i < 16; ++i) cur[i] = nxt[i];
        it = it2;
    }
}
DEV void w_colmax(const Ctx& C, const float* __restrict__ W, int K, int N, const float* __restrict__ gain, float* __restrict__ cmax, int ld) {
    const int gw = C.vcu * NWAVES + C.wave, NGW = C.G * NWAVES; const int ncb = N / 256, items = (K / 64) * ncb;
    for (int it = gw; it < items; it += NGW) { const int kb = it / ncb, nb = it - kb * ncb; const float* src = W + (size_t)(kb * 64) * ld + nb * 256 + C.lane * 4;
        f32x4 mx = {0.f, 0.f, 0.f, 0.f};
#pragma unroll 1
        for (int k0 = 0; k0 < 64; k0 += 16) { f32x4 v[16];
#pragma unroll
            for (int i = 0; i < 16; ++i) v[i] = __builtin_nontemporal_load((const f32x4*)(src + (size_t)(k0 + i) * ld));
#pragma unroll
            for (int i = 0; i < 16; ++i) { const float gk = gain[kb * 64 + k0 + i]; mx.x = fmaxf(mx.x, fabsf(v[i].x * gk)); mx.y = fmaxf(mx.y, fabsf(v[i].y * gk)); mx.z = fmaxf(mx.z, fabsf(v[i].z * gk)); mx.w = fmaxf(mx.w, fabsf(v[i].w * gk)); } }
        unsigned* dst = (unsigned*)(cmax + nb * 256 + C.lane * 4);
        atomicMax(dst + 0, __float_as_uint(mx.x)); atomicMax(dst + 1, __float_as_uint(mx.y)); atomicMax(dst + 2, __float_as_uint(mx.z)); atomicMax(dst + 3, __float_as_uint(mx.w)); }
}
template <bool UPMAP>
DEV void w_quant(const Ctx& C, const float* __restrict__ W, int K, int N, const float* __restrict__ gain, const float* __restrict__ cmax, signed char* __restrict__ WQ, int ld) {
    LAS float* scr = (LAS float*)(C.lds + C.wave * 16640);
    const int gw = C.vcu * NWAVES + C.wave, NGW = C.G * NWAVES; const int nblk = N / 64, items = (K / 64) * nblk, lane = C.lane;
    for (int it = gw; it < items; it += NGW) { const int kb = it / nblk, nb = it - kb * nblk, k0 = kb * 64, n0 = nb * 64;
        const int kr = lane >> 4, nc = (lane & 15) * 4; f32x4 v[16]; float gk[16];
#pragma unroll
        for (int i = 0; i < 16; ++i) v[i] = __builtin_nontemporal_load((const f32x4*)(W + (size_t)(k0 + 4 * i + kr) * ld + n0 + nc));
#pragma unroll
        for (int i = 0; i < 16; ++i) gk[i] = gain[k0 + 4 * i + kr];
        const f32x4 cm = *(const f32x4*)(cmax + n0 + nc); const f32x4 sc = {cm.x > 0.f ? 127.0f / cm.x : 0.f, cm.y > 0.f ? 127.0f / cm.y : 0.f, cm.z > 0.f ? 127.0f / cm.z : 0.f, cm.w > 0.f ? 127.0f / cm.w : 0.f};
#pragma unroll
        for (int i = 0; i < 16; ++i) { LAS float* sp = scr + (4 * i + kr) * 65 + nc; sp[0] = v[i].x * gk[i] * sc.x; sp[1] = v[i].y * gk[i] * sc.y; sp[2] = v[i].z * gk[i] * sc.z; sp[3] = v[i].w * gk[i] * sc.w; }
        asm volatile("s_waitcnt lgkmcnt(0)" ::: "memory");
        const int c = lane & 3, drow0 = UPMAP ? tr_row_up(n0) : n0;
#pragma unroll
        for (int j = 0; j < 4; ++j) { const int n = 16 * j + (lane >> 2); const LAS float* sp = scr + (16 * c) * 65 + n; u32x4 o;
#pragma unroll
            for (int d = 0; d < 4; ++d) { unsigned w = 0u;
#pragma unroll
                for (int b = 0; b < 4; ++b) w |= ((unsigned)(int)__builtin_rintf(sp[(4 * d + b) * 65]) & 255u) << (8 * b);
                o[d] = w; }
            __builtin_nontemporal_store(o, (u32x4*)(WQ + (size_t)(drow0 + n) * K + k0 + 16 * c)); }
        asm volatile("s_waitcnt lgkmcnt(0)" ::: "memory"); }
}
template <bool UPMAP>
DEV void w_quant_stripe(const Ctx& C, const float* __restrict__ W, int N, const float* __restrict__ gain, float* __restrict__ cmax, signed char* __restrict__ WQ, int ld) {
    constexpr int K = 4096, TP = 4112;
    LAS unsigned char* T = C.lds; LAS float* red = (LAS float*)(C.lds + 32 * TP); LAS float* cm = red + 64 * 32;
    const int tid = C.tid, quad = tid & 7, rsub = tid >> 3;
    for (int st = C.vcu; st < N / 32; st += C.G) { const int n0 = st * 32; const float* src = W + n0 + quad * 4;
        f32x4 mx = {0.f, 0.f, 0.f, 0.f};
#pragma unroll 1
        for (int b = 0; b < 2; ++b) { f32x4 v[32];
#pragma unroll
            for (int i = 0; i < 32; ++i) v[i] = *(const f32x4*)(src + (size_t)(rsub + 64 * (32 * b + i)) * ld);
#pragma unroll
            for (int i = 0; i < 32; ++i) { const float gk = gain[rsub + 64 * (32 * b + i)]; mx.x = fmaxf(mx.x, fabsf(v[i].x * gk)); mx.y = fmaxf(mx.y, fabsf(v[i].y * gk)); mx.z = fmaxf(mx.z, fabsf(v[i].z * gk)); mx.w = fmaxf(mx.w, fabsf(v[i].w * gk)); } }
        *(LAS f32x4*)(red + rsub * 32 + quad * 4) = mx;
        __syncthreads();
        if (tid < 32) { float m = 0.f;
#pragma unroll 8
            for (int r = 0; r < 64; ++r) m = fmaxf(m, red[r * 32 + tid]);
            cm[tid] = m; cmax[n0 + tid] = m; }
        __syncthreads();
        const f32x4 cq = *(const LAS f32x4*)(cm + quad * 4);
        const f32x4 sc = {cq.x > 0.f ? 127.0f / cq.x : 0.f, cq.y > 0.f ? 127.0f / cq.y : 0.f, cq.z > 0.f ? 127.0f / cq.z : 0.f, cq.w > 0.f ? 127.0f / cq.w : 0.f};
#pragma unroll 1
        for (int b = 0; b < 2; ++b) { f32x4 v[32];
#pragma unroll
            for (int i = 0; i < 32; ++i) v[i] = *(const f32x4*)(src + (size_t)(4 * (rsub + 64 * (8 * b + (i >> 2))) + (i & 3)) * ld);
#pragma unroll
            for (int j = 0; j < 8; ++j) { const int rb = rsub + 64 * (8 * b + j); unsigned w0 = 0u, w1 = 0u, w2 = 0u, w3 = 0u;
#pragma unroll
                for (int r = 0; r < 4; ++r) { const float gk = gain[4 * rb + r]; const f32x4 x = v[4 * j + r];
                    w0 |= ((unsigned)(int)__builtin_rintf(x.x * gk * sc.x) & 255u) << (8 * r); w1 |= ((unsigned)(int)__builtin_rintf(x.y * gk * sc.y) & 255u) << (8 * r);
                    w2 |= ((unsigned)(int)__builtin_rintf(x.z * gk * sc.z) & 255u) << (8 * r); w3 |= ((unsigned)(int)__builtin_rintf(x.w * gk * sc.w) & 255u) << (8 * r); }
                LAS unsigned char* tp = T + (quad * 4) * TP + 4 * rb;
                *(LAS unsigned*)(tp) = w0; *(LAS unsigned*)(tp + TP) = w1; *(LAS unsigned*)(tp + 2 * TP) = w2; *(LAS unsigned*)(tp + 3 * TP) = w3; } }
        __syncthreads();
        const int drow0 = UPMAP ? tr_row_up(n0) : n0;
#pragma unroll 4
        for (int j = 0; j < 16; ++j) { const int id = tid + 512 * j, col = id >> 8, ch = id & 255;
            __builtin_nontemporal_store(*(const LAS u32x4*)(T + col * TP + ch * 16), (u32x4*)(WQ + (size_t)(drow0 + col) * K + ch * 16)); }
        __syncthreads();
    }
}
constexpr int CW_QCNT = 65536;
template <bool UPMAP, int LD>
DEV void w_quant_half(const Ctx& C, const float* __restrict__ W, const float* __restrict__ gain, float* __restrict__ cmax, signed char* __restrict__ WQ, unsigned* cnt, int tt) {
    constexpr int K = 4096, KH = 2048, TP = 2064;
    LAS unsigned char* T = C.lds; LAS float* red = (LAS float*)(C.lds + 32 * TP); LAS float* cm = red + 64 * 32;
    const int tid = C.tid, quad = tid & 7, rsub = tid >> 3;
    const int st = tt >> 1, half = tt & 1, n0 = st * 32; const float* src = W + n0 + quad * 4;
    f32x4 v[32];
#pragma unroll
    for (int i = 0; i < 32; ++i) v[i] = __builtin_nontemporal_load((const f32x4*)(src + (size_t)(4 * (rsub + 64 * (8 * half + (i >> 2))) + (i & 3)) * LD));
    f32x4 mx = {0.f, 0.f, 0.f, 0.f};
#pragma unroll
    for (int j = 0; j < 8; ++j) { const f32x4 g4 = *(const f32x4*)(gain + 4 * (rsub + 64 * (8 * half + j)));
#pragma unroll
        for (int r = 0; r < 4; ++r) { f32x4 x = v[4 * j + r] * g4[r]; v[4 * j + r] = x;
            mx.x = fmaxf(mx.x, fabsf(x.x)); mx.y = fmaxf(mx.y, fabsf(x.y)); mx.z = fmaxf(mx.z, fabsf(x.z)); mx.w = fmaxf(mx.w, fabsf(x.w)); } }
    *(LAS f32x4*)(red + rsub * 32 + quad * 4) = mx;
    __syncthreads();
    if (tid < 64) {
        if (tid < 32) { float m = 0.f;
#pragma unroll 8
            for (int r = 0; r < 64; ++r) m = fmaxf(m, red[r * 32 + tid]);
            const unsigned old = __hip_atomic_fetch_max((unsigned*)cmax + n0 + tid, __builtin_bit_cast(unsigned, m), __ATOMIC_RELAXED, __HIP_MEMORY_SCOPE_AGENT);
            asm volatile("" :: "v"(old)); }
        asm volatile("s_waitcnt vmcnt(0)" ::: "memory");
        if (tid == 0) { (void)xb_add(cnt, 1u); unsigned sp = 0u;
            while (xb_ld(cnt) < 2u) { __builtin_amdgcn_s_sleep(1); if (++sp > (1u << 20)) break; } }
        asm volatile("" ::: "memory");
        if (tid < 32) cm[tid] = __builtin_bit_cast(float, xb_ld((unsigned*)cmax + n0 + tid));
    }
    __syncthreads();
    const f32x4 cq = *(const LAS f32x4*)(cm + quad * 4);
    const f32x4 sc = {cq.x > 0.f ? 127.0f / cq.x : 0.f, cq.y > 0.f ? 127.0f / cq.y : 0.f, cq.z > 0.f ? 127.0f / cq.z : 0.f, cq.w > 0.f ? 127.0f / cq.w : 0.f};
#pragma unroll
    for (int j = 0; j < 8; ++j) { const int rbl = rsub + 64 * j; unsigned w0 = 0u, w1 = 0u, w2 = 0u, w3 = 0u;
#pragma unroll
        for (int r = 0; r < 4; ++r) { const f32x4 x = v[4 * j + r];
            w0 |= ((unsigned)(int)__builtin_rintf(x.x * sc.x) & 255u) << (8 * r); w1 |= ((unsigned)(int)__builtin_rintf(x.y * sc.y) & 255u) << (8 * r);
            w2 |= ((unsigned)(int)__builtin_rintf(x.z * sc.z) & 255u) << (8 * r); w3 |= ((unsigned)(int)__builtin_rintf(x.w * sc.w) & 255u) << (8 * r); }
        LAS unsigned char* tp = T + (quad * 4) * TP + 4 * rbl;
        *(LAS unsigned*)(tp) = w0; *(LAS unsigned*)(tp + TP) = w1; *(LAS unsigned*)(tp + 2 * TP) = w2; *(LAS unsigned*)(tp + 3 * TP) = w3; }
    __syncthreads();
    const int drow0 = UPMAP ? tr_row_up(n0) : n0;
#pragma unroll 4
    for (int j = 0; j < 8; ++j) { const int id = tid + 512 * j, col = id >> 7, ch = id & 127;
        __builtin_nontemporal_store(*(const LAS u32x4*)(T + col * TP + ch * 16), (u32x4*)(WQ + (size_t)(drow0 + col) * K + half * KH + ch * 16)); }
    __syncthreads();
}
struct QTask { const float* W; const float* gain; float* cmax; signed char* WQ; unsigned* cnt; int ld, up, n0, part; };
DEV void q_load(f32x4 (&v)[16], const QTask& k, int quad, int rsub) {
    const float* src = k.W + k.n0 + quad * 4;
#pragma unroll
    for (int i = 0; i < 16; ++i) v[i] = __builtin_nontemporal_load((const f32x4*)(src + (size_t)(4 * (rsub + 64 * (4 * k.part + (i >> 2))) + (i & 3)) * k.ld));
}
DEV void w_quant_pipe(const Ctx& C, const float* Win, const float* gin, const float* Wup, const float* gup, float* CMAX, signed char* Qin, signed char* Qup0, signed char* Qup1, unsigned* cntb) {
    constexpr int K = 4096, KQ = 1024, TP = 1040, T_IN = NZI8 / 8, T_UP = NUP / 8, T_ALL = T_IN + 2 * T_UP;
    LAS unsigned char* T = C.lds; LAS float* red = (LAS float*)(C.lds + 32 * TP); LAS float* cm = red + 64 * 32;
    const int tid = C.tid, quad = tid & 7, rsub = tid >> 3;
    auto decode = [&](int t, QTask& k) {
        k.cnt = cntb + (t >> 2); k.part = t & 3;
        if (t < T_IN) { k.W = Win; k.gain = gin; k.cmax = CMAX + 2 * NUP; k.WQ = Qin; k.ld = NIN; k.up = 0; k.n0 = (t >> 2) * 32; }
        else { const int u = t - T_IN, L = u >= T_UP ? 1 : 0, tt = u - L * T_UP;
            k.W = Wup + (size_t)L * DM * NUP; k.gain = gup + L * DM; k.cmax = CMAX + L * NUP; k.WQ = L ? Qup1 : Qup0; k.ld = NUP; k.up = 1; k.n0 = (tt >> 2) * 32; } };
    int t = C.vcu; if (t >= T_ALL) return;
    QTask k; decode(t, k);
    f32x4 cur[16], nxt[16];
    q_load(cur, k, quad, rsub);
    for (;;) {
        f32x4 mx = {0.f, 0.f, 0.f, 0.f};
#pragma unroll
        for (int j = 0; j < 4; ++j) { const f32x4 g4 = *(const f32x4*)(k.gain + 4 * (rsub + 64 * (4 * k.part + j)));
#pragma unroll
            for (int r = 0; r < 4; ++r) { f32x4 x = cur[4 * j + r] * g4[r]; cur[4 * j + r] = x;
                mx.x = fmaxf(mx.x, fabsf(x.x)); mx.y = fmaxf(mx.y, fabsf(x.y)); mx.z = fmaxf(mx.z, fabsf(x.z)); mx.w = fmaxf(mx.w, fabsf(x.w)); } }
        *(LAS f32x4*)(red + rsub * 32 + quad * 4) = mx;
        __syncthreads();
        if (tid < 64) {
            if (tid < 32) { float m = 0.f;
#pragma unroll 8
                for (int r = 0; r < 64; ++r) m = fmaxf(m, red[r * 32 + tid]);
                const unsigned old = __hip_atomic_fetch_max((unsigned*)k.cmax + k.n0 + tid, __builtin_bit_cast(unsigned, m), __ATOMIC_RELAXED, __HIP_MEMORY_SCOPE_AGENT);
                asm volatile("" :: "v"(old)); }
            asm volatile("s_waitcnt vmcnt(0)" ::: "memory");
            if (tid == 0) (void)xb_add(k.cnt, 1u);
        }
        const int t2 = t + C.G; const bool has2 = t2 < T_ALL; QTask k2;
        if (has2) { decode(t2, k2); q_load(nxt, k2, quad, rsub); }
        if (tid < 64) {
            if (tid == 0) { unsigned sp = 0u; while (xb_ld(k.cnt) < 4u) { __builtin_amdgcn_s_sleep(1); if (++sp > (1u << 20)) break; } }
            asm volatile("" ::: "memory");
            if (tid < 32) cm[tid] = __builtin_bit_cast(float, xb_ld((unsigned*)k.cmax + k.n0 + tid));
        }
        __syncthreads();
        const f32x4 cq = *(const LAS f32x4*)(cm + quad * 4);
        const f32x4 sc = {cq.x > 0.f ? 127.0f / cq.x : 0.f, cq.y > 0.f ? 127.0f / cq.y : 0.f, cq.z > 0.f ? 127.0f / cq.z : 0.f, cq.w > 0.f ? 127.0f / cq.w : 0.f};
#pragma unroll
        for (int j = 0; j < 4; ++j) { const int rbl = rsub + 64 * j; unsigned w0 = 0u, w1 = 0u, w2 = 0u, w3 = 0u;
#pragma unroll
            for (int r = 0; r < 4; ++r) { const f32x4 x = cur[4 * j + r];
                w0 |= ((unsigned)(int)__builtin_rintf(x.x * sc.x) & 255u) << (8 * r); w1 |= ((unsigned)(int)__builtin_rintf(x.y * sc.y) & 255u) << (8 * r);
                w2 |= ((unsigned)(int)__builtin_rintf(x.z * sc.z) & 255u) << (8 * r); w3 |= ((unsigned)(int)__builtin_rintf(x.w * sc.w) & 255u) << (8 * r); }
            LAS unsigned char* tp = T + (quad * 4) * TP + 4 * rbl;
            *(LAS unsigned*)(tp) = w0; *(LAS unsigned*)(tp + TP) = w1; *(LAS unsigned*)(tp + 2 * TP) = w2; *(LAS unsigned*)(tp + 3 * TP) = w3; }
        __syncthreads();
        const int drow0 = k.up ? tr_row_up(k.n0) : k.n0;
#pragma unroll
        for (int j = 0; j < 4; ++j) { const int id = tid + 512 * j, col = id >> 6, ch = id & 63;
            __builtin_nontemporal_store(*(const LAS u32x4*)(T + col * TP + ch * 16), (u32x4*)(k.WQ + (size_t)(drow0 + col) * K + k.part * KQ + ch * 16)); }
        __syncthreads();
        if (!has2) break;
#pragma unroll
        for (int i = 0; i < 16; ++i) cur[i] = nxt[i];
        k = k2; t = t2;
    }
}
template <int SC>
DEV void w_quant_wide(const Ctx& C, const float* Win, const float* gin, const float* Wup, const float* gup, float* CMAX, signed char* Qin, signed char* Qup0, signed char* Qup1, unsigned* cntb) {
    constexpr int K = 4096, QN = SC / 4, RP = 2048 / SC, KB = 65536 / SC, P = SC / 16, TP = KB + 16, NCH = KB / 16;
    constexpr int T_IN = (NZI8 / SC) * P, T_UP = (NUP / SC) * P, T_ALL = T_IN + 2 * T_UP;
    LAS unsigned char* T = C.lds; LAS float* red = (LAS float*)(C.lds + SC * TP); LAS float* cm = red + RP * SC;
    const int tid = C.tid, quad = tid % QN, rsub = tid / QN;
    for (int t = C.vcu; t < T_ALL; t += C.G) {
        const float* W; const float* gain; float* cmax; signed char* WQ; int ld, up, tt;
        if (t < T_IN) { W = Win; gain = gin; cmax = CMAX + 2 * NUP; WQ = Qin; ld = NIN; up = 0; tt = t; }
        else { const int u = t - T_IN, L = u >= T_UP ? 1 : 0; tt = u - L * T_UP; W = Wup + (size_t)L * DM * NUP; gain = gup + L * DM; cmax = CMAX + L * NUP; WQ = L ? Qup1 : Qup0; ld = NUP; up = 1; }
        const int n0 = (tt / P) * SC, part = tt % P; unsigned* cnt = cntb + t / P;
        const float* src = W + (size_t)(part * KB) * ld + n0 + quad * 4;
        f32x4 v[32];
#pragma unroll
        for (int i = 0; i < 32; ++i) v[i] = __builtin_nontemporal_load((const f32x4*)(src + (size_t)(4 * (rsub + RP * (i >> 2)) + (i & 3)) * ld));
        f32x4 mx = {0.f, 0.f, 0.f, 0.f};
#pragma unroll
        for (int j = 0; j < 8; ++j) { const f32x4 g4 = *(const f32x4*)(gain + part * KB + 4 * (rsub + RP * j));
#pragma unroll
            for (int r = 0; r < 4; ++r) { f32x4 x = v[4 * j + r] * g4[r]; v[4 * j + r] = x;
                mx.x = fmaxf(mx.x, fabsf(x.x)); mx.y = fmaxf(mx.y, fabsf(x.y)); mx.z = fmaxf(mx.z, fabsf(x.z)); mx.w = fmaxf(mx.w, fabsf(x.w)); } }
        *(LAS f32x4*)(red + rsub * SC + quad * 4) = mx;
        __syncthreads();
        if (tid < SC) { float m = 0.f;
#pragma unroll
            for (int r = 0; r < RP; ++r) m = fmaxf(m, red[r * SC + tid]);
            const unsigned old = __hip_atomic_fetch_max((unsigned*)cmax + n0 + tid, __builtin_bit_cast(unsigned, m), __ATOMIC_RELAXED, __HIP_MEMORY_SCOPE_AGENT);
            asm volatile("" :: "v"(old));
            asm volatile("s_waitcnt vmcnt(0)" ::: "memory"); }
        __syncthreads();
        if (tid == 0) { (void)xb_add(cnt, 1u); unsigned sp = 0u; while (xb_ld(cnt) < (unsigned)P) { __builtin_amdgcn_s_sleep(1); if (++sp > (1u << 20)) break; } }
        __syncthreads();
        if (tid < SC) cm[tid] = __builtin_bit_cast(float, xb_ld((unsigned*)cmax + n0 + tid));
        __syncthreads();
        const f32x4 cq = *(const LAS f32x4*)(cm + quad * 4);
        const f32x4 sc = {cq.x > 0.f ? 127.0f / cq.x : 0.f, cq.y > 0.f ? 127.0f / cq.y : 0.f, cq.z > 0.f ? 127.0f / cq.z : 0.f, cq.w > 0.f ? 127.0f / cq.w : 0.f};
#pragma unroll
        for (int j = 0; j < 8; ++j) { const int rbl = rsub + RP * j; unsigned w0 = 0u, w1 = 0u, w2 = 0u, w3 = 0u;
#pragma unroll
            for (int r = 0; r < 4; ++r) { const f32x4 x = v[4 * j + r];
                w0 |= ((unsigned)(int)__builtin_rintf(x.x * sc.x) & 255u) << (8 * r); w1 |= ((unsigned)(int)__builtin_rintf(x.y * sc.y) & 255u) << (8 * r);
                w2 |= ((unsigned)(int)__builtin_rintf(x.z * sc.z) & 255u) << (8 * r); w3 |= ((unsigned)(int)__builtin_rintf(x.w * sc.w) & 255u) << (8 * r); }
            LAS unsigned char* tp = T + (quad * 4) * TP + 16 * ((rbl >> 2) ^ (quad & 7)) + 4 * (rbl & 3);
            *(LAS unsigned*)(tp) = w0; *(LAS unsigned*)(tp + TP) = w1; *(LAS unsigned*)(tp + 2 * TP) = w2; *(LAS unsigned*)(tp + 3 * TP) = w3; }
        __syncthreads();
#pragma unroll 4
        for (int j = 0; j < 8; ++j) { const int id = tid + 512 * j, col = id / NCH, ch = id % NCH; const int nc = n0 + col, drow = up ? tr_row_up(nc) : nc;
            __builtin_nontemporal_store(*(const LAS u32x4*)(T + col * TP + 16 * (ch ^ ((col >> 2) & 7))), (u32x4*)(WQ + (size_t)drow * K + part * KB + ch * 16)); }
        __syncthreads();
    }
}
DEV void ffn_fixup(const Ctx& C, const float* __restrict__ HALO, bf16* __restrict__ ACT, const float* __restrict__ cw, const float* __restrict__ cb) {
    const int gtid = C.vcu * (NWAVES * 64) + C.tid, nthr = C.G * NWAVES * 64;
    constexpr int NCC = DFF / 4, NT = (SEQ / 256) * NCC;
    for (int it = gtid; it < NT; it += nthr) { const int pm = it / NCC, c0 = (it - pm * NCC) * 4;
        f32x4 r[2][4];
#pragma unroll
        for (int bj = 0; bj < 2; ++bj) {
            r[bj][0] = pm ? *(const f32x4*)(HALO + (size_t)((pm - 1) * 4 + 2) * NUP + bj * DFF + c0) : (f32x4){0.f, 0.f, 0.f, 0.f};
            r[bj][1] = pm ? *(const f32x4*)(HALO + (size_t)((pm - 1) * 4 + 3) * NUP + bj * DFF + c0) : (f32x4){0.f, 0.f, 0.f, 0.f};
            r[bj][2] = *(const f32x4*)(HALO + (size_t)(pm * 4 + 0) * NUP + bj * DFF + c0);
            r[bj][3] = *(const f32x4*)(HALO + (size_t)(pm * 4 + 1) * NUP + bj * DFF + c0); }
        f32x4 w[2][3], b[2];
#pragma unroll
        for (int bj = 0; bj < 2; ++bj) {
#pragma unroll
            for (int k = 0; k < 3; ++k) w[bj][k] = *(const f32x4*)(cw + (size_t)k * NUP + bj * DFF + c0);
            b[bj] = *(const f32x4*)(cb + bj * DFF + c0); }
#pragma unroll
        for (int rr = 0; rr < 2; ++rr) {
            const f32x4 G = b[0] + w[0][0] * r[0][rr] + w[0][1] * r[0][rr + 1] + w[0][2] * r[0][rr + 2];
            const f32x4 V = b[1] + w[1][0] * r[1][rr] + w[1][1] * r[1][rr + 1] + w[1][2] * r[1][rr + 2];
            u32x2 o; o.x = pk2(silu_f(G.x) * V.x, silu_f(G.y) * V.y); o.y = pk2(silu_f(G.z) * V.z, silu_f(G.w) * V.w);
            *(u32x2*)(ACT + (size_t)(pm * 256 + rr) * DFF + c0) = o; }
    }
}

DEV float wave_max(float v) {
#pragma unroll
    for (int o = 1; o < 64; o <<= 1) v = fmaxf(v, __shfl_xor(v, o));
    return v;
}
template <bool HOLD_F32, bool OUT_F32, bool Q8 = false>
DEV void thin_row(const bf16* mixrow, const void* holdv, void* hnewv, const float* gpost, float* rs, int lane, signed char* a8row = nullptr, float* rsq = nullptr) {
    float v[8][8];
    float ss = 0.f;
#pragma unroll
    for (int j = 0; j < 8; ++j) { const u32x4 m = *(const u32x4*)(mixrow + (j * 64 + lane) * 8); unpack8(m, v[j]);
#pragma unroll
        for (int e = 0; e < 8; ++e) ss += v[j][e] * v[j][e]; }
    const float rstd = 1.0f / sqrtf(wave_sum(ss) * (1.0f / DM) + EPS);
    float ss2 = 0.f;
#pragma unroll
    for (int j = 0; j < 8; ++j) { const int c0 = (j * 64 + lane) * 8; float h[8];
        if (HOLD_F32) { const f32x4 h0 = *(const f32x4*)((const float*)holdv + c0), h1 = *(const f32x4*)((const float*)holdv + c0 + 4); h[0] = h0.x; h[1] = h0.y; h[2] = h0.z; h[3] = h0.w; h[4] = h1.x; h[5] = h1.y; h[6] = h1.z; h[7] = h1.w; }
        else unpack8(*(const u32x4*)((const bf16*)holdv + c0), h);
        const f32x4 g0 = *(const f32x4*)(gpost + c0), g1 = *(const f32x4*)(gpost + c0 + 4); const float g[8] = {g0.x, g0.y, g0.z, g0.w, g1.x, g1.y, g1.z, g1.w};
#pragma unroll
        for (int e = 0; e < 8; ++e) v[j][e] = h[e] + v[j][e] * rstd * g[e];
        if (OUT_F32) { *(f32x4*)((float*)hnewv + c0) = (f32x4){v[j][0], v[j][1], v[j][2], v[j][3]}; *(f32x4*)((float*)hnewv + c0 + 4) = (f32x4){v[j][4], v[j][5], v[j][6], v[j][7]}; }
        else { const u32x4 w = pack8(v[j]); *(u32x4*)((bf16*)hnewv + c0) = w; float r[8]; unpack8(w, r);
#pragma unroll
            for (int e = 0; e < 8; ++e) ss2 += r[e] * r[e]; } }
    if (!OUT_F32) { const float rstd2 = 1.0f / sqrtf(wave_sum(ss2) * (1.0f / DM) + EPS); if (lane == 0) *rs = rstd2;
        if constexpr (Q8) {
            float am = 0.f;
#pragma unroll
            for (int j = 0; j < 8; ++j)
#pragma unroll
                for (int e = 0; e < 8; ++e) am = fmaxf(am, fabsf(v[j][e]));
            am = fmaxf(wave_max(am), 1e-30f); const float sq = 127.0f / am;
#pragma unroll
            for (int j = 0; j < 8; ++j) { unsigned lo = 0u, hi = 0u;
#pragma unroll
                for (int e = 0; e < 4; ++e) { lo |= ((unsigned)(int)__builtin_rintf(v[j][e] * sq) & 255u) << (8 * e); hi |= ((unsigned)(int)__builtin_rintf(v[j][4 + e] * sq) & 255u) << (8 * e); }
                u32x2 w; w.x = lo; w.y = hi; *(u32x2*)(a8row + (j * 64 + lane) * 8) = w; }
            if (lane == 0) *rsq = rstd2 * am * (1.0f / 127.0f); } }
}
template <bool HOLD_F32, bool OUT_F32, bool Q8 = false>
DEV void thin_phase(const Ctx& C, const bf16* mix, const void* hold, void* hnew, const float* gpost, float* RS, signed char* A8 = nullptr, float* RSQ = nullptr) {
    const int gw = C.vcu * NWAVES + C.wave, NGW = C.G * NWAVES;
    for (int r = gw; r < SEQ; r += NGW) thin_row<HOLD_F32, OUT_F32, Q8>(mix + (size_t)r * DM, (const char*)hold + (size_t)r * DM * (HOLD_F32 ? 4 : 2), (char*)hnew + (size_t)r * DM * (OUT_F32 ? 4 : 2), gpost, RS + r, C.lane,
                                                                          Q8 ? A8 + (size_t)r * DM : nullptr, Q8 ? RSQ + r : nullptr);
}
DEV void xnorm_phase(const Ctx& C, const float* xin, bf16* abuf, signed char* a8, float* rsq) {
    const int gw = C.vcu * NWAVES + C.wave, NGW = C.G * NWAVES;
    for (int r = gw; r < SEQ; r += NGW) { const float* xr = xin + (size_t)r * DM; bf16* ar = abuf + (size_t)r * DM; float v[8][8]; float ss = 0.f, am = 0.f;
#pragma unroll
        for (int j = 0; j < 8; ++j) { const int c0 = (j * 64 + C.lane) * 8; const f32x4 h0 = *(const f32x4*)(xr + c0), h1 = *(const f32x4*)(xr + c0 + 4);
            v[j][0] = h0.x; v[j][1] = h0.y; v[j][2] = h0.z; v[j][3] = h0.w; v[j][4] = h1.x; v[j][5] = h1.y; v[j][6] = h1.z; v[j][7] = h1.w;
#pragma unroll
            for (int e = 0; e < 8; ++e) { ss += v[j][e] * v[j][e]; am = fmaxf(am, fabsf(v[j][e])); } }
        const float rstd = 1.0f / sqrtf(wave_sum(ss) * (1.0f / DM) + EPS);
        am = fmaxf(wave_max(am), 1e-30f); const float sq = 127.0f / am;
#pragma unroll
        for (int j = 0; j < 8; ++j) { float o[8]; unsigned lo = 0u, hi = 0u;
#pragma unroll
            for (int e = 0; e < 8; ++e) o[e] = v[j][e] * rstd;
            *(u32x4*)(ar + (j * 64 + C.lane) * 8) = pack8(o);
#pragma unroll
            for (int e = 0; e < 4; ++e) { lo |= ((unsigned)(int)__builtin_rintf(v[j][e] * sq) & 255u) << (8 * e); hi |= ((unsigned)(int)__builtin_rintf(v[j][4 + e] * sq) & 255u) << (8 * e); }
            u32x2 w; w.x = lo; w.y = hi; *(u32x2*)(a8 + (size_t)r * DM + (j * 64 + C.lane) * 8) = w; }
        if (C.lane == 0) rsq[r] = rstd * am * (1.0f / 127.0f); }
}

DEV void dt_gemm(const Ctx& C, const bf16* __restrict__ A, const bf16* __restrict__ Bt, float* __restrict__ out) {
    const int r16 = C.lane & 15, kq = C.lane >> 4; LAS float* part = (LAS float*)C.lds;
    for (int rb = C.vcu; rb < SEQ / 32; rb += C.G) {
        const bf16* a0 = A + (size_t)(rb * 32 + r16) * DM + C.wave * 512 + kq * 8; const bf16* a1 = a0 + (size_t)16 * DM;
        const bf16* b0 = Bt + (size_t)r16 * DM + C.wave * 512 + kq * 8;
        f32x4 acc[2][8];
#pragma unroll
        for (int m = 0; m < 2; ++m)
#pragma unroll
            for (int n = 0; n < 8; ++n) acc[m][n] = (f32x4){0.f, 0.f, 0.f, 0.f};
#pragma unroll 2
        for (int ks = 0; ks < 16; ++ks) {
            const bf16x8 fa0 = *(const bf16x8*)(a0 + ks * 32), fa1 = *(const bf16x8*)(a1 + ks * 32); bf16x8 fb[8];
#pragma unroll
            for (int n = 0; n < 8; ++n) fb[n] = *(const bf16x8*)(b0 + (size_t)(16 * n) * DM + ks * 32);
#pragma unroll
            for (int n = 0; n < 8; ++n) { acc[0][n] = __builtin_amdgcn_mfma_f32_16x16x32_bf16(fa0, fb[n], acc[0][n], 0, 0, 0); acc[1][n] = __builtin_amdgcn_mfma_f32_16x16x32_bf16(fa1, fb[n], acc[1][n], 0, 0, 0); }
        }
#pragma unroll
        for (int m = 0; m < 2; ++m)
#pragma unroll
            for (int n = 0; n < 8; ++n)
#pragma unroll
                for (int r = 0; r < 4; ++r) part[(C.wave * 32 + m * 16 + kq * 4 + r) * 128 + n * 16 + r16] = acc[m][n][r];
        __syncthreads();
#pragma unroll
        for (int i = 0; i < 2; ++i) { const int e = (C.tid + 512 * i) * 4;
            f32x4 sum = *(const LAS f32x4*)(part + e);
#pragma unroll
            for (int w = 1; w < 8; ++w) sum += *(const LAS f32x4*)(part + w * 4096 + e);
            *(f32x4*)(out + (size_t)rb * 32 * 128 + e) = sum; }
        __syncthreads();
    }
}

DEV void ssd_prep(const Ctx& C, const float* __restrict__ dtraw, const float* __restrict__ dtbias, const float* __restrict__ alog, float* __restrict__ DT, float* __restrict__ ACUM) {
    LAS float* segsum = (LAS float*)C.lds;
    for (int c = C.vcu; c < NCHUNK; c += C.G) {
        const int h = C.tid & 127, seg = C.tid >> 7; const float bias = dtbias[h], Aneg = -__expf(alog[h]);
        const size_t o0 = (size_t)(c * CHUNK + seg * 32) * NHEAD + h;
        float xr[32];
#pragma unroll
        for (int i = 0; i < 32; ++i) xr[i] = dtraw[o0 + (size_t)i * NHEAD];
        float run = 0.f;
#pragma unroll
        for (int i = 0; i < 32; ++i) { const float xx = xr[i] + bias; const float dt = fmaxf(xx, 0.f) + log1pf(__expf(-fabsf(xx))); DT[o0 + (size_t)i * NHEAD] = dt; run += dt * Aneg; xr[i] = run; }
        segsum[seg * 128 + h] = run;
        __syncthreads();
        float pre = 0.f;
#pragma unroll
        for (int k = 0; k < 3; ++k) pre += (k < seg) ? segsum[k * 128 + h] : 0.f;
#pragma unroll
        for (int i = 0; i < 32; ++i) ACUM[o0 + (size_t)i * NHEAD] = xr[i] + pre;
        __syncthreads();
    }
}

#define MFMA32(a, b, c) __builtin_amdgcn_mfma_f32_32x32x16_bf16((a), (b), (c), 0, 0, 0)
constexpr int LROW = 272;
DEV void transpose8x8(const u32x4 (&r)[8], u32x4 (&o)[8]) {
#pragma unroll
    for (int c2 = 0; c2 < 4; ++c2) {
        const unsigned a0 = r[0][c2], a1 = r[1][c2], a2 = r[2][c2], a3 = r[3][c2], a4 = r[4][c2], a5 = r[5][c2], a6 = r[6][c2], a7 = r[7][c2];
        o[2 * c2].x = __builtin_amdgcn_perm(a1, a0, 0x05040100u); o[2 * c2].y = __builtin_amdgcn_perm(a3, a2, 0x05040100u); o[2 * c2].z = __builtin_amdgcn_perm(a5, a4, 0x05040100u); o[2 * c2].w = __builtin_amdgcn_perm(a7, a6, 0x05040100u);
        o[2 * c2 + 1].x = __builtin_amdgcn_perm(a1, a0, 0x07060302u); o[2 * c2 + 1].y = __builtin_amdgcn_perm(a3, a2, 0x07060302u); o[2 * c2 + 1].z = __builtin_amdgcn_perm(a5, a4, 0x07060302u); o[2 * c2 + 1].w = __builtin_amdgcn_perm(a7, a6, 0x07060302u); }
}
DEV void conv8x8(const bf16* __restrict__ ZX, size_t t0, int ch0, const float* __restrict__ cw, const float* __restrict__ cb, u32x4 (&r)[8]) {
    const bf16* src = ZX + DINNER + ch0;
    u32x4 raw[11];
#pragma unroll
    for (int k = 0; k < 3; ++k) raw[k] = t0 ? *(const u32x4*)(src + (t0 - 3 + k) * NZX) : (u32x4){0u, 0u, 0u, 0u};
#pragma unroll
    for (int k = 0; k < 8; ++k) raw[3 + k] = *(const u32x4*)(src + (t0 + k) * NZX);
    float w[4][8], b[8];
#pragma unroll
    for (int k = 0; k < 4; ++k) { const f32x4 a = *(const f32x4*)(cw + k * CONVD + ch0), bq = *(const f32x4*)(cw + k * CONVD + ch0 + 4); w[k][0] = a.x; w[k][1] = a.y; w[k][2] = a.z; w[k][3] = a.w; w[k][4] = bq.x; w[k][5] = bq.y; w[k][6] = bq.z; w[k][7] = bq.w; }
    { const f32x4 a = *(const f32x4*)(cb + ch0), bq = *(const f32x4*)(cb + ch0 + 4); b[0] = a.x; b[1] = a.y; b[2] = a.z; b[3] = a.w; b[4] = bq.x; b[5] = bq.y; b[6] = bq.z; b[7] = bq.w; }
    float x3[8], x2[8], x1[8]; unpack8(raw[0], x3); unpack8(raw[1], x2); unpack8(raw[2], x1);
#pragma unroll
    for (int k = 0; k < 8; ++k) { float x0[8], o[8]; unpack8(raw[3 + k], x0);
#pragma unroll
        for (int e = 0; e < 8; ++e) { o[e] = silu_f(b[e] + w[0][e] * x3[e] + w[1][e] * x2[e] + w[2][e] * x1[e] + w[3][e] * x0[e]); x3[e] = x2[e]; x2[e] = x1[e]; x1[e] = x0[e]; }
        r[k] = pack8(o); }
}
DEV void ssd_states_unit(const Ctx& C, int c, int g, const bf16* __restrict__ ZX, const float* __restrict__ cw, const float* __restrict__ cb, const float* __restrict__ DT, const float* __restrict__ ACUM, bf16* __restrict__ S) {
    LAS unsigned char* BT = C.lds; LAS unsigned char* XW = C.lds + 34816; LAS float* wtab = (LAS float*)(C.lds + 104448);
    const int tid = C.tid, lane = C.lane, wave = C.wave, hh = lane >> 5, l31 = lane & 31;
    const size_t row0 = (size_t)c * CHUNK;
    for (int idx = tid; idx < 2048; idx += 512) { const int r = idx & 15, s = idx >> 4, h = g * HPG + r;
        const float alast = ACUM[(row0 + 127) * NHEAD + h]; const size_t o = (row0 + s) * NHEAD + h;
        wtab[r * 128 + s] = DT[o] * __expf(alast - ACUM[o]); }
    if (tid < 256) {
        const int so = tid & 15, oct = tid >> 4;
        u32x4 r[8], o[8];
        conv8x8(ZX, row0 + so * 8, DINNER + g * DSTATE + oct * 8, cw, cb, r);
        transpose8x8(r, o);
#pragma unroll
        for (int cc = 0; cc < 8; ++cc) *(LAS u32x4*)(BT + (oct * 8 + cc) * LROW + so * 16) = o[cc]; }
    __syncthreads();
    for (int q = 0; q < 4; ++q) {
        {
            const int so = tid & 15, oct = tid >> 4, r = 4 * q + (oct >> 3);
            u32x4 rr[8], o[8];
            conv8x8(ZX, row0 + so * 8, g * 1024 + q * 256 + oct * 8, cw, cb, rr);
            const f32x4 w0 = *(const LAS f32x4*)(wtab + r * 128 + so * 8), w1 = *(const LAS f32x4*)(wtab + r * 128 + so * 8 + 4);
            transpose8x8(rr, o);
#pragma unroll
            for (int cc = 0; cc < 8; ++cc) { float f[8]; unpack8(o[cc], f);
                u32x4 w; w.x = pk2(f[0] * w0.x, f[1] * w0.y); w.y = pk2(f[2] * w0.z, f[3] * w0.w); w.z = pk2(f[4] * w1.x, f[5] * w1.y); w.w = pk2(f[6] * w1.z, f[7] * w1.w);
                *(LAS u32x4*)(XW + (oct * 8 + cc) * LROW + so * 16) = w; } }
        __syncthreads();
        const int rq = wave >> 1, ph = wave & 1;
        f32x16 acc[4];
#pragma unroll
        for (int nt = 0; nt < 4; ++nt)
#pragma unroll
            for (int e = 0; e < 16; ++e) acc[nt][e] = 0.f;
        const LAS unsigned char* xrow = XW + (rq * 64 + ph * 32 + l31) * LROW + hh * 16;
        const LAS unsigned char* brow = BT + l31 * LROW + hh * 16;
#pragma unroll
        for (int ks = 0; ks < 8; ++ks) { const bf16x8 xb = *(const LAS bf16x8*)(xrow + ks * 32);
#pragma unroll
            for (int nt = 0; nt < 4; ++nt) { const bf16x8 a = *(const LAS bf16x8*)(brow + nt * 32 * LROW + ks * 32); acc[nt] = MFMA32(a, xb, acc[nt]); } }
        const int h = g * HPG + 4 * q + rq;
        bf16* dst = S + ((((size_t)c * NHEAD + h) * 2 + ph) * 8) * 512 + lane * 8;
#pragma unroll
        for (int nt = 0; nt < 4; ++nt)
#pragma unroll
            for (int s2 = 0; s2 < 2; ++s2) { u32x4 w; w.x = pk2(acc[nt][8 * s2 + 0], acc[nt][8 * s2 + 1]); w.y = pk2(acc[nt][8 * s2 + 2], acc[nt][8 * s2 + 3]); w.z = pk2(acc[nt][8 * s2 + 4], acc[nt][8 * s2 + 5]); w.w = pk2(acc[nt][8 * s2 + 6], acc[nt][8 * s2 + 7]);
                *(u32x4*)(dst + (2 * nt + s2) * 512) = w; }
        __syncthreads();
    }
}
DEV void ssd_scan(const Ctx& C, const bf16* __restrict__ S, const float* __restrict__ ACUM, bf16* __restrict__ ST) {
    const int gtid = C.vcu * (NWAVES * 64) + C.tid, nthr = C.G * NWAVES * 64;
    constexpr size_t CSTRIDE = (size_t)NHEAD * HDIM * DSTATE;
    for (int idx = gtid; idx < NHEAD * HDIM * DSTATE / 8; idx += nthr) {
        const int h = idx >> 10; const size_t base = (size_t)idx * 8;
        float run[8];
#pragma unroll
        for (int e = 0; e < 8; ++e) run[e] = 0.f;
#pragma unroll 1
        for (int cb = 0; cb < NCHUNK; cb += 16) { u32x4 raw[16]; float dec[16];
#pragma unroll
            for (int k = 0; k < 16; ++k) { raw[k] = __builtin_nontemporal_load((const u32x4*)(S + (cb + k) * CSTRIDE + base)); dec[k] = ACUM[((size_t)(cb + k) * CHUNK + 127) * NHEAD + h]; }
#pragma unroll
            for (int k = 0; k < 16; ++k) { float sv[8]; unpack8(raw[k], sv); const float d = __expf(dec[k]);
                *(u32x4*)(ST + (cb + k) * CSTRIDE + base) = pack8(run);
#pragma unroll
                for (int e = 0; e < 8; ++e) run[e] = run[e] * d + sv[e]; } }
    }
}
DEV void ssd_groupnorm_g(bf16* Y, size_t r0, int g, int wave, int lane) {
    for (int rr = wave; rr < CHUNK; rr += NWAVES) { bf16* p = Y + (r0 + rr) * DINNER + g * 1024 + lane * 16;
        float a[8], b[8]; unpack8(*(const u32x4*)p, a); unpack8(*(const u32x4*)(p + 8), b); float ss = 0.f;
#pragma unroll
        for (int e = 0; e < 8; ++e) ss += a[e] * a[e] + b[e] * b[e];
        const float rstd = 1.0f / sqrtf(wave_sum(ss) * (1.0f / 1024.0f) + SSM_EPS);
#pragma unroll
        for (int e = 0; e < 8; ++e) { a[e] *= rstd; b[e] *= rstd; }
        *(u32x4*)p = pack8(a); *(u32x4*)(p + 8) = pack8(b); }
}
constexpr int YROW = 528;
DEV void ssd_out_unit(const Ctx& C, int c, int g, const float* __restrict__ cw, const float* __restrict__ cb, const bf16* __restrict__ ZX, const float* __restrict__ DT, const float* __restrict__ ACUM,
                      const bf16* __restrict__ ST, const float* __restrict__ dskip, bf16* __restrict__ Y) {
    LAS unsigned char* CM = C.lds; LAS unsigned char* BM = C.lds + 34816; LAS unsigned char* XT = C.lds + 69632;
    LAS float* atab = (LAS float*)(C.lds + 139264); LAS float* dtab = (LAS float*)(C.lds + 147456); LAS float* ttab = (LAS float*)(C.lds + 155648);
    const int tid0 = C.tid, lane = C.lane, wave = C.wave, hh = lane >> 5, l31 = lane & 31;
    const size_t row0 = (size_t)c * CHUNK;
    { const int tid = tid0;
    {
        const int isc = tid >> 8, so = tid & 15, oct = (tid >> 4) & 15; u32x4 r[8];
        conv8x8(ZX, row0 + so * 8, DINNER + isc * NGRP * DSTATE + g * DSTATE + oct * 8, cw, cb, r);
        LAS unsigned char* dstm = isc ? CM : BM;
#pragma unroll
        for (int j = 0; j < 8; ++j) *(LAS u32x4*)(dstm + (so * 8 + j) * LROW + oct * 16) = r[j]; }
    for (int idx = tid; idx < 2048; idx += 512) { const int r = idx & 15, s = idx >> 4; const size_t o = (row0 + s) * NHEAD + g * HPG + r; atab[r * 128 + s] = ACUM[o]; dtab[r * 128 + s] = DT[o]; } }
    __syncthreads();
    {
        const int lt = wave >> 1, st0 = 2 * (wave & 1);
        f32x16 cb[2];
#pragma unroll
        for (int t = 0; t < 2; ++t)
#pragma unroll
            for (int e = 0; e < 16; ++e) cb[t][e] = 0.f;
        const LAS unsigned char* arow = CM + (lt * 32 + l31) * LROW + hh * 16;
        const LAS unsigned char* brow = BM + (st0 * 32 + l31) * LROW + hh * 16;
#pragma unroll
        for (int ks = 0; ks < 8; ++ks) { const bf16x8 a = *(const LAS bf16x8*)(arow + ks * 32);
#pragma unroll
            for (int t = 0; t < 2; ++t) { const bf16x8 b = *(const LAS bf16x8*)(brow + t * 32 * LROW + ks * 32); cb[t] = MFMA32(a, b, cb[t]); } }
        __syncthreads();
#pragma unroll
        for (int t = 0; t < 2; ++t)
#pragma unroll
            for (int e = 0; e < 16; ++e) { const int l = lt * 32 + (e & 3) + 8 * (e >> 2) + 4 * hh, s = (st0 + t) * 32 + l31;
                *(LAS unsigned short*)(BM + l * LROW + s * 2) = f2bf(cb[t][e]); }
    }
    __syncthreads();
    float ssq[8];
#pragma unroll
    for (int i = 0; i < 8; ++i) ssq[i] = 0.f;
    for (int q = 0; q < 4; ++q) {
        int tid = tid0; asm volatile("" : "+v"(tid));
        const int ch = tid & 31, lrow = tid >> 5;
        const int rq = wave >> 1, r = 4 * q + rq, h = g * HPG + r; const float Dk = dskip[h];
        const bf16* stp = ST + (((size_t)c * NHEAD + h) * 2 * 8) * 512 + lane * 8;
        bf16x8 sb[8][2];
        {
            const int so = tid & 15, oct = tid >> 4;
            u32x4 rr[8], o[8];
            conv8x8(ZX, row0 + so * 8, g * 1024 + q * 256 + oct * 8, cw, cb, rr);
            transpose8x8(rr, o);
#pragma unroll
            for (int cc = 0; cc < 8; ++cc) *(LAS u32x4*)(XT + (oct * 8 + cc) * LROW + so * 16) = o[cc]; }
#ifdef P4_FACT
        { const int rl = tid >> 7, s_ = tid & 127, rr_ = (4 * q + rl) * 128;
          ttab[rl * 128 + s_] = __expf(atab[rr_ + (s_ | 7)] - atab[rr_ + s_]) * dtab[rr_ + s_]; }
#endif
        asm volatile("" ::: "memory");
#pragma unroll
        for (int ks = 0; ks < 8; ++ks) { sb[ks][0] = *(const bf16x8*)(stp + ks * 512); sb[ks][1] = *(const bf16x8*)(stp + (8 + ks) * 512); }
        __syncthreads();
        const int lt0 = (wave & 1) ? 1 : 0, lt1 = (wave & 1) ? 2 : 3;
        const int l0 = lt0 * 32 + l31, l1 = lt1 * 32 + l31;
        const float al0 = atab[r * 128 + l0], al1 = atab[r * 128 + l1]; const float eal0 = __expf(al0), eal1 = __expf(al1);
        f32x16 acc[2][2];
#pragma unroll
        for (int li = 0; li < 2; ++li)
#pragma unroll
            for (int pt = 0; pt < 2; ++pt)
#pragma unroll
                for (int e = 0; e < 16; ++e) acc[li][pt][e] = 0.f;
#pragma unroll
        for (int ks = 0; ks < 8; ++ks) {
            const bf16x8 b0 = sb[ks][0], b1 = sb[ks][1];
            float f[8]; { const u32x2 c0 = *(const LAS u32x2*)(CM + l0 * LROW + ks * 32 + hh * 8), c1 = *(const LAS u32x2*)(CM + l0 * LROW + ks * 32 + 16 + hh * 8); u32x4 cw; cw.x = c0.x; cw.y = c0.y; cw.z = c1.x; cw.w = c1.y; unpack8(cw, f); }
#pragma unroll
            for (int j = 0; j < 8; ++j) f[j] *= eal0;
            const bf16x8 a0 = __builtin_bit_cast(bf16x8, pack8(f));
            { const u32x2 c0 = *(const LAS u32x2*)(CM + l1 * LROW + ks * 32 + hh * 8), c1 = *(const LAS u32x2*)(CM + l1 * LROW + ks * 32 + 16 + hh * 8); u32x4 cw; cw.x = c0.x; cw.y = c0.y; cw.z = c1.x; cw.w = c1.y; unpack8(cw, f); }
#pragma unroll
            for (int j = 0; j < 8; ++j) f[j] *= eal1;
            const bf16x8 a1 = __builtin_bit_cast(bf16x8, pack8(f));
            acc[0][0] = MFMA32(a0, b0, acc[0][0]); acc[0][1] = MFMA32(a0, b1, acc[0][1]); acc[1][0] = MFMA32(a1, b0, acc[1][0]); acc[1][1] = MFMA32(a1, b1, acc[1][1]); }
#ifdef P4_FACT
        for (int ks = 0; ks < 2 * lt1 + 2; ++ks) { const int s0 = ks * 16 + hh * 8;
            const bf16x8 b0 = *(const LAS bf16x8*)(XT + (rq * 64 + l31) * LROW + s0 * 2), b1 = *(const LAS bf16x8*)(XT + (rq * 64 + 32 + l31) * LROW + s0 * 2);
            float f[8];
            if (ks < 2 * lt1) {
                const f32x4 t0 = *(const LAS f32x4*)(ttab + rq * 128 + s0), t1 = *(const LAS f32x4*)(ttab + rq * 128 + s0 + 4); const float aref = atab[r * 128 + s0 + 7];
                const float tt[8] = {t0.x, t0.y, t0.z, t0.w, t1.x, t1.y, t1.z, t1.w};
                const float E1 = __expf(al1 - aref);
                unpack8(*(const LAS u32x4*)(BM + l1 * LROW + s0 * 2), f);
#pragma unroll
                for (int j = 0; j < 8; ++j) f[j] = f[j] * (E1 * tt[j]);
                const bf16x8 a1 = __builtin_bit_cast(bf16x8, pack8(f));
                acc[1][0] = MFMA32(a1, b0, acc[1][0]); acc[1][1] = MFMA32(a1, b1, acc[1][1]);
                if (ks < 2 * lt0) {
                    const float E0 = __expf(al0 - aref);
                    unpack8(*(const LAS u32x4*)(BM + l0 * LROW + s0 * 2), f);
#pragma unroll
                    for (int j = 0; j < 8; ++j) f[j] = f[j] * (E0 * tt[j]);
                    const bf16x8 a0 = __builtin_bit_cast(bf16x8, pack8(f));
                    acc[0][0] = MFMA32(a0, b0, acc[0][0]); acc[0][1] = MFMA32(a0, b1, acc[0][1]); }
                else if (ks < 2 * lt0 + 2) {
                    const f32x4 q0 = *(const LAS f32x4*)(atab + r * 128 + s0), q1 = *(const LAS f32x4*)(atab + r * 128 + s0 + 4), d0 = *(const LAS f32x4*)(dtab + r * 128 + s0), d1 = *(const LAS f32x4*)(dtab + r * 128 + s0 + 4);
                    const float as[8] = {q0.x, q0.y, q0.z, q0.w, q1.x, q1.y, q1.z, q1.w}, ds[8] = {d0.x, d0.y, d0.z, d0.w, d1.x, d1.y, d1.z, d1.w};
                    unpack8(*(const LAS u32x4*)(BM + l0 * LROW + s0 * 2), f);
#pragma unroll
                    for (int j = 0; j < 8; ++j) { f[j] = (s0 + j <= l0) ? f[j] * __expf(al0 - as[j]) * ds[j] : 0.f; if (s0 + j == l0) f[j] += Dk; }
                    const bf16x8 a0 = __builtin_bit_cast(bf16x8, pack8(f));
                    acc[0][0] = MFMA32(a0, b0, acc[0][0]); acc[0][1] = MFMA32(a0, b1, acc[0][1]); } }
            else {
                const f32x4 q0 = *(const LAS f32x4*)(atab + r * 128 + s0), q1 = *(const LAS f32x4*)(atab + r * 128 + s0 + 4), d0 = *(const LAS f32x4*)(dtab + r * 128 + s0), d1 = *(const LAS f32x4*)(dtab + r * 128 + s0 + 4);
                const float as[8] = {q0.x, q0.y, q0.z, q0.w, q1.x, q1.y, q1.z, q1.w}, ds[8] = {d0.x, d0.y, d0.z, d0.w, d1.x, d1.y, d1.z, d1.w};
                unpack8(*(const LAS u32x4*)(BM + l1 * LROW + s0 * 2), f);
#pragma unroll
                for (int j = 0; j < 8; ++j) { f[j] = (s0 + j <= l1) ? f[j] * __expf(al1 - as[j]) * ds[j] : 0.f; if (s0 + j == l1) f[j] += Dk; }
                const bf16x8 a1 = __builtin_bit_cast(bf16x8, pack8(f));
                acc[1][0] = MFMA32(a1, b0, acc[1][0]); acc[1][1] = MFMA32(a1, b1, acc[1][1]); } }
#else
        for (int ks = 0; ks < 2 * lt1 + 2; ++ks) { const int s0 = ks * 16 + hh * 8;
            const bf16x8 b0 = *(const LAS bf16x8*)(XT + (rq * 64 + l31) * LROW + s0 * 2), b1 = *(const LAS bf16x8*)(XT + (rq * 64 + 32 + l31) * LROW + s0 * 2);
            const f32x4 q0 = *(const LAS f32x4*)(atab + r * 128 + s0), q1 = *(const LAS f32x4*)(atab + r * 128 + s0 + 4), d0 = *(const LAS f32x4*)(dtab + r * 128 + s0), d1 = *(const LAS f32x4*)(dtab + r * 128 + s0 + 4);
            const float as[8] = {q0.x, q0.y, q0.z, q0.w, q1.x, q1.y, q1.z, q1.w}, ds[8] = {d0.x, d0.y, d0.z, d0.w, d1.x, d1.y, d1.z, d1.w};
            float f[8]; unpack8(*(const LAS u32x4*)(BM + l1 * LROW + s0 * 2), f);
#pragma unroll
            for (int j = 0; j < 8; ++j) { f[j] = (s0 + j <= l1) ? f[j] * __expf(al1 - as[j]) * ds[j] : 0.f; if (s0 + j == l1) f[j] += Dk; }
            const bf16x8 a1 = __builtin_bit_cast(bf16x8, pack8(f));
            acc[1][0] = MFMA32(a1, b0, acc[1][0]); acc[1][1] = MFMA32(a1, b1, acc[1][1]);
            if (ks < 2 * lt0 + 2) {
                unpack8(*(const LAS u32x4*)(BM + l0 * LROW + s0 * 2), f);
#pragma unroll
                for (int j = 0; j < 8; ++j) { f[j] = (s0 + j <= l0) ? f[j] * __expf(al0 - as[j]) * ds[j] : 0.f; if (s0 + j == l0) f[j] += Dk; }
                const bf16x8 a0 = __builtin_bit_cast(bf16x8, pack8(f));
                acc[0][0] = MFMA32(a0, b0, acc[0][0]); acc[0][1] = MFMA32(a0, b1, acc[0][1]); } }
#endif
        __syncthreads();
#pragma unroll
        for (int li = 0; li < 2; ++li)
#pragma unroll
            for (int pt = 0; pt < 2; ++pt)
#pragma unroll
                for (int e = 0; e < 16; ++e) { const int le = (li ? lt1 : lt0) * 32 + (e & 3) + 8 * (e >> 2) + 4 * hh;
                    *(LAS unsigned short*)(XT + le * YROW + (rq * 64 + pt * 32 + l31) * 2) = f2bf(acc[li][pt][e]); }
        __syncthreads();
#pragma unroll
        for (int i = 0; i < 8; ++i) { const int l = lrow + 16 * i; const size_t colg = (size_t)g * 1024 + q * 256 + ch * 8;
            float ys[8], zs[8]; unpack8(*(const LAS u32x4*)(XT + l * YROW + ch * 16), ys); unpack8(__builtin_nontemporal_load((const u32x4*)(ZX + (row0 + l) * NZX + colg)), zs);
#pragma unroll
            for (int j = 0; j < 8; ++j) ys[j] = ys[j] * silu_f(zs[j]);
            const u32x4 w = pack8(ys); *(u32x4*)(Y + (row0 + l) * DINNER + colg) = w; unpack8(w, ys);
            float s = 0.f;
#pragma unroll
            for (int j = 0; j < 8; ++j) s += ys[j] * ys[j];
            ssq[i] += s; }
        __syncthreads();
    }
    asm volatile("s_waitcnt vmcnt(0)" ::: "memory");
    int tid = tid0; asm volatile("" : "+v"(tid));
    const int ch = tid & 31, lrow = tid >> 5;
#pragma unroll
    for (int i = 0; i < 8; ++i) { float s = ssq[i]; s += __shfl_xor(s, 1); s += __shfl_xor(s, 2); s += __shfl_xor(s, 4); s += __shfl_xor(s, 8); s += __shfl_xor(s, 16); ssq[i] = 1.0f / sqrtf(s * (1.0f / 1024.0f) + SSM_EPS); }
#pragma unroll
    for (int qp = 0; qp < 2; ++qp) { u32x4 raw[2][8];
#pragma unroll
        for (int q2 = 0; q2 < 2; ++q2)
#pragma unroll
            for (int i = 0; i < 8; ++i) raw[q2][i] = *(const u32x4*)(Y + (row0 + lrow + 16 * i) * DINNER + (size_t)g * 1024 + (2 * qp + q2) * 256 + ch * 8);
#pragma unroll
        for (int q2 = 0; q2 < 2; ++q2)
#pragma unroll
            for (int i = 0; i < 8; ++i) { float v[8]; unpack8(raw[q2][i], v);
#pragma unroll
                for (int j = 0; j < 8; ++j) v[j] *= ssq[i];
                *(u32x4*)(Y + (row0 + lrow + 16 * i) * DINNER + (size_t)g * 1024 + (2 * qp + q2) * 256 + ch * 8) = pack8(v); } }
}

DEV int t5_bucket(int rel) { if (rel < 16) return rel; const int v = 16 + (int)(logf((float)rel * (1.0f / 16.0f)) / logf(8.0f) * 16.0f); return v < 31 ? v : 31; }

constexpr int KROW = 144;
constexpr int VROW = 528;
DEV void attn_unit(const Ctx& C, int qb, int g, const bf16* __restrict__ Q, const bf16* __restrict__ KV, bf16* __restrict__ O, const float* __restrict__ sinks, const float* __restrict__ relb) {
    LAS unsigned char* KT = C.lds; LAS unsigned char* VT = C.lds + 36864; LAS float* btab = (LAS float*)(C.lds + 70656);
    const int tid = C.tid, lane = C.lane, wave = C.wave, hh = lane >> 5, l31 = lane & 31;
#pragma unroll
    for (int i = 0; i < 4; ++i) { const int task = tid + 512 * i, ch = task & 7, kr = task >> 3; const int row = (qb - 1) * 128 + kr;
        u32x4 kv = {0u, 0u, 0u, 0u}, vv = {0u, 0u, 0u, 0u};
        if (row >= 0) { const bf16* src = KV + (size_t)row * 1024 + g * 64 + ch * 8; kv = *(const u32x4*)src; vv = *(const u32x4*)(src + 512); }
        *(LAS u32x4*)(KT + kr * KROW + ch * 16) = kv;
        LAS unsigned short* vd = (LAS unsigned short*)(VT + (ch * 8) * VROW + kr * 2);
        vd[0 * (VROW / 2)] = (unsigned short)(vv.x & 0xffffu); vd[1 * (VROW / 2)] = (unsigned short)(vv.x >> 16); vd[2 * (VROW / 2)] = (unsigned short)(vv.y & 0xffffu); vd[3 * (VROW / 2)] = (unsigned short)(vv.y >> 16);
        vd[4 * (VROW / 2)] = (unsigned short)(vv.z & 0xffffu); vd[5 * (VROW / 2)] = (unsigned short)(vv.z >> 16); vd[6 * (VROW / 2)] = (unsigned short)(vv.w & 0xffffu); vd[7 * (VROW / 2)] = (unsigned short)(vv.w >> 16); }
    for (int idx = tid; idx < 1024; idx += 512) { const int w = idx >> 7, rel = idx & 127; btab[idx] = relb[t5_bucket(rel) * 64 + g * 8 + w]; }
    __syncthreads();
    const int hq = g * 8 + wave; const float sink = sinks[hq];
    for (int qt = 0; qt < 4; ++qt) {
        const size_t qrow = (size_t)qb * 128 + qt * 32 + l31;
        bf16x8 qf[4];
#pragma unroll
        for (int ks = 0; ks < 4; ++ks) qf[ks] = *(const bf16x8*)(Q + qrow * DM + hq * 64 + ks * 16 + hh * 8);
        f32x16 sc[5];
#pragma unroll
        for (int i = 0; i < 5; ++i) {
#pragma unroll
            for (int e = 0; e < 16; ++e) sc[i][e] = 0.f;
#pragma unroll
            for (int ks = 0; ks < 4; ++ks) { const bf16x8 a = *(const LAS bf16x8*)(KT + ((qt + i) * 32 + l31) * KROW + ks * 32 + hh * 16); sc[i] = MFMA32(a, qf[ks], sc[i]); } }
        float mx = -3.0e38f;
#pragma unroll
        for (int i = 0; i < 5; ++i)
#pragma unroll
            for (int e = 0; e < 16; ++e) { const int kl = (e & 3) + 8 * (e >> 2) + 4 * hh;
                const int rel = l31 - kl + 128 - 32 * i; const int key = (qt + i) * 32 + kl;
                const bool valid = (rel >= 0) && (rel < 128) && (qb > 0 || key >= 128);
                const float s = sc[i][e] + btab[wave * 128 + (rel & 127)];
                sc[i][e] = valid ? s : -3.0e38f; mx = fmaxf(mx, sc[i][e]); }
        mx = fmaxf(mx, __shfl_xor(mx, 32)); mx = fmaxf(mx, sink);
        float lsum = 0.f;
#pragma unroll
        for (int i = 0; i < 5; ++i)
#pragma unroll
            for (int e = 0; e < 16; ++e) { const float p = (sc[i][e] > -1.0e38f) ? __expf(sc[i][e] - mx) : 0.f; sc[i][e] = p; lsum += p; }
        lsum += __shfl_xor(lsum, 32);
        const float inv = 1.0f / (lsum + __expf(sink - mx));
        f32x16 oa[2];
#pragma unroll
        for (int dt = 0; dt < 2; ++dt)
#pragma unroll
            for (int e = 0; e < 16; ++e) oa[dt][e] = 0.f;
#pragma unroll
        for (int i = 0; i < 5; ++i)
#pragma unroll
            for (int s2 = 0; s2 < 2; ++s2) {
                asm volatile("" ::: "memory");
                u32x4 pw; pw.x = pk2(sc[i][8 * s2 + 0], sc[i][8 * s2 + 1]); pw.y = pk2(sc[i][8 * s2 + 2], sc[i][8 * s2 + 3]); pw.z = pk2(sc[i][8 * s2 + 4], sc[i][8 * s2 + 5]); pw.w = pk2(sc[i][8 * s2 + 6], sc[i][8 * s2 + 7]);
                const bf16x8 pb = __builtin_bit_cast(bf16x8, pw);
#pragma unroll
                for (int dt = 0; dt < 2; ++dt) { const LAS unsigned char* vp = VT + (dt * 32 + l31) * VROW + ((qt + i) * 32 + 16 * s2 + 4 * hh) * 2;
                    const u32x2 v0 = *(const LAS u32x2*)vp, v1 = *(const LAS u32x2*)(vp + 16);
                    u32x4 aw; aw.x = v0.x; aw.y = v0.y; aw.z = v1.x; aw.w = v1.y;
                    oa[dt] = MFMA32(__builtin_bit_cast(bf16x8, aw), pb, oa[dt]); } }
        bf16* op = O + qrow * DM + hq * 64 + 4 * hh;
#pragma unroll
        for (int dt = 0; dt < 2; ++dt)
#pragma unroll
            for (int g4 = 0; g4 < 4; ++g4) { u32x2 w; w.x = pk2(oa[dt][4 * g4] * inv, oa[dt][4 * g4 + 1] * inv); w.y = pk2(oa[dt][4 * g4 + 2] * inv, oa[dt][4 * g4 + 3] * inv);
                *(u32x2*)(op + dt * 32 + 8 * g4) = w; }
    }
    __syncthreads();
}

#ifndef REP_PRO
#define REP_PRO 1
#endif
#ifndef REP_GEMM_IN
#define REP_GEMM_IN 1
#endif
#ifndef REP_GEMM_OUT
#define REP_GEMM_OUT 1
#endif
#ifndef REP_GEMM_UP
#define REP_GEMM_UP 1
#endif
#ifndef REP_GEMM_DN
#define REP_GEMM_DN 1
#endif
#ifndef REP_GEMM_KVQ
#define REP_GEMM_KVQ 1
#endif
#ifndef REP_GEMM_O
#define REP_GEMM_O 1
#endif
#ifndef REP_PREP
#define REP_PREP 1
#endif
#ifndef REP_P2
#define REP_P2 1
#endif
#ifndef REP_P3
#define REP_P3 1
#endif
#ifndef REP_P4
#define REP_P4 1
#endif
#ifndef REP_THIN
#define REP_THIN 1
#endif
#ifndef REP_CONV
#define REP_CONV 1
#endif
#ifndef REP_ATT
#define REP_ATT 1
#endif
struct Args { const float* in[26]; float* out; unsigned char* ws; };
enum { I_X = 0, I_NMPRE, I_NMPOST, I_NFPRE, I_NFPOST, I_WIN, I_SCW, I_SCB, I_DTB, I_ALOG, I_D, I_SNORM, I_WOUT, I_KVN, I_WKV, I_BKV, I_WQ, I_BQ, I_SINK, I_WO, I_BO, I_RELB, I_WUP, I_FCW, I_FCB, I_WDN };

#ifndef GEMM_ALIGN
#define GEMM_ALIGN true
#endif
#ifndef GEMM_SP2
#define GEMM_SP2 true
#endif
#ifdef NOIDLE
#define IDLE_SLOT(n_units, W_, K_, N_, gain_, WT_, lo_, hi_) do { } while (0)
#else
#define IDLE_SLOT_REAL 1
#endif
#ifdef IDLE_SLOT_REAL
#define IDLE_SLOT(n_units, W_, K_, N_, gain_, WT_, lo_, hi_) do { const int ex_ = (n_units) % C.G; \
    const int iw_ = ex_ > 0 ? ((int)blockIdx.x - ex_) * NWAVES + C.wave : (int)blockIdx.x * NWAVES + C.wave, in_ = ex_ > 0 ? (C.G - ex_) * NWAVES : C.G * NWAVES;     \
    if (iw_ >= 0) tr_matrix(C, (W_), (K_), (N_), (gain_), (WT_), 0, iw_, in_, (lo_), (hi_)); } while (0)
#endif
#define RUN_GEMM_I8(EpiT, Aptr, Btptr, N_, K8_, Eobj) do { pg8::Gemm g_{(const pg8::bf16_t*)(Aptr), (const pg8::bf16_t*)(Btptr), SEQ, (N_), (K8_) / 2}; pg8::StaticOrder S_; S_.init(SEQ, (N_), C.G, (int)blockIdx.x); \
    pg8::gemm_phase<EpiT, pg8::StaticOrder, GEMM_ALIGN, GEMM_SP2, true>(C.lds, g_, S_, Eobj); } while (0)
#define RUN_GEMM(EpiT, Aptr, Btptr, N_, K_, Eobj) do { pg8::Gemm g_{(const pg8::bf16_t*)(Aptr), (const pg8::bf16_t*)(Btptr), SEQ, (N_), (K_)}; pg8::StaticOrder S_; S_.init(SEQ, (N_), C.G, (int)blockIdx.x); \
    pg8::gemm_phase<EpiT, pg8::StaticOrder, GEMM_ALIGN, GEMM_SP2>(C.lds, g_, S_, Eobj); } while (0)

__global__ void __launch_bounds__(NWAVES * 64, 2) mk_fwd(Args args) {
    extern __shared__ __attribute__((aligned(16))) unsigned char lds_raw[];
    Ctx C; C.lds = (LAS unsigned char*)lds_raw; C.tid = threadIdx.x; C.lane = C.tid & 63; C.wave = __builtin_amdgcn_readfirstlane(C.tid >> 6);
    C.G = gridDim.x; { const int bx = blockIdx.x; C.vcu = (C.G % 8 == 0) ? (bx % 8) * (C.G / 8) + bx / 8 : bx; }
    volatile LAS unsigned* MISC = (volatile LAS unsigned*)(C.lds + MISC_OFF);
    if (C.tid < 64) MISC[C.tid] = 0u;
    __syncthreads();
    unsigned char* ws = args.ws;
    gu32* ctl = (gu32*)(ws + WS_CTL);
    XcdBarrier bar = xcd_barrier_post((unsigned*)(ctl + CW_BAR), MISC + 8);
#define GRID_BAR() xcd_barrier(bar)
    const float* x = args.in[I_X]; float* out = args.out;
    bf16* Win_bc = (bf16*)(ws + WS_WIN + 64 * MiB);     bf16* Wout_t = (bf16*)(ws + WS_WOUT); bf16* Wkvq_t = (bf16*)(ws + WS_WKVQ); bf16* Wo_t = (bf16*)(ws + WS_WO);
    bf16* Abuf = (bf16*)(ws + WS_A); bf16* MIX = (bf16*)(ws + WS_MIX);
    float* DTRAW = (float*)(ws + WS_DTRAW); float* DT = (float*)(ws + WS_DT); float* ACUM = (float*)(ws + WS_ACUM);
    bf16* ZX = (bf16*)(ws + WS_ZX); bf16* Y = (bf16*)(ws + WS_Y);
    bf16* Sbuf = (bf16*)(ws + WS_S); bf16* STb = (bf16*)(ws + WS_ST);
    bf16* ACT = (bf16*)(ws + WS_ACT); float* HALO = (float*)(ws + WS_HALO); float* RS = (float*)(ws + WS_RS); float* RSQ = (float*)(ws + WS_RSQ); float* CMAX = (float*)(ws + WS_CMAX); signed char* A8 = (signed char*)(ws + WS_A8);
    bf16* Qb = (bf16*)(ws + WS_Q); bf16* KVb = (bf16*)(ws + WS_KV); bf16* Ob = (bf16*)(ws + WS_O);

#define PHASE(rep, ...) do { __VA_ARGS__; GRID_BAR(); if constexpr ((rep) > 1) { __VA_ARGS__; GRID_BAR(); } } while (0)
    PHASE(REP_PRO,
#if defined(ZHI8) && defined(TRWIDE)
        tr_wide<true>(C, args.in[I_WIN], DM, QCOL0, args.in[I_NMPRE], Win_bc, 0, NIN);
        tr_wide<true>(C, args.in[I_WIN] + 2 * DINNER, DM, NIN - 2 * DINNER, args.in[I_NMPRE], Win_bc, QCOL0, NIN);
#elif defined(ZHI8) && defined(BCI8)
        tr_matrix(C, args.in[I_WIN], DM, QCOL0, args.in[I_NMPRE], Win_bc, 0, -1, 0, 0, 20, NIN);
        tr_matrix(C, args.in[I_WIN] + NZX, DM, NIN - NZX, args.in[I_NMPRE], Win_bc, QCOL0, -1, 0, 0, 20, NIN);
#elif defined(ZHI8)
        tr_matrix(C, args.in[I_WIN], DM, QCOL0, args.in[I_NMPRE], Win_bc, 0, -1, 0, 0, 20, NIN);
        tr_matrix(C, args.in[I_WIN] + 2 * DINNER, DM, NIN - 2 * DINNER, args.in[I_NMPRE], Win_bc, QCOL0, -1, 0, 0, 20, NIN);
#elif defined(XBCI8)
        tr_matrix(C, args.in[I_WIN], DM, DINNER, args.in[I_NMPRE], Win_bc, 0, -1, 0, 0, 20, NIN);
        tr_matrix(C, args.in[I_WIN] + NZX, DM, NIN - NZX, args.in[I_NMPRE], Win_bc, DINNER, -1, 0, 0, 20, NIN);
#elif defined(ZXI8)
        tr_matrix(C, args.in[I_WIN] + 2 * DINNER, DM, NIN - 2 * DINNER, args.in[I_NMPRE], Win_bc, 0, -1, 0, 0, 20, NIN);
#else
        tr_matrix(C, args.in[I_WIN], DM, DINNER, args.in[I_NMPRE], Win_bc, 0, -1, 0, 0, 20, NIN);
        tr_matrix(C, args.in[I_WIN] + 2 * DINNER, DM, NIN - 2 * DINNER, args.in[I_NMPRE], Win_bc, DINNER, -1, 0, 0, 20, NIN);
#endif
#ifdef TRWIDE
        tr_wide<true>(C, args.in[I_WOUT], DINNER, DM, args.in[I_SNORM], Wout_t, 0, DM);
#else
        tr_matrix(C, args.in[I_WOUT], DINNER, DM, args.in[I_SNORM], Wout_t, 0);
#endif
#ifndef TRWIDE
#ifdef NOIDLE
        tr_matrix(C, args.in[I_WDN], DFF, DM, nullptr, (bf16*)(ws + WS_WDN0), 0);
        tr_matrix(C, args.in[I_WDN] + (size_t)DFF * DM, DFF, DM, nullptr, (bf16*)(ws + WS_WDN1), 0);
        tr_matrix(C, args.in[I_WO], DM, DM, nullptr, Wo_t, 0);
#else
        tr_matrix(C, args.in[I_WDN], DFF, DM, nullptr, (bf16*)(ws + WS_WDN0), 0, -1, 0, 0, 9);
#endif
#endif
#ifdef TRWIDE
        tr_wide<true>(C, args.in[I_WKV], DM, 1024, args.in[I_KVN], Wkvq_t, 0, 1024);
        tr_wide<true>(C, args.in[I_WQ], DM, DM, args.in[I_NMPRE] + DM, Wkvq_t, 1024, DM);
        tr_matrix(C, args.in[I_WDN], DFF, DM, nullptr, (bf16*)(ws + WS_WDN0), 0, -1, 0, 0, 9);
#else
        tr_matrix(C, args.in[I_WKV], DM, 1024, args.in[I_KVN], Wkvq_t, 0);
#ifndef QI8
        tr_matrix(C, args.in[I_WQ], DM, DM, args.in[I_NMPRE] + DM, Wkvq_t, 1024);
#endif
#endif
        xnorm_phase(C, x, Abuf, (signed char*)MIX, RSQ);
        __syncthreads();
#ifdef QWIDE
        w_quant_wide<QWIDE>(C, args.in[I_WIN] + QCOL0, args.in[I_NMPRE], args.in[I_WUP], args.in[I_NFPRE], CMAX, (signed char*)(ws + WS_WIN), (signed char*)(ws + WS_WUP0), (signed char*)(ws + WS_WUP1), (unsigned*)(ctl + CW_QCNT)));
#elif defined(QPIPE)
        w_quant_pipe(C, args.in[I_WIN] + QCOL0, args.in[I_NMPRE], args.in[I_WUP], args.in[I_NFPRE], CMAX, (signed char*)(ws + WS_WIN), (signed char*)(ws + WS_WUP0), (signed char*)(ws + WS_WUP1), (unsigned*)(ctl + CW_QCNT)));
#else
#ifdef QI8
        { constexpr int T_IN = NZI8 / 16, T_UP = NUP / 16, T_Q = DM / 16;
          for (int t = C.vcu; t < T_IN + 2 * T_UP + T_Q; t += C.G) {
              if (t < T_IN) w_quant_half<false, NIN>(C, args.in[I_WIN] + QCOL0, args.in[I_NMPRE], CMAX + 2 * NUP, (signed char*)(ws + WS_WIN), (unsigned*)(ctl + CW_QCNT) + (t >> 1), t);
              else if (t < T_IN + 2 * T_UP) { const int u = t - T_IN, L = u >= T_UP ? 1 : 0;
                  w_quant_half<true, NUP>(C, args.in[I_WUP] + (size_t)L * DM * NUP, args.in[I_NFPRE] + L * DM, CMAX + L * NUP, (signed char*)(ws + (L ? WS_WUP1 : WS_WUP0)), (unsigned*)(ctl + CW_QCNT) + (t >> 1), u - L * T_UP); }
              else w_quant_half<false, DM>(C, args.in[I_WQ], args.in[I_NMPRE] + DM, CMAX + 2 * NUP + 16384, (signed char*)(ws + WS_WKVQ + 8 * MiB), (unsigned*)(ctl + CW_QCNT) + (t >> 1), t - T_IN - 2 * T_UP); } });
#else
        { constexpr int T_IN = NZI8 / 16, T_UP = NUP / 16;
          for (int t = C.vcu; t < T_IN + 2 * T_UP; t += C.G) {
              if (t < T_IN) w_quant_half<false, NIN>(C, args.in[I_WIN] + QCOL0, args.in[I_NMPRE], CMAX + 2 * NUP, (signed char*)(ws + WS_WIN), (unsigned*)(ctl + CW_QCNT) + (t >> 1), t);
              else { const int u = t - T_IN, L = u >= T_UP ? 1 : 0;
                  w_quant_half<true, NUP>(C, args.in[I_WUP] + (size_t)L * DM * NUP, args.in[I_NFPRE] + L * DM, CMAX + L * NUP, (signed char*)(ws + (L ? WS_WUP1 : WS_WUP0)), (unsigned*)(ctl + CW_QCNT) + (t >> 1), u - L * T_UP); } } });
#endif
#endif

#ifdef ZHI8
    PHASE(REP_GEMM_IN, { pg8::EpiOutI8 E{(pg8::bf16_t*)(ZX + QCOL0), NZX, nullptr, 1.0f, RSQ, CMAX + 2 * NUP}; RUN_GEMM_I8(pg8::EpiOutI8, (signed char*)MIX, ws + WS_WIN, NZI8, DM, E); }
#ifdef BCI8
        { pg8::EpiOut E{(pg8::bf16_t*)ZX, NZX, nullptr, 1.0f, nullptr, nullptr}; RUN_GEMM(pg8::EpiOut, Abuf, Win_bc, NBC, DM, E); }
#else
        { pg8::EpiZBC E{{(pg8::bf16_t*)ZX, NZX, nullptr, 1.0f, nullptr, nullptr}}; RUN_GEMM(pg8::EpiZBC, Abuf, Win_bc, NBC, DM, E); }
#endif
#elif defined(XBCI8)
    PHASE(REP_GEMM_IN, { pg8::EpiOutI8 E{(pg8::bf16_t*)(ZX + DINNER), NZX, nullptr, 1.0f, RSQ, CMAX + 2 * NUP}; RUN_GEMM_I8(pg8::EpiOutI8, (signed char*)MIX, ws + WS_WIN, NZI8, DM, E); }
        { pg8::EpiOut E{(pg8::bf16_t*)ZX, NZX, nullptr, 1.0f, nullptr, nullptr}; RUN_GEMM(pg8::EpiOut, Abuf, Win_bc, NBC, DM, E); }
#elif defined(ZXI8)
    PHASE(REP_GEMM_IN, { pg8::EpiOutI8 E{(pg8::bf16_t*)ZX, NZX, nullptr, 1.0f, RSQ, CMAX + 2 * NUP}; RUN_GEMM_I8(pg8::EpiOutI8, (signed char*)MIX, ws + WS_WIN, NZI8, DM, E); }
        { pg8::EpiOut E{(pg8::bf16_t*)(ZX + NZI8), NZX, nullptr, 1.0f, nullptr, nullptr}; RUN_GEMM(pg8::EpiOut, Abuf, Win_bc, NBC, DM, E); }
#else
    PHASE(REP_GEMM_IN, { pg8::EpiOutI8 E{(pg8::bf16_t*)(ZX + DINNER), NZX, nullptr, 1.0f, RSQ, CMAX + 2 * NUP}; RUN_GEMM_I8(pg8::EpiOutI8, (signed char*)MIX, ws + WS_WIN, NZI8, DM, E); }
        { pg8::EpiZBC E{{(pg8::bf16_t*)ZX, NZX, nullptr, 1.0f, nullptr, nullptr}}; RUN_GEMM(pg8::EpiZBC, Abuf, Win_bc, NBC, DM, E); }
#endif
        dt_gemm(C, Abuf, Win_bc + (size_t)NBC * DM, DTRAW));
    PHASE(REP_PREP, ssd_prep(C, DTRAW, args.in[I_DTB], args.in[I_ALOG], DT, ACUM));
    PHASE(REP_P2, for (int u = C.vcu; u < NCHUNK * NGRP; u += C.G) ssd_states_unit(C, u >> 3, u & 7, ZX, args.in[I_SCW], args.in[I_SCB], DT, ACUM, Sbuf));
    PHASE(REP_P3, ssd_scan(C, Sbuf, ACUM, STb));
    PHASE(REP_P4, for (int u = C.vcu; u < NCHUNK * NGRP; u += C.G) ssd_out_unit(C, u >> 3, u & 7, args.in[I_SCW], args.in[I_SCB], ZX, DT, ACUM, STb, args.in[I_D], Y));
    PHASE(REP_GEMM_OUT, { pg8::EpiOut E{(pg8::bf16_t*)MIX, DM, nullptr, 1.0f, nullptr, nullptr}; RUN_GEMM(pg8::EpiOut, Y, Wout_t, DM, DINNER, E); });
    PHASE(REP_THIN, thin_phase<true, false, true>(C, MIX, x, Abuf, args.in[I_NMPOST], RS, A8, RSQ));
    PHASE(REP_GEMM_UP, { pg8::EpiConvGateI8 E{CMAX, (pg8::bf16_t*)ACT, HALO, args.in[I_FCW], args.in[I_FCB], (LAS float*)(C.lds + 131072), DFF, NUP, RSQ}; RUN_GEMM_I8(pg8::EpiConvGateI8, A8, ws + WS_WUP0, NUP, DM, E); }
        IDLE_SLOT((SEQ / 256) * (NUP / 256), args.in[I_WDN], DFF, DM, nullptr, (bf16*)(ws + WS_WDN0), 9, 20));
    PHASE(REP_CONV, ffn_fixup(C, HALO, ACT, args.in[I_FCW], args.in[I_FCB]));
    PHASE(REP_GEMM_DN, { pg8::EpiOut E{(pg8::bf16_t*)MIX, DM, nullptr, 1.0f, nullptr, nullptr}; RUN_GEMM(pg8::EpiOut, ACT, ws + WS_WDN0, DM, DFF, E); });
#ifdef QI8
    PHASE(1, thin_phase<false, false, true>(C, MIX, Abuf, Abuf, args.in[I_NFPOST], RS, (signed char*)(ws + WS_BIG + 160 * MiB), RSQ));
#else
    PHASE(1, thin_phase<false, false>(C, MIX, Abuf, Abuf, args.in[I_NFPOST], RS));
#endif

#ifdef QI8
    PHASE(REP_GEMM_KVQ, { pg8::EpiOutI8 E{(pg8::bf16_t*)Qb, DM, args.in[I_BQ], 0.125f, RSQ, CMAX + 2 * NUP + 16384}; RUN_GEMM_I8(pg8::EpiOutI8, (signed char*)(ws + WS_BIG + 160 * MiB), ws + WS_WKVQ + 8 * MiB, DM, DM, E); }
        { pg8::EpiOut E{(pg8::bf16_t*)KVb, 1024, args.in[I_BKV], 1.0f, RS, nullptr}; RUN_GEMM(pg8::EpiOut, Abuf, Wkvq_t, 1024, DM, E); }
        IDLE_SLOT((SEQ / 256) * (1024 / 256), args.in[I_WO], DM, DM, nullptr, Wo_t, 0, 20);
        IDLE_SLOT((SEQ / 256) * (1024 / 256), args.in[I_WDN] + (size_t)DFF * DM, DFF, DM, nullptr, (bf16*)(ws + WS_WDN1), 0, 12));
#else
    PHASE(REP_GEMM_KVQ, { pg8::EpiKVQ E{(pg8::bf16_t*)KVb, (pg8::bf16_t*)Qb, args.in[I_BKV], args.in[I_BQ], 0.125f, RS}; RUN_GEMM(pg8::EpiKVQ, Abuf, Wkvq_t, NKVQ, DM, E); }
        IDLE_SLOT((SEQ / 256) * (NKVQ / 256), args.in[I_WO], DM, DM, nullptr, Wo_t, 0, 20);
        IDLE_SLOT((SEQ / 256) * (NKVQ / 256), args.in[I_WDN] + (size_t)DFF * DM, DFF, DM, nullptr, (bf16*)(ws + WS_WDN1), 0, 12));
#endif
#ifdef PROBE_KVQ_GEMMONLY
    PHASE(1, { pg8::EpiKVQ E{(pg8::bf16_t*)KVb, (pg8::bf16_t*)Qb, args.in[I_BKV], args.in[I_BQ], 0.125f, RS}; RUN_GEMM(pg8::EpiKVQ, Abuf, Wkvq_t, NKVQ, DM, E); });
#endif
    PHASE(REP_ATT, for (int u = C.vcu; u < (SEQ / 128) * 8; u += C.G) attn_unit(C, u >> 3, u & 7, Qb, KVb, Ob, args.in[I_SINK], args.in[I_RELB]));
    PHASE(REP_GEMM_O, { pg8::EpiOut E{(pg8::bf16_t*)MIX, DM, args.in[I_BO], 1.0f, nullptr, nullptr}; RUN_GEMM(pg8::EpiOut, Ob, Wo_t, DM, DM, E); });
    PHASE(1, thin_phase<false, false, true>(C, MIX, Abuf, Abuf, args.in[I_NMPOST] + DM, RS, A8, RSQ));
    PHASE(1, { pg8::EpiConvGateI8 E{CMAX + NUP, (pg8::bf16_t*)ACT, HALO, args.in[I_FCW] + 3 * NUP, args.in[I_FCB] + NUP, (LAS float*)(C.lds + 131072), DFF, NUP, RSQ}; RUN_GEMM_I8(pg8::EpiConvGateI8, A8, ws + WS_WUP1, NUP, DM, E); }
        IDLE_SLOT((SEQ / 256) * (NUP / 256), args.in[I_WDN] + (size_t)DFF * DM, DFF, DM, nullptr, (bf16*)(ws + WS_WDN1), 12, 20));
    PHASE(1, ffn_fixup(C, HALO, ACT, args.in[I_FCW] + 3 * NUP, args.in[I_FCB] + NUP));
    PHASE(1, { pg8::EpiOut E{(pg8::bf16_t*)MIX, DM, nullptr, 1.0f, nullptr, nullptr}; RUN_GEMM(pg8::EpiOut, ACT, ws + WS_WDN1, DM, DFF, E); });
    thin_phase<false, true>(C, MIX, Abuf, out, args.in[I_NFPOST] + DM, RS);
}

extern "C" void kernel_launch(void* const* d_in, const int* in_sizes, int n_in, void* d_out, int out_size, void* d_ws, size_t ws_size, hipStream_t stream) {
    static int grid = 0;
    if (grid == 0) {
        if (n_in != 26 || in_sizes[0] != SEQ * DM || out_size != SEQ * DM || ws_size < WS_END) { fprintf(stderr, "kernel_launch: unexpected shapes: n_in %d in0 %d out %d ws %zu (need %zu)\n", n_in, n_in > 0 ? in_sizes[0] : -1, out_size, ws_size, (size_t)WS_END); grid = -1; return; }
        int dev = 0, cus = 0, per_cu = 0;
        if (hipGetDevice(&dev) != hipSuccess || hipDeviceGetAttribute(&cus, hipDeviceAttributeMultiprocessorCount, dev) != hipSuccess) { fprintf(stderr, "kernel_launch: device query failed\n"); grid = -1; return; }
        if (hipFuncSetAttribute((const void*)mk_fwd, hipFuncAttributeMaxDynamicSharedMemorySize, LDS_BYTES) != hipSuccess) { fprintf(stderr, "kernel_launch: hipFuncSetAttribute failed\n"); grid = -1; return; }
        if (hipOccupancyMaxActiveBlocksPerMultiprocessor(&per_cu, (const void*)mk_fwd, NWAVES * 64, LDS_BYTES) != hipSuccess || per_cu < 1) fprintf(stderr, "kernel_launch: occupancy query reports %d\n", per_cu);
        (void)hipGetLastError();
        grid = cus;
    }
    if (grid < 0) return;
    if (hipMemsetAsync((char*)d_ws + WS_CTL, 0, CTL_ZERO_BYTES, stream) != hipSuccess) { fprintf(stderr, "kernel_launch: memset failed\n"); return; }
    Args a{};
    for (int i = 0; i < 26; ++i) a.in[i] = (const float*)d_in[i];
    a.out = (float*)d_out; a.ws = (unsigned char*)d_ws;
    hipLaunchKernelGGL(mk_fwd, dim3(grid), dim3(NWAVES * 64), LDS_BYTES, stream, a);
    const hipError_t le = hipPeekAtLastError();
    if (le != hipSuccess) fprintf(stderr, "kernel_launch: launch failed: %s\n", hipGetErrorName(le));
}
```

```cpp
#define ZHI8 1
#define BCI8 1
#define ZHI8_Q0 4096
#define QI8 1
#include <hip/hip_runtime.h>
#include <cstdio>
#include <cstdint>
#ifndef PG8_WGM
#define PG8_WGM 8
#endif
namespace pg8 {
#define PG8_LAS __attribute__((address_space(3)))
typedef unsigned short bf16_t;
typedef short bf16x8 __attribute__((ext_vector_type(8)));
typedef float f32x4 __attribute__((ext_vector_type(4)));
typedef unsigned u32x4 __attribute__((ext_vector_type(4)));
constexpr int BM = 256, BK = 64, HALF = 128, HTB = HALF * BK * 2  , STAGE_BYTES = 8 * HTB, NXCD = 8, WGM = PG8_WGM;

__host__ __device__ __forceinline__ int lds_byte(int r, int c) { const int st = (r >> 4) * 2 + (c >> 5), rr = r & 15, cc = c & 31, ob = rr * 64 + cc * 2; return st * 1024 + (ob ^ (((ob >> 9) & 1) << 5)); }
__host__ __device__ __forceinline__ void stage_rc(int b, int& R, int& C) { const int st = b / 1024, sb = b % 1024, swz = sb ^ (((sb >> 9) & 1) << 5); R = (st >> 1) * 16 + swz / 64; C = (st & 1) * 32 + (swz % 64) / 2; }
__host__ __device__ __forceinline__ int perm32(int rho) { const int n = rho >> 4, i = rho & 15; return 8 * (i >> 2) + 4 * n + (i & 3); }

struct Unit { int pm, pn; };
struct Gemm { const bf16_t* A; const bf16_t* Bt; int M, N, K; };

struct StaticOrder {
    int nM, nN, nwg, G, c;
    __host__ __device__ void init(int M, int N, int G_, int c_) { nM = M / BM; nN = N / BM; nwg = nM * nN; G = G_; c = c_; }
    __host__ __device__ bool next(int i, Unit& u) const {
        const long L = (long)i * G + c; if (L >= nwg) return false;
        int wgid = (int)L; { const int q = nwg / NXCD, r = nwg % NXCD, xcd = wgid % NXCD, off = wgid / NXCD; wgid = (xcd < r ? xcd * (q + 1) : r * (q + 1) + (xcd - r) * q) + off; }
        const int nig = WGM * nN, gid = wgid / nig, fm = gid * WGM, gsz = (nM - fm) < WGM ? (nM - fm) : WGM;
        u.pm = fm + ((wgid % nig) % gsz); u.pn = (wgid % nig) / gsz; return true;
    }
    __device__ __forceinline__ void a_ready(const Unit&) const {}
    __device__ __forceinline__ void done(const Unit&) const {}
};

typedef __bf16 bf16v2_t __attribute__((ext_vector_type(2)));
typedef float f32x2_t __attribute__((ext_vector_type(2)));
typedef unsigned u32x2 __attribute__((ext_vector_type(2)));
__device__ __forceinline__ unsigned cvt_pk_bf16(float lo, float hi) { bf16v2_t v = __builtin_convertvector((f32x2_t){lo, hi}, bf16v2_t); return __builtin_bit_cast(unsigned, v); }

template <bool I8> struct EpiOutT {
    static constexpr bool PERM = true, AFTER_DRAIN = false;
    bf16_t* O; int ldc; const float* bias; float scale; const float* rowscale; const float* colmax;
    __device__ __forceinline__ void operator()(const f32x4 (&acc)[2][2][4][2], const Unit& u, int wr, int wc, int fr, int fq) const {
        const int row0 = u.pm * BM + wr * 64 + fr; const int col0 = u.pn * BM + wc * 32 + 8 * fq;
        float rs[2][4];
#pragma unroll
        for (int ai = 0; ai < 2; ++ai)
#pragma unroll
            for (int m = 0; m < 4; ++m) rs[ai][m] = rowscale ? rowscale[row0 + ai * HALF + m * 16] : 1.0f;
        f32x4 bv[2][2];
#pragma unroll
        for (int bj = 0; bj < 2; ++bj)
#pragma unroll
            for (int n = 0; n < 2; ++n) bv[bj][n] = bias ? *(const f32x4*)(bias + col0 + bj * HALF + 4 * n) : (f32x4){0.f, 0.f, 0.f, 0.f};
#pragma unroll
        for (int ai = 0; ai < 2; ++ai)
#pragma unroll
            for (int m = 0; m < 4; ++m) { bf16_t* rowp = O + (size_t)(row0 + ai * HALF + m * 16) * ldc + col0;
#pragma unroll
                for (int bj = 0; bj < 2; ++bj) { f32x4 a0 = acc[ai][bj][m][0], a1 = acc[ai][bj][m][1];
                    if constexpr (I8) { typedef int v4i_t __attribute__((ext_vector_type(4)));
                        a0 = __builtin_convertvector(__builtin_bit_cast(v4i_t, a0), f32x4) * (*(const f32x4*)(colmax + col0 + bj * HALF) * (1.0f / 127.0f));
                        a1 = __builtin_convertvector(__builtin_bit_cast(v4i_t, a1), f32x4) * (*(const f32x4*)(colmax + col0 + bj * HALF + 4) * (1.0f / 127.0f)); }
                    f32x4 v0 = (a0 * rs[ai][m] + bv[bj][0]) * scale, v1 = (a1 * rs[ai][m] + bv[bj][1]) * scale;
                    u32x4 w; w.x = cvt_pk_bf16(v0[0], v0[1]); w.y = cvt_pk_bf16(v0[2], v0[3]); w.z = cvt_pk_bf16(v1[0], v1[1]); w.w = cvt_pk_bf16(v1[2], v1[3]);
                    *(u32x4*)(rowp + bj * HALF) = w; } }
    }
};
typedef EpiOutT<false> EpiOut; typedef EpiOutT<true> EpiOutI8;
#ifndef PG8_ZB_TILES
#define PG8_ZB_TILES 32
#define PG8_ZB_SHIFT 32
#endif
struct EpiZBC {
    static constexpr bool PERM = true, AFTER_DRAIN = false;
    EpiOut e;
    __device__ __forceinline__ void operator()(const f32x4 (&acc)[2][2][4][2], const Unit& u, int wr, int wc, int fr, int fq) const { Unit v = u; if (u.pn >= PG8_ZB_TILES) v.pn = u.pn + PG8_ZB_SHIFT; e(acc, v, wr, wc, fr, fq); }
};
struct EpiKVQ {
    static constexpr bool PERM = true, AFTER_DRAIN = false;
    bf16_t* KV; bf16_t* Q; const float* bkv; const float* bq; float qscale; const float* rowscale;
    __device__ __forceinline__ void operator()(const f32x4 (&acc)[2][2][4][2], const Unit& u, int wr, int wc, int fr, int fq) const {
        const bool isq = u.pn >= 4;
        EpiOut e; Unit v = u; e.rowscale = rowscale; e.colmax = nullptr;
        if (isq) { e.O = Q; e.ldc = 4096; e.bias = bq; e.scale = qscale; v.pn = u.pn - 4; }
        else     { e.O = KV; e.ldc = 1024; e.bias = bkv; e.scale = 1.0f; }
        e(acc, v, wr, wc, fr, fq);
    }
};
__device__ __forceinline__ float dpp_ror1(float v) { return __builtin_bit_cast(float, __builtin_amdgcn_update_dpp(0, __builtin_bit_cast(int, v), 0x121, 0xf, 0xf, false)); }
__device__ __forceinline__ float dpp_ror2(float v) { return __builtin_bit_cast(float, __builtin_amdgcn_update_dpp(0, __builtin_bit_cast(int, v), 0x122, 0xf, 0xf, false)); }
template <bool I8> struct EpiConvGateT {
    static constexpr bool PERM = true, AFTER_DRAIN = false; const float* colmax;
    bf16_t* ACT; float* HALO; const float* cw; const float* cb; PG8_LAS float* xch; int dff, nup; const float* rowscale;
    __device__ __forceinline__ void operator()(const f32x4 (&acc_in)[2][2][4][2], const Unit& u, int wr, int wc, int fr, int fq) const {
        const int cbase = u.pn * 128 + wc * 32 + 8 * fq;
        f32x4 (&acc)[2][2][4][2] = const_cast<f32x4 (&)[2][2][4][2]>(acc_in);
#pragma unroll
        for (int ai = 0; ai < 2; ++ai)
#pragma unroll
            for (int m = 0; m < 4; ++m) { const float rsv = rowscale[u.pm * BM + ai * HALF + wr * 64 + m * 16 + fr];
#pragma unroll
                for (int bj = 0; bj < 2; ++bj)
#pragma unroll
                    for (int n = 0; n < 2; ++n) {
                        if constexpr (I8) { typedef int v4i_t __attribute__((ext_vector_type(4))); const f32x4 cs = *(const f32x4*)(colmax + bj * dff + cbase + 4 * n) * (1.0f / 127.0f);
                            acc[ai][bj][m][n] = __builtin_convertvector(__builtin_bit_cast(v4i_t, acc[ai][bj][m][n]), f32x4) * cs * rsv; }
                        else acc[ai][bj][m][n] = acc[ai][bj][m][n] * rsv; } }
        if (fr >= 14) {
#pragma unroll
            for (int ai = 0; ai < 2; ++ai)
#pragma unroll
                for (int bj = 0; bj < 2; ++bj)
#pragma unroll
                    for (int n = 0; n < 2; ++n) *(PG8_LAS f32x4*)(xch + (((((ai * 2 + wr) * 4 + wc) * 2 + (fr - 14)) * 2 + bj) * 32 + fq * 8 + n * 4)) = acc[ai][bj][3][n];
        }
        if (wr == 0 && fr < 2) {
#pragma unroll
            for (int bj = 0; bj < 2; ++bj)
#pragma unroll
                for (int n = 0; n < 2; ++n) *(f32x4*)(HALO + (size_t)(u.pm * 4 + fr) * nup + bj * dff + cbase + 4 * n) = acc[0][bj][0][n];
        }
        if (wr == 1 && fr >= 14) {
#pragma unroll
            for (int bj = 0; bj < 2; ++bj)
#pragma unroll
                for (int n = 0; n < 2; ++n) *(f32x4*)(HALO + (size_t)(u.pm * 4 + fr - 12) * nup + bj * dff + cbase + 4 * n) = acc[1][bj][3][n];
        }
        asm volatile("s_waitcnt lgkmcnt(0)" ::: "memory"); __builtin_amdgcn_s_barrier(); asm volatile("" ::: "memory");
        u32x2 ow[2][4];
#pragma unroll
        for (int n = 0; n < 2; ++n) {
            asm volatile("" ::: "memory");
            f32x4 w[2][3], b[2];
#pragma unroll
            for (int bj = 0; bj < 2; ++bj) {
#pragma unroll
                for (int k = 0; k < 3; ++k) w[bj][k] = *(const f32x4*)(cw + (size_t)k * nup + bj * dff + cbase + 4 * n);
                b[bj] = *(const f32x4*)(cb + bj * dff + cbase + 4 * n); }
#pragma unroll
            for (int ai = 0; ai < 2; ++ai) {
                const int pai = (wr == 1) ? ai : 0, pwr = (wr == 1) ? 0 : 1;
                f32x4 x14[2], x15[2];
#pragma unroll
                for (int bj = 0; bj < 2; ++bj) { x14[bj] = *(const PG8_LAS f32x4*)(xch + (((((pai * 2 + pwr) * 4 + wc) * 2 + 0) * 2 + bj) * 32 + fq * 8 + n * 4));
                                                 x15[bj] = *(const PG8_LAS f32x4*)(xch + (((((pai * 2 + pwr) * 4 + wc) * 2 + 1) * 2 + bj) * 32 + fq * 8 + n * 4)); }
#pragma unroll
                for (int m = 0; m < 4; ++m) {
                    f32x4 cv[2];
#pragma unroll
                    for (int bj = 0; bj < 2; ++bj) {
                        const f32x4 cur = acc[ai][bj][m][n]; f32x4 p1, p2;
#pragma unroll
                        for (int j = 0; j < 4; ++j) {
                            const float c1 = dpp_ror1(cur[j]), c2 = dpp_ror2(cur[j]); float q1, q2;
                            if (m == 0) { q1 = x15[bj][j]; q2 = (fr == 1) ? x15[bj][j] : x14[bj][j]; }
                            else { const float pv = acc[ai][bj][m > 0 ? m - 1 : 0][n][j]; q1 = dpp_ror1(pv); q2 = dpp_ror2(pv); }
                            p1[j] = (fr >= 1) ? c1 : q1; p2[j] = (fr >= 2) ? c2 : q2; }
                        cv[bj] = b[bj] + w[bj][0] * p2 + w[bj][1] * p1 + w[bj][2] * cur; }
                    float o[4];
#pragma unroll
                    for (int j = 0; j < 4; ++j) o[j] = cv[0][j] * __builtin_amdgcn_rcpf(1.0f + __expf(-cv[0][j])) * cv[1][j];
                    u32x2 pkd; pkd.x = cvt_pk_bf16(o[0], o[1]); pkd.y = cvt_pk_bf16(o[2], o[3]);
                    if (n == 0) ow[ai][m] = pkd;
                    else { u32x4 wv; wv.x = ow[ai][m].x; wv.y = ow[ai][m].y; wv.z = pkd.x; wv.w = pkd.y;
                        *(u32x4*)(ACT + (size_t)(u.pm * BM + ai * HALF + wr * 64 + m * 16 + fr) * dff + cbase) = wv; } }
            }
        }
    }
};
typedef EpiConvGateT<false> EpiConvGate; typedef EpiConvGateT<true> EpiConvGateI8;

typedef int pg8_v4i __attribute__((ext_vector_type(4)));
template <bool I8> __device__ __forceinline__ f32x4 mma16(const bf16x8 b, const bf16x8 a, const f32x4 c) {
    if constexpr (I8) return __builtin_bit_cast(f32x4, __builtin_amdgcn_mfma_i32_16x16x64_i8(__builtin_bit_cast(pg8_v4i, b), __builtin_bit_cast(pg8_v4i, a), __builtin_bit_cast(pg8_v4i, c), 0, 0, 0));
    else return __builtin_amdgcn_mfma_f32_16x16x32_bf16(b, a, c, 0, 0, 0);
}
template <class Epi, class Sched, bool ALIGN_EPI = false, bool SP2 = false, bool I8 = false>
__device__ __forceinline__ void gemm_phase(PG8_LAS unsigned char* lds, const Gemm g, const Sched& S, const Epi& E) {
    int tid_l = threadIdx.x; asm volatile("" : "+v"(tid_l));
    const int tid = tid_l, wid = __builtin_amdgcn_readfirstlane(tid >> 6), lane = tid & 63, wr = wid >> 2, wc = wid & 3, fr = lane & 15, fq = lane >> 4;
    const int K = g.K, nt = K / BK;
    unsigned voffA[2], voffB[2];
#pragma unroll
    for (int i = 0; i < 2; ++i) { int R, C; stage_rc(tid * 16 + i * 8192, R, C); const int Rb = Epi::PERM ? ((R & ~31) + perm32(R & 31)) : R;
        voffA[i] = (unsigned)(R * K + C) * 2u; voffB[i] = (unsigned)(Rb * K + C) * 2u; }
    const size_t kstep = (size_t)(BK * 2);
    const size_t hstep = (size_t)HALF * K * 2;
    const size_t tstep = 2 * hstep;
    const unsigned ldsw = (unsigned)wid * 1024u;
    const int aoff = lds_byte(wr * 64 + fr, fq * 8), boff = lds_byte(wc * 32 + fr, fq * 8);
#define PG8_SA(b, h) (((b) * 2 + (h)) * HTB)
#define PG8_SB(b, h) ((4 + (b) * 2 + (h)) * HTB)
#define PG8_STAGE(bufoff, gbase, voff) do { _Pragma("unroll") for (int _i = 0; _i < 2; ++_i) \
        __builtin_amdgcn_global_load_lds((const unsigned*)((const char*)(gbase) + (voff)[_i]), (PG8_LAS unsigned*)(lds + (bufoff) + ldsw + _i * 8192), 16, 0, 0); } while (0)
#define PG8_LDA(dst, b, h) do { _Pragma("unroll") for (int m = 0; m < 4; ++m) _Pragma("unroll") for (int k = 0; k < 2; ++k) dst[m][k] = *(const PG8_LAS bf16x8*)(lds + PG8_SA(b, h) + aoff + m * 2048 + k * 1024); } while (0)
#define PG8_LDB(dst, b, h) do { _Pragma("unroll") for (int n = 0; n < 2; ++n) _Pragma("unroll") for (int k = 0; k < 2; ++k) dst[n][k] = *(const PG8_LAS bf16x8*)(lds + PG8_SB(b, h) + boff + n * 2048 + k * 1024); } while (0)
#define PG8_MMA(ai, bj, At, Bt) do { __builtin_amdgcn_s_setprio(1); _Pragma("unroll") for (int m = 0; m < 4; ++m) _Pragma("unroll") for (int n = 0; n < 2; ++n) _Pragma("unroll") for (int k = 0; k < 2; ++k) \
        acc[ai][bj][m][n] = mma16<I8>(Bt[n][k], At[m][k], acc[ai][bj][m][n]); __builtin_amdgcn_s_setprio(0); } while (0)
#define PG8_WAIT_V(n) asm volatile("s_waitcnt vmcnt(" #n ")" ::: "memory")
#define PG8_WAIT_L(n) asm volatile("s_waitcnt lgkmcnt(" #n ")" ::: "memory")
#define PG8_BAR __builtin_amdgcn_s_barrier()
#define PG8_SCHED __builtin_amdgcn_sched_barrier(0)
    Unit cur, nxt; int ui = 0;
    if (!S.next(0, cur)) return;
    f32x4 acc[2][2][4][2];
#pragma unroll
    for (int a = 0; a < 2; ++a)
#pragma unroll
        for (int b = 0; b < 2; ++b)
#pragma unroll
            for (int m = 0; m < 4; ++m)
#pragma unroll
                for (int n = 0; n < 2; ++n) acc[a][b][m][n] = (f32x4){0.f, 0.f, 0.f, 0.f};
    bf16x8 At[4][2], B0[2][2], B1[2][2];
    const char* cA = (const char*)g.A + (size_t)cur.pm * tstep; const char* cB = (const char*)g.Bt + (size_t)cur.pn * tstep;
    S.a_ready(cur);
    if constexpr (SP2) {
        PG8_STAGE(PG8_SB(0, 0), cB, voffB); PG8_STAGE(PG8_SB(0, 1), cB + hstep, voffB); PG8_STAGE(PG8_SA(0, 0), cA, voffA); PG8_STAGE(PG8_SA(0, 1), cA + hstep, voffA);
        if (wr == 1) PG8_BAR;
        PG8_WAIT_V(2); PG8_BAR;
        PG8_STAGE(PG8_SB(1, 0), cB + kstep, voffB); PG8_STAGE(PG8_SA(1, 0), cA + kstep, voffA); PG8_STAGE(PG8_SB(1, 1), cB + hstep + kstep, voffB);
        PG8_WAIT_V(6); PG8_BAR;
    } else {
        PG8_STAGE(PG8_SB(0, 0), cB, voffB); PG8_STAGE(PG8_SA(0, 0), cA, voffA); PG8_STAGE(PG8_SB(0, 1), cB + hstep, voffB); PG8_STAGE(PG8_SA(0, 1), cA + hstep, voffA);
        if (wr == 1) PG8_BAR;
        PG8_WAIT_V(4); PG8_BAR;
        PG8_STAGE(PG8_SB(1, 0), cB + kstep, voffB); PG8_STAGE(PG8_SA(1, 0), cA + kstep, voffA); PG8_STAGE(PG8_SB(1, 1), cB + hstep + kstep, voffB);
        PG8_WAIT_V(6); PG8_BAR;
    }
    for (;;) {
        const bool has_next = S.next(ui + 1, nxt);
        const char* nA = has_next ? (const char*)g.A + (size_t)nxt.pm * tstep : cA; const char* nB = has_next ? (const char*)g.Bt + (size_t)nxt.pn * tstep : cB;
        for (int t = 0; t < nt; t += 2) {
            const bool last = (t == nt - 2);
            const char* a1 = cA + (size_t)(t + 1) * kstep;
            const char* a2 = last ? nA : cA + (size_t)(t + 2) * kstep; const char* b2 = last ? nB : cB + (size_t)(t + 2) * kstep;
            const char* a3 = a2 + kstep; const char* b3 = b2 + kstep;
            if (last && has_next) S.a_ready(nxt);
            if constexpr (SP2) {
            PG8_LDB(B0, 0, 0); PG8_LDB(B1, 0, 1); PG8_SCHED; PG8_LDA(At, 0, 0); PG8_STAGE(PG8_SA(1, 1), a1 + hstep, voffA);
            PG8_WAIT_V(8); PG8_WAIT_L(0); PG8_BAR; PG8_MMA(0, 0, At, B0); PG8_MMA(0, 1, At, B1); PG8_BAR; PG8_SCHED;
            PG8_LDA(At, 0, 1); PG8_STAGE(PG8_SB(0, 0), b2, voffB); PG8_STAGE(PG8_SB(0, 1), b2 + hstep, voffB); PG8_STAGE(PG8_SA(0, 0), a2, voffA);
            PG8_WAIT_V(8); PG8_WAIT_L(0); PG8_BAR; PG8_MMA(1, 0, At, B0); PG8_MMA(1, 1, At, B1); PG8_BAR; PG8_SCHED;
            PG8_LDB(B0, 1, 0); PG8_LDB(B1, 1, 1); PG8_SCHED; PG8_LDA(At, 1, 0); PG8_STAGE(PG8_SA(0, 1), a2 + hstep, voffA);
            PG8_WAIT_V(8); PG8_WAIT_L(0); PG8_BAR; PG8_MMA(0, 0, At, B0); PG8_MMA(0, 1, At, B1); PG8_BAR; PG8_SCHED;
            PG8_LDA(At, 1, 1); PG8_STAGE(PG8_SB(1, 0), b3, voffB); PG8_STAGE(PG8_SB(1, 1), b3 + hstep, voffB); PG8_STAGE(PG8_SA(1, 0), a3, voffA);
            PG8_WAIT_V(8); PG8_WAIT_L(0); PG8_BAR; PG8_MMA(1, 0, At, B0); PG8_MMA(1, 1, At, B1); PG8_BAR; PG8_SCHED;
            } else {
            PG8_LDB(B0, 0, 0); PG8_SCHED; PG8_LDA(At, 0, 0); PG8_STAGE(PG8_SA(1, 1), a1 + hstep, voffA);
            PG8_WAIT_L(8); PG8_BAR; PG8_WAIT_L(0); PG8_MMA(0, 0, At, B0); PG8_BAR; PG8_SCHED;
            PG8_LDB(B1, 0, 1); PG8_STAGE(PG8_SB(0, 0), b2, voffB);
            PG8_BAR; PG8_WAIT_L(0); PG8_MMA(0, 1, At, B1); PG8_BAR;
            PG8_LDA(At, 0, 1); PG8_STAGE(PG8_SA(0, 0), a2, voffA);
            PG8_BAR; PG8_WAIT_L(0); PG8_MMA(1, 0, At, B0); PG8_BAR; PG8_SCHED;
            PG8_STAGE(PG8_SB(0, 1), b2 + hstep, voffB);
            PG8_WAIT_V(6); PG8_BAR; PG8_MMA(1, 1, At, B1); PG8_BAR;
            PG8_LDB(B0, 1, 0); PG8_SCHED; PG8_LDA(At, 1, 0); PG8_STAGE(PG8_SA(0, 1), a2 + hstep, voffA);
            PG8_WAIT_L(8); PG8_BAR; PG8_WAIT_L(0); PG8_MMA(0, 0, At, B0); PG8_BAR; PG8_SCHED;
            PG8_LDB(B1, 1, 1); PG8_STAGE(PG8_SB(1, 0), b3, voffB);
            PG8_BAR; PG8_WAIT_L(0); PG8_MMA(0, 1, At, B1); PG8_BAR;
            PG8_LDA(At, 1, 1); PG8_STAGE(PG8_SA(1, 0), a3, voffA);
            PG8_BAR; PG8_WAIT_L(0); PG8_MMA(1, 0, At, B0); PG8_BAR; PG8_SCHED;
            PG8_STAGE(PG8_SB(1, 1), b3 + hstep, voffB);
            PG8_WAIT_V(6); PG8_BAR; PG8_MMA(1, 1, At, B1); PG8_BAR;
            }
        }
        if constexpr (ALIGN_EPI) { if (wr == 0) PG8_BAR; }
        if constexpr (!Epi::AFTER_DRAIN) { E(acc, cur, wr, wc, fr, fq); S.done(cur); }
        if (!has_next) break;
#pragma unroll
        for (int a = 0; a < 2; ++a)
#pragma unroll
            for (int b = 0; b < 2; ++b)
#pragma unroll
                for (int m = 0; m < 4; ++m)
#pragma unroll
                    for (int n = 0; n < 2; ++n) acc[a][b][m][n] = (f32x4){0.f, 0.f, 0.f, 0.f};
        cur = nxt; cA = nA; cB = nB; ++ui;
        if constexpr (ALIGN_EPI) { if (wr == 1) PG8_BAR; }
    }
    PG8_WAIT_V(0);
    if constexpr (!ALIGN_EPI) { if (wr == 0) PG8_BAR; }
    PG8_BAR;
    if constexpr (Epi::AFTER_DRAIN) { E.fused(acc, cur, wr, wc, fr, fq, lds, wid, lane); S.done(cur); }
#undef PG8_SA
#undef PG8_SB
#undef PG8_STAGE
#undef PG8_LDA
#undef PG8_LDB
#undef PG8_MMA
#undef PG8_WAIT_V
#undef PG8_WAIT_L
#undef PG8_BAR
#undef PG8_SCHED
}
}
#define GAS __attribute__((address_space(1)))
#define LAS __attribute__((address_space(3)))
typedef unsigned short bf16;
typedef unsigned v4u __attribute__((ext_vector_type(4)));
typedef float f32x4 __attribute__((ext_vector_type(4)));
typedef short bf16x8 __attribute__((ext_vector_type(8)));
typedef GAS unsigned gu32;
typedef GAS unsigned long long gu64;
#define RLX_AGENT __ATOMIC_RELAXED, __HIP_MEMORY_SCOPE_AGENT
#define LDS_WAIT() asm volatile("s_waitcnt lgkmcnt(0)" ::: "memory")
#define VM_WAIT() asm volatile("s_waitcnt vmcnt(0)" ::: "memory")
__device__ __forceinline__ unsigned long long rt() { return __builtin_amdgcn_s_memrealtime(); }

#define XB_TMO      128
#define XB_XCNT(j)  (256  + 64 * (j))
#define XB_XSUB(j)  (1280 + 64 * (j))
#define XB_XGEN(j)  (2304 + 64 * (j))
#define XB_TOP      3328
#define XB_TOPGEN   3392
#define XCD_BAR_WORDS 3456
#define XB_SPIN_CAP (1u << 18)

__device__ __forceinline__ unsigned xb_ld(unsigned* p)              { return __hip_atomic_load(p, __ATOMIC_RELAXED, __HIP_MEMORY_SCOPE_AGENT); }
__device__ __forceinline__ unsigned xb_add(unsigned* p, unsigned v) { return __hip_atomic_fetch_add(p, v, __ATOMIC_RELAXED, __HIP_MEMORY_SCOPE_AGENT); }
__device__ __forceinline__ unsigned xb_xcc_id() { return (unsigned)__builtin_amdgcn_s_getreg((3 << 11) | 20) & 0xFu; }
#define XB_SPIN(cond, bar) do { unsigned _sp = 0; while (cond) { __builtin_amdgcn_s_sleep(1); \
    if ((++_sp & 255u) == 0u) { if (xb_ld(&(bar)[XB_TMO])) break; if (_sp > XB_SPIN_CAP) { atomicAdd(&(bar)[XB_TMO], 1u); break; } } } } while (0)

struct XcdBarrier {
    unsigned* bar; unsigned x;
    volatile LAS unsigned* st;
};

__device__ __forceinline__ XcdBarrier xcd_barrier_post(unsigned* bar, volatile LAS unsigned* st) {
    XcdBarrier b; b.bar = bar; b.x = xb_xcc_id(); b.st = st;
    if (threadIdx.x == 0) (void)xb_add(&bar[XB_XCNT(b.x)], 1u);
    return b;
}
__device__ __forceinline__ void xcd_barrier_complete(unsigned* bar, unsigned x, unsigned& nloc, unsigned& nx) {
    const unsigned G = gridDim.x * gridDim.y * gridDim.z;
    unsigned sum, cnt, mine, sp = 0u;
    for (;;) {
        sum = 0u; cnt = 0u; mine = 0u;
#pragma unroll
        for (unsigned j = 0; j < 16; ++j) { const unsigned c = xb_ld(&bar[XB_XCNT(j)]); sum += c; cnt += (c > 0u) ? 1u : 0u; mine = (j == x) ? c : mine; }
        if (sum == G) break;
        __builtin_amdgcn_s_sleep(1);
        if ((++sp & 255u) == 0u) { if (xb_ld(&bar[XB_TMO])) break; if (sp > XB_SPIN_CAP) { atomicAdd(&bar[XB_TMO], 1u); break; } }
    }
    nloc = mine > 0u ? mine : 1u; nx = cnt > 0u ? cnt : 1u;
}

__device__ __forceinline__ void xcd_barrier(const XcdBarrier& b) {
    asm volatile("s_waitcnt vmcnt(0)" ::: "memory");
    __syncthreads();
    if (threadIdx.x == 0) {
        unsigned* bar = b.bar;
        __builtin_amdgcn_s_waitcnt(0);
        unsigned nloc = b.st[0], nx = b.st[1];
        if (nloc == 0u) { xcd_barrier_complete(bar, b.x, nloc, nx); b.st[0] = nloc; b.st[1] = nx; }
        const unsigned old = xb_add(&bar[XB_XSUB(b.x)], 1u);
        const unsigned gen = old / nloc;
        if (old + 1u == (gen + 1u) * nloc) {
            __builtin_amdgcn_fence(__ATOMIC_RELEASE, "agent");
            asm volatile("s_waitcnt vmcnt(0)" ::: "memory");
            const unsigned og = xb_add(&bar[XB_TOP], 1u);
            const unsigned tg = og / nx;
            if (og + 1u == (tg + 1u) * nx) xb_add(&bar[XB_TOPGEN], 1u);
            else XB_SPIN(xb_ld(&bar[XB_TOPGEN]) == tg, bar);
            __builtin_amdgcn_fence(__ATOMIC_ACQUIRE, "agent");
            xb_add(&bar[XB_XGEN(b.x)], 1u);
            asm volatile("s_waitcnt vmcnt(0)" ::: "memory");
        } else {
            XB_SPIN(xb_ld(&bar[XB_XGEN(b.x)]) == gen, bar);
            __builtin_amdgcn_fence(__ATOMIC_ACQUIRE, "agent");
            asm volatile("s_waitcnt vmcnt(0)" ::: "memory");
        }
    }
    __syncthreads();
}


constexpr int SEQ = 8192, DM = 4096, DINNER = 8192, NHEAD = 128, HDIM = 64, NGRP = 8, HPG = 16, DSTATE = 128;
constexpr int CONVD = 10240, NZX = 18432, NIN = 18560, DFF = 11008, NUP = 22016, NKVQ = 5120;
constexpr int CHUNK = 128, NCHUNK = 64;
#ifdef ZHI8
#ifndef ZHI8_Q0
#define ZHI8_Q0 4096
#endif
#ifdef BCI8
constexpr int NZI8 = NZX - ZHI8_Q0, NBC = NZX - NZI8;
#else
constexpr int NZI8 = 16384 - ZHI8_Q0, NBC = NZX - NZI8;
#endif
#elif defined(XBCI8)
constexpr int NZI8 = 10240, NBC = NZX - NZI8;
#elif defined(ZXI8)
constexpr int NZI8 = 16384, NBC = NZX - NZI8;
#else
constexpr int NZI8 = 8192, NBC = NZX - NZI8;
#endif
#ifdef ZHI8
constexpr int QCOL0 = ZHI8_Q0;
#elif defined(ZXI8)
constexpr int QCOL0 = 0;
#else
constexpr int QCOL0 = DINNER;
#endif
constexpr float EPS = 1e-6f, SSM_EPS = 1e-5f;
constexpr int NWAVES = 8;

constexpr size_t MiB = 1u << 20;
constexpr size_t WS_CTL = 0, CTL_ZERO_BYTES = 1 * MiB;
constexpr size_t WS_WIN = 1 * MiB;
constexpr size_t WS_WOUT = 146 * MiB;
constexpr size_t WS_WUP0 = 210 * MiB;
constexpr size_t WS_WUP1 = 382 * MiB;
constexpr size_t WS_WDN0 = 554 * MiB;
constexpr size_t WS_WDN1 = 640 * MiB;
constexpr size_t WS_WKVQ = 726 * MiB;
constexpr size_t WS_WO = 766 * MiB;
constexpr size_t WS_A = 798 * MiB;
constexpr size_t WS_MIX = 862 * MiB;
constexpr size_t WS_DTRAW = 926 * MiB;
constexpr size_t WS_DT = 930 * MiB;
constexpr size_t WS_ACUM = 934 * MiB;
constexpr size_t WS_HALO = WS_DTRAW;
constexpr size_t WS_RS = 937 * MiB;
constexpr size_t WS_RSQ = 937 * MiB + 65536;
constexpr size_t WS_CMAX = 512 * 1024;
constexpr size_t WS_BIG = 938 * MiB;
constexpr size_t WS_A8 = WS_BIG;
constexpr size_t WS_ZX = WS_BIG;
constexpr size_t WS_S = WS_BIG + 448 * MiB;
constexpr size_t WS_ST = WS_BIG + 704 * MiB;
constexpr size_t WS_Y = WS_BIG + 832 * MiB;
constexpr size_t WS_ACT = WS_BIG + 344 * MiB;
constexpr size_t WS_Q = WS_BIG;
constexpr size_t WS_KV = WS_BIG + 64 * MiB;
constexpr size_t WS_O = WS_BIG + 80 * MiB;
constexpr size_t WS_END = WS_BIG + 960 * MiB;
constexpr int CW_BAR = 4096;

constexpr int LDS_BYTES = 163840;
constexpr int MISC_OFF = LDS_BYTES - 256;

typedef float f32x4 __attribute__((ext_vector_type(4)));
typedef float f32x16 __attribute__((ext_vector_type(16)));
typedef short bf16x8 __attribute__((ext_vector_type(8)));
typedef short bf16x4 __attribute__((ext_vector_type(4)));
typedef unsigned u32x4 __attribute__((ext_vector_type(4)));
typedef unsigned u32x2 __attribute__((ext_vector_type(2)));
#define DEV __device__ __forceinline__
DEV unsigned pk2(float lo, float hi) { return pg8::cvt_pk_bf16(lo, hi); }
DEV float bf_lo(unsigned w) { return __builtin_bit_cast(float, w << 16); }
DEV float bf_hi(unsigned w) { return __builtin_bit_cast(float, w & 0xffff0000u); }
DEV float bf2f(bf16 b) { return __builtin_bit_cast(float, ((unsigned)b) << 16); }
DEV bf16 f2bf(float f) { return (bf16)(pk2(f, 0.f) & 0xffffu); }
DEV float silu_f(float v) { return v * __builtin_amdgcn_rcpf(1.0f + __expf(-v)); }
DEV float wave_sum(float v) {
#pragma unroll
    for (int o = 1; o < 64; o <<= 1) v += __shfl_xor(v, o);
    return v;
}
DEV void unpack8(const u32x4 w, float (&f)[8]) { f[0] = bf_lo(w.x); f[1] = bf_hi(w.x); f[2] = bf_lo(w.y); f[3] = bf_hi(w.y); f[4] = bf_lo(w.z); f[5] = bf_hi(w.z); f[6] = bf_lo(w.w); f[7] = bf_hi(w.w); }
DEV u32x4 pack8(const float (&f)[8]) { u32x4 w; w.x = pk2(f[0], f[1]); w.y = pk2(f[2], f[3]); w.z = pk2(f[4], f[5]); w.w = pk2(f[6], f[7]); return w; }

struct Ctx { LAS unsigned char* lds; int tid, lane, wave, vcu, G; };

struct TrTile { f32x4 v[16]; float g[16]; };
DEV void tr_load(TrTile& t, const float* __restrict__ W, int N, const float* __restrict__ gain, int k0, int n0, int lane) {
    const int kr = lane >> 4, nc = (lane & 15) * 4;
#pragma unroll
    for (int i = 0; i < 16; ++i) { const int kk = 4 * i + kr; t.v[i] = __builtin_nontemporal_load((const f32x4*)(W + (size_t)(k0 + kk) * N + n0 + nc));     t.g[i] = gain ? gain[k0 + kk] : 1.0f; }
}
DEV void tr_store(const TrTile& t, bf16* __restrict__ WT, int K, int row_off, int k0, int n0, LAS float* scr, int lane) {
    const int kr = lane >> 4, nc = (lane & 15) * 4;
#pragma unroll
    for (int i = 0; i < 16; ++i) { const int kk = 4 * i + kr; LAS float* s = scr + kk * 65 + nc; s[0] = t.v[i].x * t.g[i]; s[1] = t.v[i].y * t.g[i]; s[2] = t.v[i].z * t.g[i]; s[3] = t.v[i].w * t.g[i]; }
    asm volatile("s_waitcnt lgkmcnt(0)" ::: "memory");
    const int c = lane & 7;
#pragma unroll
    for (int j = 0; j < 8; ++j) { const int n = 8 * j + (lane >> 3); const LAS float* s = scr + (8 * c) * 65 + n;
        u32x4 o; o.x = pk2(s[0 * 65], s[1 * 65]); o.y = pk2(s[2 * 65], s[3 * 65]); o.z = pk2(s[4 * 65], s[5 * 65]); o.w = pk2(s[6 * 65], s[7 * 65]);
        __builtin_nontemporal_store(o, (u32x4*)(WT + (size_t)(row_off + n0 + n) * K + k0 + 8 * c)); }
    asm volatile("s_waitcnt lgkmcnt(0)" ::: "memory");
}
DEV int tr_row_up(int n0) { const int isv = n0 >= DFF ? 1 : 0, m0 = n0 - isv * DFF; return (m0 >> 7) * 256 + isv * 128 + (m0 & 127); }
template <bool UPMAP = false>
DEV void tr_matrix(const Ctx& C, const float* W, int K, int N, const float* gain, bf16* WT, int row_off, int gw_in = -1, int NGW_in = 0, int part_lo = 0, int part_hi = 20, int ldW = 0) {
    LAS float* scr = (LAS float*)(C.lds + C.wave * 16640);
    const int gw = gw_in < 0 ? C.vcu * NWAVES + C.wave : gw_in, NGW = gw_in < 0 ? C.G * NWAVES : NGW_in;
    const int ld = ldW ? ldW : N; const int nblk = N / 64, items_all = (K / 64) * nblk;
    const int it_lo = (int)((long)items_all * part_lo / 20), items = (int)((long)items_all * part_hi / 20);
    if (it_lo + gw >= items) return;
    TrTile cur, nxt;
    { const int kb = (it_lo + gw) / nblk, nb = (it_lo + gw) - kb * nblk; tr_load(cur, W, ld, gain, kb * 64, nb * 64, C.lane); }
    for (int it = it_lo + gw; it < items; it += NGW) { const int kb = it / nblk, nb = it - kb * nblk; const int n0 = nb * 64; int ro = row_off;
        if (UPMAP) { const int isv = n0 >= DFF ? 1 : 0, m0 = n0 - isv * DFF; ro = (m0 >> 7) * 256 + isv * 128 + (m0 & 127) - n0; }
        const int it2 = it + NGW; const bool more = it2 < items;
        if (more) { const int kb2 = it2 / nblk, nb2 = it2 - kb2 * nblk; tr_load(nxt, W, ld, gain, kb2 * 64, nb2 * 64, C.lane); }
        tr_store(cur, WT, K, ro, kb * 64, n0, scr, C.lane);
        if (more) cur = nxt; }
}
template <bool HAS_GAIN>
DEV void tr_wide(const Ctx& C, const float* __restrict__ W, int K, int N, const float* __restrict__ gain, bf16* __restrict__ WT, int row_off, int ld) {
    constexpr int TN = 128, TK = 256, TPB = TK * 2 + 16;
    LAS unsigned char* T = C.lds;
    const int tid = C.tid, quad = tid & 31, rsub = tid >> 5;
    const int nblk = N / TN, items = (K / TK) * nblk;
    int it = C.vcu; if (it >= items) return;
    f32x4 cur[16], nxt[16];
    { const int kb = it / nblk, nb = it - kb * nblk; const float* src = W + (size_t)(kb * TK) * ld + nb * TN + quad * 4;
#pragma unroll
      for (int i = 0; i < 16; ++i) cur[i] = __builtin_nontemporal_load((const f32x4*)(src + (size_t)(4 * (rsub + 16 * (i >> 2)) + (i & 3)) * ld)); }
    for (;;) {
        const int kb = it / nblk, nb = it - kb * nblk, k0 = kb * TK, n0 = nb * TN;
        const int it2 = it + C.G; const bool more = it2 < items;
        if (more) { const int kb2 = it2 / nblk, nb2 = it2 - kb2 * nblk; const float* src = W + (size_t)(kb2 * TK) * ld + nb2 * TN + quad * 4;
#pragma unroll
            for (int i = 0; i < 16; ++i) nxt[i] = __builtin_nontemporal_load((const f32x4*)(src + (size_t)(4 * (rsub + 16 * (i >> 2)) + (i & 3)) * ld)); }
#pragma unroll
        for (int j = 0; j < 4; ++j) { const int rbl = rsub + 16 * j; f32x4 g4 = {1.f, 1.f, 1.f, 1.f}; if constexpr (HAS_GAIN) g4 = *(const f32x4*)(gain + k0 + 4 * rbl);
            LAS unsigned char* tp = T + (quad * 4) * TPB + 16 * ((rbl >> 1) ^ (quad & 7)) + 8 * (rbl & 1);
#pragma unroll
            for (int c = 0; c < 4; ++c) { u32x2 w; w.x = pk2(cur[4 * j + 0][c] * g4.x, cur[4 * j + 1][c] * g4.y); w.y = pk2(cur[4 * j + 2][c] * g4.z, cur[4 * j + 3][c] * g4.w);
                *(LAS u32x2*)(tp + c * TPB) = w; } }
        __syncthreads();
#pragma unroll 4
        for (int j = 0; j < 8; ++j) { const int id = tid + 512 * j, n = id >> 5, ch = id & 31;
            __builtin_nontemporal_store(*(const LAS u32x4*)(T + n * TPB + 16 * (ch ^ ((n >> 2) & 7))), (u32x4*)(WT + (size_t)(row_off + n0 + n) * K + k0 + ch * 8)); }
        __syncthreads();
        if (!more) break;
#pragma unroll
        for (int i = 0; i < 16; ++i) cur[i] = nxt[i];
        it = it2;
    }
}
DEV void w_colmax(const Ctx& C, const float* __restrict__ W, int K, int N, const float* __restrict__ gain, float* __restrict__ cmax, int ld) {
    const int gw = C.vcu * NWAVES + C.wave, NGW = C.G * NWAVES; const int ncb = N / 256, items = (K / 64) * ncb;
    for (int it = gw; it < items; it += NGW) { const int kb = it / ncb, nb = it - kb * ncb; const float* src = W + (size_t)(kb * 64) * ld + nb * 256 + C.lane * 4;
        f32x4 mx = {0.f, 0.f, 0.f, 0.f};
#pragma unroll 1
        for (int k0 = 0; k0 < 64; k0 += 16) { f32x4 v[16];
#pragma unroll
            for (int i = 0; i < 16; ++i) v[i] = __builtin_nontemporal_load((const f32x4*)(src + (size_t)(k0 + i) * ld));
#pragma unroll
            for (int i = 0; i < 16; ++i) { const float gk = gain[kb * 64 + k0 + i]; mx.x = fmaxf(mx.x, fabsf(v[i].x * gk)); mx.y = fmaxf(mx.y, fabsf(v[i].y * gk)); mx.z = fmaxf(mx.z, fabsf(v[i].z * gk)); mx.w = fmaxf(mx.w, fabsf(v[i].w * gk)); } }
        unsigned* dst = (unsigned*)(cmax + nb * 256 + C.lane * 4);
        atomicMax(dst + 0, __float_as_uint(mx.x)); atomicMax(dst + 1, __float_as_uint(mx.y)); atomicMax(dst + 2, __float_as_uint(mx.z)); atomicMax(dst + 3, __float_as_uint(mx.w)); }
}
template <bool UPMAP>
DEV void w_quant(const Ctx& C, const float* __restrict__ W, int K, int N, const float* __restrict__ gain, const float* __restrict__ cmax, signed char* __restrict__ WQ, int ld) {
    LAS float* scr = (LAS float*)(C.lds + C.wave * 16640);
    const int gw = C.vcu * NWAVES + C.wave, NGW = C.G * NWAVES; const int nblk = N / 64, items = (K / 64) * nblk, lane = C.lane;
    for (int it = gw; it < items; it += NGW) { const int kb = it / nblk, nb = it - kb * nblk, k0 = kb * 64, n0 = nb * 64;
        const int kr = lane >> 4, nc = (lane & 15) * 4; f32x4 v[16]; float gk[16];
#pragma unroll
        for (int i = 0; i < 16; ++i) v[i] = __builtin_nontemporal_load((const f32x4*)(W + (size_t)(k0 + 4 * i + kr) * ld + n0 + nc));
#pragma unroll
        for (int i = 0; i < 16; ++i) gk[i] = gain[k0 + 4 * i + kr];
        const f32x4 cm = *(const f32x4*)(cmax + n0 + nc); const f32x4 sc = {cm.x > 0.f ? 127.0f / cm.x : 0.f, cm.y > 0.f ? 127.0f / cm.y : 0.f, cm.z > 0.f ? 127.0f / cm.z : 0.f, cm.w > 0.f ? 127.0f / cm.w : 0.f};
#pragma unroll
        for (int i = 0; i < 16; ++i) { LAS float* sp = scr + (4 * i + kr) * 65 + nc; sp[0] = v[i].x * gk[i] * sc.x; sp[1] = v[i].y * gk[i] * sc.y; sp[2] = v[i].z * gk[i] * sc.z; sp[3] = v[i].w * gk[i] * sc.w; }
        asm volatile("s_waitcnt lgkmcnt(0)" ::: "memory");
        const int c = lane & 3, drow0 = UPMAP ? tr_row_up(n0) : n0;
#pragma unroll
        for (int j = 0; j < 4; ++j) { const int n = 16 * j + (lane >> 2); const LAS float* sp = scr + (16 * c) * 65 + n; u32x4 o;
#pragma unroll
            for (int d = 0; d < 4; ++d) { unsigned w = 0u;
#pragma unroll
                for (int b = 0; b < 4; ++b) w |= ((unsigned)(int)__builtin_rintf(sp[(4 * d + b) * 65]) & 255u) << (8 * b);
                o[d] = w; }
            __builtin_nontemporal_store(o, (u32x4*)(WQ + (size_t)(drow0 + n) * K + k0 + 16 * c)); }
        asm volatile("s_waitcnt lgkmcnt(0)" ::: "memory"); }
}
template <bool UPMAP>
DEV void w_quant_stripe(const Ctx& C, const float* __restrict__ W, int N, const float* __restrict__ gain, float* __restrict__ cmax, signed char* __restrict__ WQ, int ld) {
    constexpr int K = 4096, TP = 4112;
    LAS unsigned char* T = C.lds; LAS float* red = (LAS float*)(C.lds + 32 * TP); LAS float* cm = red + 64 * 32;
    const int tid = C.tid, quad = tid & 7, rsub = tid >> 3;
    for (int st = C.vcu; st < N / 32; st += C.G) { const int n0 = st * 32; const float* src = W + n0 + quad * 4;
        f32x4 mx = {0.f, 0.f, 0.f, 0.f};
#pragma unroll 1
        for (int b = 0; b < 2; ++b) { f32x4 v[32];
#pragma unroll
            for (int i = 0; i < 32; ++i) v[i] = *(const f32x4*)(src + (size_t)(rsub + 64 * (32 * b + i)) * ld);
#pragma unroll
            for (int i = 0; i < 32; ++i) { const float gk = gain[rsub + 64 * (32 * b + i)]; mx.x = fmaxf(mx.x, fabsf(v[i].x * gk)); mx.y = fmaxf(mx.y, fabsf(v[i].y * gk)); mx.z = fmaxf(mx.z, fabsf(v[i].z * gk)); mx.w = fmaxf(mx.w, fabsf(v[i].w * gk)); } }
        *(LAS f32x4*)(red + rsub * 32 + quad * 4) = mx;
        __syncthreads();
        if (tid < 32) { float m = 0.f;
#pragma unroll 8
            for (int r = 0; r < 64; ++r) m = fmaxf(m, red[r * 32 + tid]);
            cm[tid] = m; cmax[n0 + tid] = m; }
        __syncthreads();
        const f32x4 cq = *(const LAS f32x4*)(cm + quad * 4);
        const f32x4 sc = {cq.x > 0.f ? 127.0f / cq.x : 0.f, cq.y > 0.f ? 127.0f / cq.y : 0.f, cq.z > 0.f ? 127.0f / cq.z : 0.f, cq.w > 0.f ? 127.0f / cq.w : 0.f};
#pragma unroll 1
        for (int b = 0; b < 2; ++b) { f32x4 v[32];
#pragma unroll
            for (int i = 0; i < 32; ++i) v[i] = *(const f32x4*)(src + (size_t)(4 * (rsub + 64 * (8 * b + (i >> 2))) + (i & 3)) * ld);
#pragma unroll
            for (int j = 0; j < 8; ++j) { const int rb = rsub + 64 * (8 * b + j); unsigned w0 = 0u, w1 = 0u, w2 = 0u, w3 = 0u;
#pragma unroll
                for (int r = 0; r < 4; ++r) { const float gk = gain[4 * rb + r]; const f32x4 x = v[4 * j + r];
                    w0 |= ((unsigned)(int)__builtin_rintf(x.x * gk * sc.x) & 255u) << (8 * r); w1 |= ((unsigned)(int)__builtin_rintf(x.y * gk * sc.y) & 255u) << (8 * r);
                    w2 |= ((unsigned)(int)__builtin_rintf(x.z * gk * sc.z) & 255u) << (8 * r); w3 |= ((unsigned)(int)__builtin_rintf(x.w * gk * sc.w) & 255u) << (8 * r); }
                LAS unsigned char* tp = T + (quad * 4) * TP + 4 * rb;
                *(LAS unsigned*)(tp) = w0; *(LAS unsigned*)(tp + TP) = w1; *(LAS unsigned*)(tp + 2 * TP) = w2; *(LAS unsigned*)(tp + 3 * TP) = w3; } }
        __syncthreads();
        const int drow0 = UPMAP ? tr_row_up(n0) : n0;
#pragma unroll 4
        for (int j = 0; j < 16; ++j) { const int id = tid + 512 * j, col = id >> 8, ch = id & 255;
            __builtin_nontemporal_store(*(const LAS u32x4*)(T + col * TP + ch * 16), (u32x4*)(WQ + (size_t)(drow0 + col) * K + ch * 16)); }
        __syncthreads();
    }
}
constexpr int CW_QCNT = 65536;
template <bool UPMAP, int LD>
DEV void w_quant_half(const Ctx& C, const float* __restrict__ W, const float* __restrict__ gain, float* __restrict__ cmax, signed char* __restrict__ WQ, unsigned* cnt, int tt) {
    constexpr int K = 4096, KH = 2048, TP = 2064;
    LAS unsigned char* T = C.lds; LAS float* red = (LAS float*)(C.lds + 32 * TP); LAS float* cm = red + 64 * 32;
    const int tid = C.tid, quad = tid & 7, rsub = tid >> 3;
    const int st = tt >> 1, half = tt & 1, n0 = st * 32; const float* src = W + n0 + quad * 4;
    f32x4 v[32];
#pragma unroll
    for (int i = 0; i < 32; ++i) v[i] = __builtin_nontemporal_load((const f32x4*)(src + (size_t)(4 * (rsub + 64 * (8 * half + (i >> 2))) + (i & 3)) * LD));
    f32x4 mx = {0.f, 0.f, 0.f, 0.f};
#pragma unroll
    for (int j = 0; j < 8; ++j) { const f32x4 g4 = *(const f32x4*)(gain + 4 * (rsub + 64 * (8 * half + j)));
#pragma unroll
        for (int r = 0; r < 4; ++r) { f32x4 x = v[4 * j + r] * g4[r]; v[4 * j + r] = x;
            mx.x = fmaxf(mx.x, fabsf(x.x)); mx.y = fmaxf(mx.y, fabsf(x.y)); mx.z = fmaxf(mx.z, fabsf(x.z)); mx.w = fmaxf(mx.w, fabsf(x.w)); } }
    *(LAS f32x4*)(red + rsub * 32 + quad * 4) = mx;
    __syncthreads();
    if (tid < 64) {
        if (tid < 32) { float m = 0.f;
#pragma unroll 8
            for (int r = 0; r < 64; ++r) m = fmaxf(m, red[r * 32 + tid]);
            const unsigned old = __hip_atomic_fetch_max((unsigned*)cmax + n0 + tid, __builtin_bit_cast(unsigned, m), __ATOMIC_RELAXED, __HIP_MEMORY_SCOPE_AGENT);
            asm volatile("" :: "v"(old)); }
        asm volatile("s_waitcnt vmcnt(0)" ::: "memory");
        if (tid == 0) { (void)xb_add(cnt, 1u); unsigned sp = 0u;
            while (xb_ld(cnt) < 2u) { __builtin_amdgcn_s_sleep(1); if (++sp > (1u << 20)) break; } }
        asm volatile("" ::: "memory");
        if (tid < 32) cm[tid] = __builtin_bit_cast(float, xb_ld((unsigned*)cmax + n0 + tid));
    }
    __syncthreads();
    const f32x4 cq = *(const LAS f32x4*)(cm + quad * 4);
    const f32x4 sc = {cq.x > 0.f ? 127.0f / cq.x : 0.f, cq.y > 0.f ? 127.0f / cq.y : 0.f, cq.z > 0.f ? 127.0f / cq.z : 0.f, cq.w > 0.f ? 127.0f / cq.w : 0.f};
#pragma unroll
    for (int j = 0; j < 8; ++j) { const int rbl = rsub + 64 * j; unsigned w0 = 0u, w1 = 0u, w2 = 0u, w3 = 0u;
#pragma unroll
        for (int r = 0; r < 4; ++r) { const f32x4 x = v[4 * j + r];
            w0 |= ((unsigned)(int)__builtin_rintf(x.x * sc.x) & 255u) << (8 * r); w1 |= ((unsigned)(int)__builtin_rintf(x.y * sc.y) & 255u) << (8 * r);
            w2 |= ((unsigned)(int)__builtin_rintf(x.z * sc.z) & 255u) << (8 * r); w3 |= ((unsigned)(int)__builtin_rintf(x.w * sc.w) & 255u) << (8 * r); }
        LAS unsigned char* tp = T + (quad * 4) * TP + 4 * rbl;
        *(LAS unsigned*)(tp) = w0; *(LAS unsigned*)(tp + TP) = w1; *(LAS unsigned*)(tp + 2 * TP) = w2; *(LAS unsigned*)(tp + 3 * TP) = w3; }
    __syncthreads();
    const int drow0 = UPMAP ? tr_row_up(n0) : n0;
#pragma unroll 4
    for (int j = 0; j < 8; ++j) { const int id = tid + 512 * j, col = id >> 7, ch = id & 127;
        __builtin_nontemporal_store(*(const LAS u32x4*)(T + col * TP + ch * 16), (u32x4*)(WQ + (size_t)(drow0 + col) * K + half * KH + ch * 16)); }
    __syncthreads();
}
struct QTask { const float* W; const float* gain; float* cmax; signed char* WQ; unsigned* cnt; int ld, up, n0, part; };
DEV void q_load(f32x4 (&v)[16], const QTask& k, int quad, int rsub) {
    const float* src = k.W + k.n0 + quad * 4;
#pragma unroll
    for (int i = 0; i < 16; ++i) v[i] = __builtin_nontemporal_load((const f32x4*)(src + (size_t)(4 * (rsub + 64 * (4 * k.part + (i >> 2))) + (i & 3)) * k.ld));
}
DEV void w_quant_pipe(const Ctx& C, const float* Win, const float* gin, const float* Wup, const float* gup, float* CMAX, signed char* Qin, signed char* Qup0, signed char* Qup1, unsigned* cntb) {
    constexpr int K = 4096, KQ = 1024, TP = 1040, T_IN = NZI8 / 8, T_UP = NUP / 8, T_ALL = T_IN + 2 * T_UP;
    LAS unsigned char* T = C.lds; LAS float* red = (LAS float*)(C.lds + 32 * TP); LAS float* cm = red + 64 * 32;
    const int tid = C.tid, quad = tid & 7, rsub = tid >> 3;
    auto decode = [&](int t, QTask& k) {
        k.cnt = cntb + (t >> 2); k.part = t & 3;
        if (t < T_IN) { k.W = Win; k.gain = gin; k.cmax = CMAX + 2 * NUP; k.WQ = Qin; k.ld = NIN; k.up = 0; k.n0 = (t >> 2) * 32; }
        else { const int u = t - T_IN, L = u >= T_UP ? 1 : 0, tt = u - L * T_UP;
            k.W = Wup + (size_t)L * DM * NUP; k.gain = gup + L * DM; k.cmax = CMAX + L * NUP; k.WQ = L ? Qup1 : Qup0; k.ld = NUP; k.up = 1; k.n0 = (tt >> 2) * 32; } };
    int t = C.vcu; if (t >= T_ALL) return;
    QTask k; decode(t, k);
    f32x4 cur[16], nxt[16];
    q_load(cur, k, quad, rsub);
    for (;;) {
        f32x4 mx = {0.f, 0.f, 0.f, 0.f};
#pragma unroll
        for (int j = 0; j < 4; ++j) { const f32x4 g4 = *(const f32x4*)(k.gain + 4 * (rsub + 64 * (4 * k.part + j)));
#pragma unroll
            for (int r = 0; r < 4; ++r) { f32x4 x = cur[4 * j + r] * g4[r]; cur[4 * j + r] = x;
                mx.x = fmaxf(mx.x, fabsf(x.x)); mx.y = fmaxf(mx.y, fabsf(x.y)); mx.z = fmaxf(mx.z, fabsf(x.z)); mx.w = fmaxf(mx.w, fabsf(x.w)); } }
        *(LAS f32x4*)(red + rsub * 32 + quad * 4) = mx;
        __syncthreads();
        if (tid < 64) {
            if (tid < 32) { float m = 0.f;
#pragma unroll 8
                for (int r = 0; r < 64; ++r) m = fmaxf(m, red[r * 32 + tid]);
                const unsigned old = __hip_atomic_fetch_max((unsigned*)k.cmax + k.n0 + tid, __builtin_bit_cast(unsigned, m), __ATOMIC_RELAXED, __HIP_MEMORY_SCOPE_AGENT);
                asm volatile("" :: "v"(old)); }
            asm volatile("s_waitcnt vmcnt(0)" ::: "memory");
            if (tid == 0) (void)xb_add(k.cnt, 1u);
        }
        const int t2 = t + C.G; const bool has2 = t2 < T_ALL; QTask k2;
        if (has2) { decode(t2, k2); q_load(nxt, k2, quad, rsub); }
        if (tid < 64) {
            if (tid == 0) { unsigned sp = 0u; while (xb_ld(k.cnt) < 4u) { __builtin_amdgcn_s_sleep(1); if (++sp > (1u << 20)) break; } }
            asm volatile("" ::: "memory");
            if (tid < 32) cm[tid] = __builtin_bit_cast(float, xb_ld((unsigned*)k.cmax + k.n0 + tid));
        }
        __syncthreads();
        const f32x4 cq = *(const LAS f32x4*)(cm + quad * 4);
        const f32x4 sc = {cq.x > 0.f ? 127.0f / cq.x : 0.f, cq.y > 0.f ? 127.0f / cq.y : 0.f, cq.z > 0.f ? 127.0f / cq.z : 0.f, cq.w > 0.f ? 127.0f / cq.w : 0.f};
#pragma unroll
        for (int j = 0; j < 4; ++j) { const int rbl = rsub + 64 * j; unsigned w0 = 0u, w1 = 0u, w2 = 0u, w3 = 0u;
#pragma unroll
            for (int r = 0; r < 4; ++r) { const f32x4 x = cur[4 * j + r];
                w0 |= ((unsigned)(int)__builtin_rintf(x.x * sc.x) & 255u) << (8 * r); w1 |= ((unsigned)(int)__builtin_rintf(x.y * sc.y) & 255u) << (8 * r);
                w2 |= ((unsigned)(int)__builtin_rintf(x.z * sc.z) & 255u) << (8 * r); w3 |= ((unsigned)(int)__builtin_rintf(x.w * sc.w) & 255u) << (8 * r); }
            LAS unsigned char* tp = T + (quad * 4) * TP + 4 * rbl;
            *(LAS unsigned*)(tp) = w0; *(LAS unsigned*)(tp + TP) = w1; *(LAS unsigned*)(tp + 2 * TP) = w2; *(LAS unsigned*)(tp + 3 * TP) = w3; }
        __syncthreads();
        const int drow0 = k.up ? tr_row_up(k.n0) : k.n0;
#pragma unroll
        for (int j = 0; j < 4; ++j) { const int id = tid + 512 * j, col = id >> 6, ch = id & 63;
            __builtin_nontemporal_store(*(const LAS u32x4*)(T + col * TP + ch * 16), (u32x4*)(k.WQ + (size_t)(drow0 + col) * K + k.part * KQ + ch * 16)); }
        __syncthreads();
        if (!has2) break;
#pragma unroll
        for (int i = 0; i < 16; ++i) cur[i] = nxt[i];
        k = k2; t = t2;
    }
}
template <int SC>
DEV void w_quant_wide(const Ctx& C, const float* Win, const float* gin, const float* Wup, const float* gup, float* CMAX, signed char* Qin, signed char* Qup0, signed char* Qup1, unsigned* cntb) {
    constexpr int K = 4096, QN = SC / 4, RP = 2048 / SC, KB = 65536 / SC, P = SC / 16, TP = KB + 16, NCH = KB / 16;
    constexpr int T_IN = (NZI8 / SC) * P, T_UP = (NUP / SC) * P, T_ALL = T_IN + 2 * T_UP;
    LAS unsigned char* T = C.lds; LAS float* red = (LAS float*)(C.lds + SC * TP); LAS float* cm = red + RP * SC;
    const int tid = C.tid, quad = tid % QN, rsub = tid / QN;
    for (int t = C.vcu; t < T_ALL; t += C.G) {
        const float* W; const float* gain; float* cmax; signed char* WQ; int ld, up, tt;
        if (t < T_IN) { W = Win; gain = gin; cmax = CMAX + 2 * NUP; WQ = Qin; ld = NIN; up = 0; tt = t; }
        else { const int u = t - T_IN, L = u >= T_UP ? 1 : 0; tt = u - L * T_UP; W = Wup + (size_t)L * DM * NUP; gain = gup + L * DM; cmax = CMAX + L * NUP; WQ = L ? Qup1 : Qup0; ld = NUP; up = 1; }
        const int n0 = (tt / P) * SC, part = tt % P; unsigned* cnt = cntb + t / P;
        const float* src = W + (size_t)(part * KB) * ld + n0 + quad * 4;
        f32x4 v[32];
#pragma unroll
        for (int i = 0; i < 32; ++i) v[i] = __builtin_nontemporal_load((const f32x4*)(src + (size_t)(4 * (rsub + RP * (i >> 2)) + (i & 3)) * ld));
        f32x4 mx = {0.f, 0.f, 0.f, 0.f};
#pragma unroll
        for (int j = 0; j < 8; ++j) { const f32x4 g4 = *(const f32x4*)(gain + part * KB + 4 * (rsub + RP * j));
#pragma unroll
            for (int r = 0; r < 4; ++r) { f32x4 x = v[4 * j + r] * g4[r]; v[4 * j + r] = x;
                mx.x = fmaxf(mx.x, fabsf(x.x)); mx.y = fmaxf(mx.y, fabsf(x.y)); mx.z = fmaxf(mx.z, fabsf(x.z)); mx.w = fmaxf(mx.w, fabsf(x.w)); } }
        *(LAS f32x4*)(red + rsub * SC + quad * 4) = mx;
        __syncthreads();
        if (tid < SC) { float m = 0.f;
#pragma unroll
            for (int r = 0; r < RP; ++r) m = fmaxf(m, red[r * SC + tid]);
            const unsigned old = __hip_atomic_fetch_max((unsigned*)cmax + n0 + tid, __builtin_bit_cast(unsigned, m), __ATOMIC_RELAXED, __HIP_MEMORY_SCOPE_AGENT);
            asm volatile("" :: "v"(old));
            asm volatile("s_waitcnt vmcnt(0)" ::: "memory"); }
        __syncthreads();
        if (tid == 0) { (void)xb_add(cnt, 1u); unsigned sp = 0u; while (xb_ld(cnt) < (unsigned)P) { __builtin_amdgcn_s_sleep(1); if (++sp > (1u << 20)) break; } }
        __syncthreads();
        if (tid < SC) cm[tid] = __builtin_bit_cast(float, xb_ld((unsigned*)cmax + n0 + tid));
        __syncthreads();
        const f32x4 cq = *(const LAS f32x4*)(cm + quad * 4);
        const f32x4 sc = {cq.x > 0.f ? 127.0f / cq.x : 0.f, cq.y > 0.f ? 127.0f / cq.y : 0.f, cq.z > 0.f ? 127.0f / cq.z : 0.f, cq.w > 0.f ? 127.0f / cq.w : 0.f};
#pragma unroll
        for (int j = 0; j < 8; ++j) { const int rbl = rsub + RP * j; unsigned w0 = 0u, w1 = 0u, w2 = 0u, w3 = 0u;
#pragma unroll
            for (int r = 0; r < 4; ++r) { const f32x4 x = v[4 * j + r];
                w0 |= ((unsigned)(int)__builtin_rintf(x.x * sc.x) & 255u) << (8 * r); w1 |= ((unsigned)(int)__builtin_rintf(x.y * sc.y) & 255u) << (8 * r);
                w2 |= ((unsigned)(int)__builtin_rintf(x.z * sc.z) & 255u) << (8 * r); w3 |= ((unsigned)(int)__builtin_rintf(x.w * sc.w) & 255u) << (8 * r); }
            LAS unsigned char* tp = T + (quad * 4) * TP + 16 * ((rbl >> 2) ^ (quad & 7)) + 4 * (rbl & 3);
            *(LAS unsigned*)(tp) = w0; *(LAS unsigned*)(tp + TP) = w1; *(LAS unsigned*)(tp + 2 * TP) = w2; *(LAS unsigned*)(tp + 3 * TP) = w3; }
        __syncthreads();
#pragma unroll 4
        for (int j = 0; j < 8; ++j) { const int id = tid + 512 * j, col = id / NCH, ch = id % NCH; const int nc = n0 + col, drow = up ? tr_row_up(nc) : nc;
            __builtin_nontemporal_store(*(const LAS u32x4*)(T + col * TP + 16 * (ch ^ ((col >> 2) & 7))), (u32x4*)(WQ + (size_t)drow * K + part * KB + ch * 16)); }
        __syncthreads();
    }
}
DEV void ffn_fixup(const Ctx& C, const float* __restrict__ HALO, bf16* __restrict__ ACT, const float* __restrict__ cw, const float* __restrict__ cb) {
    const int gtid = C.vcu * (NWAVES * 64) + C.tid, nthr = C.G * NWAVES * 64;
    constexpr int NCC = DFF / 4, NT = (SEQ / 256) * NCC;
    for (int it = gtid; it < NT; it += nthr) { const int pm = it / NCC, c0 = (it - pm * NCC) * 4;
        f32x4 r[2][4];
#pragma unroll
        for (int bj = 0; bj < 2; ++bj) {
            r[bj][0] = pm ? *(const f32x4*)(HALO + (size_t)((pm - 1) * 4 + 2) * NUP + bj * DFF + c0) : (f32x4){0.f, 0.f, 0.f, 0.f};
            r[bj][1] = pm ? *(const f32x4*)(HALO + (size_t)((pm - 1) * 4 + 3) * NUP + bj * DFF + c0) : (f32x4){0.f, 0.f, 0.f, 0.f};
            r[bj][2] = *(const f32x4*)(HALO + (size_t)(pm * 4 + 0) * NUP + bj * DFF + c0);
            r[bj][3] = *(const f32x4*)(HALO + (size_t)(pm * 4 + 1) * NUP + bj * DFF + c0); }
        f32x4 w[2][3], b[2];
#pragma unroll
        for (int bj = 0; bj < 2; ++bj) {
#pragma unroll
            for (int k = 0; k < 3; ++k) w[bj][k] = *(const f32x4*)(cw + (size_t)k * NUP + bj * DFF + c0);
            b[bj] = *(const f32x4*)(cb + bj * DFF + c0); }
#pragma unroll
        for (int rr = 0; rr < 2; ++rr) {
            const f32x4 G = b[0] + w[0][0] * r[0][rr] + w[0][1] * r[0][rr + 1] + w[0][2] * r[0][rr + 2];
            const f32x4 V = b[1] + w[1][0] * r[1][rr] + w[1][1] * r[1][rr + 1] + w[1][2] * r[1][rr + 2];
            u32x2 o; o.x = pk2(silu_f(G.x) * V.x, silu_f(G.y) * V.y); o.y = pk2(silu_f(G.z) * V.z, silu_f(G.w) * V.w);
            *(u32x2*)(ACT + (size_t)(pm * 256 + rr) * DFF + c0) = o; }
    }
}

DEV float wave_max(float v) {
#pragma unroll
    for (int o = 1; o < 64; o <<= 1) v = fmaxf(v, __shfl_xor(v, o));
    return v;
}
template <bool HOLD_F32, bool OUT_F32, bool Q8 = false>
DEV void thin_row(const bf16* mixrow, const void* holdv, void* hnewv, const float* gpost, float* rs, int lane, signed char* a8row = nullptr, float* rsq = nullptr) {
    float v[8][8];
    float ss = 0.f;
#pragma unroll
    for (int j = 0; j < 8; ++j) { const u32x4 m = *(const u32x4*)(mixrow + (j * 64 + lane) * 8); unpack8(m, v[j]);
#pragma unroll
        for (int e = 0; e < 8; ++e) ss += v[j][e] * v[j][e]; }
    const float rstd = 1.0f / sqrtf(wave_sum(ss) * (1.0f / DM) + EPS);
    float ss2 = 0.f;
#pragma unroll
    for (int j = 0; j < 8; ++j) { const int c0 = (j * 64 + lane) * 8; float h[8];
        if (HOLD_F32) { const f32x4 h0 = *(const f32x4*)((const float*)holdv + c0), h1 = *(const f32x4*)((const float*)holdv + c0 + 4); h[0] = h0.x; h[1] = h0.y; h[2] = h0.z; h[3] = h0.w; h[4] = h1.x; h[5] = h1.y; h[6] = h1.z; h[7] = h1.w; }
        else unpack8(*(const u32x4*)((const bf16*)holdv + c0), h);
        const f32x4 g0 = *(const f32x4*)(gpost + c0), g1 = *(const f32x4*)(gpost + c0 + 4); const float g[8] = {g0.x, g0.y, g0.z, g0.w, g1.x, g1.y, g1.z, g1.w};
#pragma unroll
        for (int e = 0; e < 8; ++e) v[j][e] = h[e] + v[j][e] * rstd * g[e];
        if (OUT_F32) { *(f32x4*)((float*)hnewv + c0) = (f32x4){v[j][0], v[j][1], v[j][2], v[j][3]}; *(f32x4*)((float*)hnewv + c0 + 4) = (f32x4){v[j][4], v[j][5], v[j][6], v[j][7]}; }
        else { const u32x4 w = pack8(v[j]); *(u32x4*)((bf16*)hnewv + c0) = w; float r[8]; unpack8(w, r);
#pragma unroll
            for (int e = 0; e < 8; ++e) ss2 += r[e] * r[e]; } }
    if (!OUT_F32) { const float rstd2 = 1.0f / sqrtf(wave_sum(ss2) * (1.0f / DM) + EPS); if (lane == 0) *rs = rstd2;
        if constexpr (Q8) {
            float am = 0.f;
#pragma unroll
            for (int j = 0; j < 8; ++j)
#pragma unroll
                for (int e = 0; e < 8; ++e) am = fmaxf(am, fabsf(v[j][e]));
            am = fmaxf(wave_max(am), 1e-30f); const float sq = 127.0f / am;
#pragma unroll
            for (int j = 0; j < 8; ++j) { unsigned lo = 0u, hi = 0u;
#pragma unroll
                for (int e = 0; e < 4; ++e) { lo |= ((unsigned)(int)__builtin_rintf(v[j][e] * sq) & 255u) << (8 * e); hi |= ((unsigned)(int)__builtin_rintf(v[j][4 + e] * sq) & 255u) << (8 * e); }
                u32x2 w; w.x = lo; w.y = hi; *(u32x2*)(a8row + (j * 64 + lane) * 8) = w; }
            if (lane == 0) *rsq = rstd2 * am * (1.0f / 127.0f); } }
}
template <bool HOLD_F32, bool OUT_F32, bool Q8 = false>
DEV void thin_phase(const Ctx& C, const bf16* mix, const void* hold, void* hnew, const float* gpost, float* RS, signed char* A8 = nullptr, float* RSQ = nullptr) {
    const int gw = C.vcu * NWAVES + C.wave, NGW = C.G * NWAVES;
    for (int r = gw; r < SEQ; r += NGW) thin_row<HOLD_F32, OUT_F32, Q8>(mix + (size_t)r * DM, (const char*)hold + (size_t)r * DM * (HOLD_F32 ? 4 : 2), (char*)hnew + (size_t)r * DM * (OUT_F32 ? 4 : 2), gpost, RS + r, C.lane,
                                                                          Q8 ? A8 + (size_t)r * DM : nullptr, Q8 ? RSQ + r : nullptr);
}
DEV void xnorm_phase(const Ctx& C, const float* xin, bf16* abuf, signed char* a8, float* rsq) {
    const int gw = C.vcu * NWAVES + C.wave, NGW = C.G * NWAVES;
    for (int r = gw; r < SEQ; r += NGW) { const float* xr = xin + (size_t)r * DM; bf16* ar = abuf + (size_t)r * DM; float v[8][8]; float ss = 0.f, am = 0.f;
#pragma unroll
        for (int j = 0; j < 8; ++j) { const int c0 = (j * 64 + C.lane) * 8; const f32x4 h0 = *(const f32x4*)(xr + c0), h1 = *(const f32x4*)(xr + c0 + 4);
            v[j][0] = h0.x; v[j][1] = h0.y; v[j][2] = h0.z; v[j][3] = h0.w; v[j][4] = h1.x; v[j][5] = h1.y; v[j][6] = h1.z; v[j][7] = h1.w;
#pragma unroll
            for (int e = 0; e < 8; ++e) { ss += v[j][e] * v[j][e]; am = fmaxf(am, fabsf(v[j][e])); } }
        const float rstd = 1.0f / sqrtf(wave_sum(ss) * (1.0f / DM) + EPS);
        am = fmaxf(wave_max(am), 1e-30f); const float sq = 127.0f / am;
#pragma unroll
        for (int j = 0; j < 8; ++j) { float o[8]; unsigned lo = 0u, hi = 0u;
#pragma unroll
            for (int e = 0; e < 8; ++e) o[e] = v[j][e] * rstd;
            *(u32x4*)(ar + (j * 64 + C.lane) * 8) = pack8(o);
#pragma unroll
            for (int e = 0; e < 4; ++e) { lo |= ((unsigned)(int)__builtin_rintf(v[j][e] * sq) & 255u) << (8 * e); hi |= ((unsigned)(int)__builtin_rintf(v[j][4 + e] * sq) & 255u) << (8 * e); }
            u32x2 w; w.x = lo; w.y = hi; *(u32x2*)(a8 + (size_t)r * DM + (j * 64 + C.lane) * 8) = w; }
        if (C.lane == 0) rsq[r] = rstd * am * (1.0f / 127.0f); }
}

DEV void dt_gemm(const Ctx& C, const bf16* __restrict__ A, const bf16* __restrict__ Bt, float* __restrict__ out) {
    const int r16 = C.lane & 15, kq = C.lane >> 4; LAS float* part = (LAS float*)C.lds;
    for (int rb = C.vcu; rb < SEQ / 32; rb += C.G) {
        const bf16* a0 = A + (size_t)(rb * 32 + r16) * DM + C.wave * 512 + kq * 8; const bf16* a1 = a0 + (size_t)16 * DM;
        const bf16* b0 = Bt + (size_t)r16 * DM + C.wave * 512 + kq * 8;
        f32x4 acc[2][8];
#pragma unroll
        for (int m = 0; m < 2; ++m)
#pragma unroll
            for (int n = 0; n < 8; ++n) acc[m][n] = (f32x4){0.f, 0.f, 0.f, 0.f};
#pragma unroll 2
        for (int ks = 0; ks < 16; ++ks) {
            const bf16x8 fa0 = *(const bf16x8*)(a0 + ks * 32), fa1 = *(const bf16x8*)(a1 + ks * 32); bf16x8 fb[8];
#pragma unroll
            for (int n = 0; n < 8; ++n) fb[n] = *(const bf16x8*)(b0 + (size_t)(16 * n) * DM + ks * 32);
#pragma unroll
            for (int n = 0; n < 8; ++n) { acc[0][n] = __builtin_amdgcn_mfma_f32_16x16x32_bf16(fa0, fb[n], acc[0][n], 0, 0, 0); acc[1][n] = __builtin_amdgcn_mfma_f32_16x16x32_bf16(fa1, fb[n], acc[1][n], 0, 0, 0); }
        }
#pragma unroll
        for (int m = 0; m < 2; ++m)
#pragma unroll
            for (int n = 0; n < 8; ++n)
#pragma unroll
                for (int r = 0; r < 4; ++r) part[(C.wave * 32 + m * 16 + kq * 4 + r) * 128 + n * 16 + r16] = acc[m][n][r];
        __syncthreads();
#pragma unroll
        for (int i = 0; i < 2; ++i) { const int e = (C.tid + 512 * i) * 4;
            f32x4 sum = *(const LAS f32x4*)(part + e);
#pragma unroll
            for (int w = 1; w < 8; ++w) sum += *(const LAS f32x4*)(part + w * 4096 + e);
            *(f32x4*)(out + (size_t)rb * 32 * 128 + e) = sum; }
        __syncthreads();
    }
}

DEV void ssd_prep(const Ctx& C, const float* __restrict__ dtraw, const float* __restrict__ dtbias, const float* __restrict__ alog, float* __restrict__ DT, float* __restrict__ ACUM) {
    LAS float* segsum = (LAS float*)C.lds;
    for (int c = C.vcu; c < NCHUNK; c += C.G) {
        const int h = C.tid & 127, seg = C.tid >> 7; const float bias = dtbias[h], Aneg = -__expf(alog[h]);
        const size_t o0 = (size_t)(c * CHUNK + seg * 32) * NHEAD + h;
        float xr[32];
#pragma unroll
        for (int i = 0; i < 32; ++i) xr[i] = dtraw[o0 + (size_t)i * NHEAD];
        float run = 0.f;
#pragma unroll
        for (int i = 0; i < 32; ++i) { const float xx = xr[i] + bias; const float dt = fmaxf(xx, 0.f) + log1pf(__expf(-fabsf(xx))); DT[o0 + (size_t)i * NHEAD] = dt; run += dt * Aneg; xr[i] = run; }
        segsum[seg * 128 + h] = run;
        __syncthreads();
        float pre = 0.f;
#pragma unroll
        for (int k = 0; k < 3; ++k) pre += (k < seg) ? segsum[k * 128 + h] : 0.f;
#pragma unroll
        for (int i = 0; i < 32; ++i) ACUM[o0 + (size_t)i * NHEAD] = xr[i] + pre;
        __syncthreads();
    }
}

#define MFMA32(a, b, c) __builtin_amdgcn_mfma_f32_32x32x16_bf16((a), (b), (c), 0, 0, 0)
constexpr int LROW = 272;
DEV void transpose8x8(const u32x4 (&r)[8], u32x4 (&o)[8]) {
#pragma unroll
    for (int c2 = 0; c2 < 4; ++c2) {
        const unsigned a0 = r[0][c2], a1 = r[1][c2], a2 = r[2][c2], a3 = r[3][c2], a4 = r[4][c2], a5 = r[5][c2], a6 = r[6][c2], a7 = r[7][c2];
        o[2 * c2].x = __builtin_amdgcn_perm(a1, a0, 0x05040100u); o[2 * c2].y = __builtin_amdgcn_perm(a3, a2, 0x05040100u); o[2 * c2].z = __builtin_amdgcn_perm(a5, a4, 0x05040100u); o[2 * c2].w = __builtin_amdgcn_perm(a7, a6, 0x05040100u);
        o[2 * c2 + 1].x = __builtin_amdgcn_perm(a1, a0, 0x07060302u); o[2 * c2 + 1].y = __builtin_amdgcn_perm(a3, a2, 0x07060302u); o[2 * c2 + 1].z = __builtin_amdgcn_perm(a5, a4, 0x07060302u); o[2 * c2 + 1].w = __builtin_amdgcn_perm(a7, a6, 0x07060302u); }
}
DEV void conv8x8(const bf16* __restrict__ ZX, size_t t0, int ch0, const float* __restrict__ cw, const float* __restrict__ cb, u32x4 (&r)[8]) {
    const bf16* src = ZX + DINNER + ch0;
    u32x4 raw[11];
#pragma unroll
    for (int k = 0; k < 3; ++k) raw[k] = t0 ? *(const u32x4*)(src + (t0 - 3 + k) * NZX) : (u32x4){0u, 0u, 0u, 0u};
#pragma unroll
    for (int k = 0; k < 8; ++k) raw[3 + k] = *(const u32x4*)(src + (t0 + k) * NZX);
    float w[4][8], b[8];
#pragma unroll
    for (int k = 0; k < 4; ++k) { const f32x4 a = *(const f32x4*)(cw + k * CONVD + ch0), bq = *(const f32x4*)(cw + k * CONVD + ch0 + 4); w[k][0] = a.x; w[k][1] = a.y; w[k][2] = a.z; w[k][3] = a.w; w[k][4] = bq.x; w[k][5] = bq.y; w[k][6] = bq.z; w[k][7] = bq.w; }
    { const f32x4 a = *(const f32x4*)(cb + ch0), bq = *(const f32x4*)(cb + ch0 + 4); b[0] = a.x; b[1] = a.y; b[2] = a.z; b[3] = a.w; b[4] = bq.x; b[5] = bq.y; b[6] = bq.z; b[7] = bq.w; }
    float x3[8], x2[8], x1[8]; unpack8(raw[0], x3); unpack8(raw[1], x2); unpack8(raw[2], x1);
#pragma unroll
    for (int k = 0; k < 8; ++k) { float x0[8], o[8]; unpack8(raw[3 + k], x0);
#pragma unroll
        for (int e = 0; e < 8; ++e) { o[e] = silu_f(b[e] + w[0][e] * x3[e] + w[1][e] * x2[e] + w[2][e] * x1[e] + w[3][e] * x0[e]); x3[e] = x2[e]; x2[e] = x1[e]; x1[e] = x0[e]; }
        r[k] = pack8(o); }
}
DEV void ssd_states_unit(const Ctx& C, int c, int g, const bf16* __restrict__ ZX, const float* __restrict__ cw, const float* __restrict__ cb, const float* __restrict__ DT, const float* __restrict__ ACUM, bf16* __restrict__ S) {
    LAS unsigned char* BT = C.lds; LAS unsigned char* XW = C.lds + 34816; LAS float* wtab = (LAS float*)(C.lds + 104448);
    const int tid = C.tid, lane = C.lane, wave = C.wave, hh = lane >> 5, l31 = lane & 31;
    const size_t row0 = (size_t)c * CHUNK;
    for (int idx = tid; idx < 2048; idx += 512) { const int r = idx & 15, s = idx >> 4, h = g * HPG + r;
        const float alast = ACUM[(row0 + 127) * NHEAD + h]; const size_t o = (row0 + s) * NHEAD + h;
        wtab[r * 128 + s] = DT[o] * __expf(alast - ACUM[o]); }
    if (tid < 256) {
        const int so = tid & 15, oct = tid >> 4;
        u32x4 r[8], o[8];
        conv8x8(ZX, row0 + so * 8, DINNER + g * DSTATE + oct * 8, cw, cb, r);
        transpose8x8(r, o);
#pragma unroll
        for (int cc = 0; cc < 8; ++cc) *(LAS u32x4*)(BT + (oct * 8 + cc) * LROW + so * 16) = o[cc]; }
    __syncthreads();
    for (int q = 0; q < 4; ++q) {
        {
            const int so = tid & 15, oct = tid >> 4, r = 4 * q + (oct >> 3);
            u32x4 rr[8], o[8];
            conv8x8(ZX, row0 + so * 8, g * 1024 + q * 256 + oct * 8, cw, cb, rr);
            const f32x4 w0 = *(const LAS f32x4*)(wtab + r * 128 + so * 8), w1 = *(const LAS f32x4*)(wtab + r * 128 + so * 8 + 4);
            transpose8x8(rr, o);
#pragma unroll
            for (int cc = 0; cc < 8; ++cc) { float f[8]; unpack8(o[cc], f);
                u32x4 w; w.x = pk2(f[0] * w0.x, f[1] * w0.y); w.y = pk2(f[2] * w0.z, f[3] * w0.w); w.z = pk2(f[4] * w1.x, f[5] * w1.y); w.w = pk2(f[6] * w1.z, f[7] * w1.w);
                *(LAS u32x4*)(XW + (oct * 8 + cc) * LROW + so * 16) = w; } }
        __syncthreads();
        const int rq = wave >> 1, ph = wave & 1;
        f32x16 acc[4];
#pragma unroll
        for (int nt = 0; nt < 4; ++nt)
#pragma unroll
            for (int e = 0; e < 16; ++e) acc[nt][e] = 0.f;
        const LAS unsigned char* xrow = XW + (rq * 64 + ph * 32 + l31) * LROW + hh * 16;
        const LAS unsigned char* brow = BT + l31 * LROW + hh * 16;
#pragma unroll
        for (int ks = 0; ks < 8; ++ks) { const bf16x8 xb = *(const LAS bf16x8*)(xrow + ks * 32);
#pragma unroll
            for (int nt = 0; nt < 4; ++nt) { const bf16x8 a = *(const LAS bf16x8*)(brow + nt * 32 * LROW + ks * 32); acc[nt] = MFMA32(a, xb, acc[nt]); } }
        const int h = g * HPG + 4 * q + rq;
        bf16* dst = S + ((((size_t)c * NHEAD + h) * 2 + ph) * 8) * 512 + lane * 8;
#pragma unroll
        for (int nt = 0; nt < 4; ++nt)
#pragma unroll
            for (int s2 = 0; s2 < 2; ++s2) { u32x4 w; w.x = pk2(acc[nt][8 * s2 + 0], acc[nt][8 * s2 + 1]); w.y = pk2(acc[nt][8 * s2 + 2], acc[nt][8 * s2 + 3]); w.z = pk2(acc[nt][8 * s2 + 4], acc[nt][8 * s2 + 5]); w.w = pk2(acc[nt][8 * s2 + 6], acc[nt][8 * s2 + 7]);
                *(u32x4*)(dst + (2 * nt + s2) * 512) = w; }
        __syncthreads();
    }
}
DEV void ssd_scan(const Ctx& C, const bf16* __restrict__ S, const float* __restrict__ ACUM, bf16* __restrict__ ST) {
    const int gtid = C.vcu * (NWAVES * 64) + C.tid, nthr = C.G * NWAVES * 64;
    constexpr size_t CSTRIDE = (size_t)NHEAD * HDIM * DSTATE;
    for (int idx = gtid; idx < NHEAD * HDIM * DSTATE / 8; idx += nthr) {
        const int h = idx >> 10; const size_t base = (size_t)idx * 8;
        float run[8];
#pragma unroll
        for (int e = 0; e < 8; ++e) run[e] = 0.f;
#pragma unroll 1
        for (int cb = 0; cb < NCHUNK; cb += 16) { u32x4 raw[16]; float dec[16];
#pragma unroll
            for (int k = 0; k < 16; ++k) { raw[k] = __builtin_nontemporal_load((const u32x4*)(S + (cb + k) * CSTRIDE + base)); dec[k] = ACUM[((size_t)(cb + k) * CHUNK + 127) * NHEAD + h]; }
#pragma unroll
            for (int k = 0; k < 16; ++k) { float sv[8]; unpack8(raw[k], sv); const float d = __expf(dec[k]);
                *(u32x4*)(ST + (cb + k) * CSTRIDE + base) = pack8(run);
#pragma unroll
                for (int e = 0; e < 8; ++e) run[e] = run[e] * d + sv[e]; } }
    }
}
DEV void ssd_groupnorm_g(bf16* Y, size_t r0, int g, int wave, int lane) {
    for (int rr = wave; rr < CHUNK; rr += NWAVES) { bf16* p = Y + (r0 + rr) * DINNER + g * 1024 + lane * 16;
        float a[8], b[8]; unpack8(*(const u32x4*)p, a); unpack8(*(const u32x4*)(p + 8), b); float ss = 0.f;
#pragma unroll
        for (int e = 0; e < 8; ++e) ss += a[e] * a[e] + b[e] * b[e];
        const float rstd = 1.0f / sqrtf(wave_sum(ss) * (1.0f / 1024.0f) + SSM_EPS);
#pragma unroll
        for (int e = 0; e < 8; ++e) { a[e] *= rstd; b[e] *= rstd; }
        *(u32x4*)p = pack8(a); *(u32x4*)(p + 8) = pack8(b); }
}
constexpr int YROW = 528;
DEV void ssd_out_unit(const Ctx& C, int c, int g, const float* __restrict__ cw, const float* __restrict__ cb, const bf16* __restrict__ ZX, const float* __restrict__ DT, const float* __restrict__ ACUM,
                      const bf16* __restrict__ ST, const float* __restrict__ dskip, bf16* __restrict__ Y) {
    LAS unsigned char* CM = C.lds; LAS unsigned char* BM = C.lds + 34816; LAS unsigned char* XT = C.lds + 69632;
    LAS float* atab = (LAS float*)(C.lds + 139264); LAS float* dtab = (LAS float*)(C.lds + 147456); LAS float* ttab = (LAS float*)(C.lds + 155648);
    const int tid0 = C.tid, lane = C.lane, wave = C.wave, hh = lane >> 5, l31 = lane & 31;
    const size_t row0 = (size_t)c * CHUNK;
    { const int tid = tid0;
    {
        const int isc = tid >> 8, so = tid & 15, oct = (tid >> 4) & 15; u32x4 r[8];
        conv8x8(ZX, row0 + so * 8, DINNER + isc * NGRP * DSTATE + g * DSTATE + oct * 8, cw, cb, r);
        LAS unsigned char* dstm = isc ? CM : BM;
#pragma unroll
        for (int j = 0; j < 8; ++j) *(LAS u32x4*)(dstm + (so * 8 + j) * LROW + oct * 16) = r[j]; }
    for (int idx = tid; idx < 2048; idx += 512) { const int r = idx & 15, s = idx >> 4; const size_t o = (row0 + s) * NHEAD + g * HPG + r; atab[r * 128 + s] = ACUM[o]; dtab[r * 128 + s] = DT[o]; } }
    __syncthreads();
    {
        const int lt = wave >> 1, st0 = 2 * (wave & 1);
        f32x16 cb[2];
#pragma unroll
        for (int t = 0; t < 2; ++t)
#pragma unroll
            for (int e = 0; e < 16; ++e) cb[t][e] = 0.f;
        const LAS unsigned char* arow = CM + (lt * 32 + l31) * LROW + hh * 16;
        const LAS unsigned char* brow = BM + (st0 * 32 + l31) * LROW + hh * 16;
#pragma unroll
        for (int ks = 0; ks < 8; ++ks) { const bf16x8 a = *(const LAS bf16x8*)(arow + ks * 32);
#pragma unroll
            for (int t = 0; t < 2; ++t) { const bf16x8 b = *(const LAS bf16x8*)(brow + t * 32 * LROW + ks * 32); cb[t] = MFMA32(a, b, cb[t]); } }
        __syncthreads();
#pragma unroll
        for (int t = 0; t < 2; ++t)
#pragma unroll
            for (int e = 0; e < 16; ++e) { const int l = lt * 32 + (e & 3) + 8 * (e >> 2) + 4 * hh, s = (st0 + t) * 32 + l31;
                *(LAS unsigned short*)(BM + l * LROW + s * 2) = f2bf(cb[t][e]); }
    }
    __syncthreads();
    float ssq[8];
#pragma unroll
    for (int i = 0; i < 8; ++i) ssq[i] = 0.f;
    for (int q = 0; q < 4; ++q) {
        int tid = tid0; asm volatile("" : "+v"(tid));
        const int ch = tid & 31, lrow = tid >> 5;
        const int rq = wave >> 1, r = 4 * q + rq, h = g * HPG + r; const float Dk = dskip[h];
        const bf16* stp = ST + (((size_t)c * NHEAD + h) * 2 * 8) * 512 + lane * 8;
        bf16x8 sb[8][2];
        {
            const int so = tid & 15, oct = tid >> 4;
            u32x4 rr[8], o[8];
            conv8x8(ZX, row0 + so * 8, g * 1024 + q * 256 + oct * 8, cw, cb, rr);
            transpose8x8(rr, o);
#pragma unroll
            for (int cc = 0; cc < 8; ++cc) *(LAS u32x4*)(XT + (oct * 8 + cc) * LROW + so * 16) = o[cc]; }
#ifdef P4_FACT
        { const int rl = tid >> 7, s_ = tid & 127, rr_ = (4 * q + rl) * 128;
          ttab[rl * 128 + s_] = __expf(atab[rr_ + (s_ | 7)] - atab[rr_ + s_]) * dtab[rr_ + s_]; }
#endif
        asm volatile("" ::: "memory");
#pragma unroll
        for (int ks = 0; ks < 8; ++ks) { sb[ks][0] = *(const bf16x8*)(stp + ks * 512); sb[ks][1] = *(const bf16x8*)(stp + (8 + ks) * 512); }
        __syncthreads();
        const int lt0 = (wave & 1) ? 1 : 0, lt1 = (wave & 1) ? 2 : 3;
        const int l0 = lt0 * 32 + l31, l1 = lt1 * 32 + l31;
        const float al0 = atab[r * 128 + l0], al1 = atab[r * 128 + l1]; const float eal0 = __expf(al0), eal1 = __expf(al1);
        f32x16 acc[2][2];
#pragma unroll
        for (int li = 0; li < 2; ++li)
#pragma unroll
            for (int pt = 0; pt < 2; ++pt)
#pragma unroll
                for (int e = 0; e < 16; ++e) acc[li][pt][e] = 0.f;
#pragma unroll
        for (int ks = 0; ks < 8; ++ks) {
            const bf16x8 b0 = sb[ks][0], b1 = sb[ks][1];
            float f[8]; { const u32x2 c0 = *(const LAS u32x2*)(CM + l0 * LROW + ks * 32 + hh * 8), c1 = *(const LAS u32x2*)(CM + l0 * LROW + ks * 32 + 16 + hh * 8); u32x4 cw; cw.x = c0.x; cw.y = c0.y; cw.z = c1.x; cw.w = c1.y; unpack8(cw, f); }
#pragma unroll
            for (int j = 0; j < 8; ++j) f[j] *= eal0;
            const bf16x8 a0 = __builtin_bit_cast(bf16x8, pack8(f));
            { const u32x2 c0 = *(const LAS u32x2*)(CM + l1 * LROW + ks * 32 + hh * 8), c1 = *(const LAS u32x2*)(CM + l1 * LROW + ks * 32 + 16 + hh * 8); u32x4 cw; cw.x = c0.x; cw.y = c0.y; cw.z = c1.x; cw.w = c1.y; unpack8(cw, f); }
#pragma unroll
            for (int j = 0; j < 8; ++j) f[j] *= eal1;
            const bf16x8 a1 = __builtin_bit_cast(bf16x8, pack8(f));
            acc[0][0] = MFMA32(a0, b0, acc[0][0]); acc[0][1] = MFMA32(a0, b1, acc[0][1]); acc[1][0] = MFMA32(a1, b0, acc[1][0]); acc[1][1] = MFMA32(a1, b1, acc[1][1]); }
#ifdef P4_FACT
        for (int ks = 0; ks < 2 * lt1 + 2; ++ks) { const int s0 = ks * 16 + hh * 8;
            const bf16x8 b0 = *(const LAS bf16x8*)(XT + (rq * 64 + l31) * LROW + s0 * 2), b1 = *(const LAS bf16x8*)(XT + (rq * 64 + 32 + l31) * LROW + s0 * 2);
            float f[8];
            if (ks < 2 * lt1) {
                const f32x4 t0 = *(const LAS f32x4*)(ttab + rq * 128 + s0), t1 = *(const LAS f32x4*)(ttab + rq * 128 + s0 + 4); const float aref = atab[r * 128 + s0 + 7];
                const float tt[8] = {t0.x, t0.y, t0.z, t0.w, t1.x, t1.y, t1.z, t1.w};
                const float E1 = __expf(al1 - aref);
                unpack8(*(const LAS u32x4*)(BM + l1 * LROW + s0 * 2), f);
#pragma unroll
                for (int j = 0; j < 8; ++j) f[j] = f[j] * (E1 * tt[j]);
                const bf16x8 a1 = __builtin_bit_cast(bf16x8, pack8(f));
                acc[1][0] = MFMA32(a1, b0, acc[1][0]); acc[1][1] = MFMA32(a1, b1, acc[1][1]);
                if (ks < 2 * lt0) {
                    const float E0 = __expf(al0 - aref);
                    unpack8(*(const LAS u32x4*)(BM + l0 * LROW + s0 * 2), f);
#pragma unroll
                    for (int j = 0; j < 8; ++j) f[j] = f[j] * (E0 * tt[j]);
                    const bf16x8 a0 = __builtin_bit_cast(bf16x8, pack8(f));
                    acc[0][0] = MFMA32(a0, b0, acc[0][0]); acc[0][1] = MFMA32(a0, b1, acc[0][1]); }
                else if (ks < 2 * lt0 + 2) {
                    const f32x4 q0 = *(const LAS f32x4*)(atab + r * 128 + s0), q1 = *(const LAS f32x4*)(atab + r * 128 + s0 + 4), d0 = *(const LAS f32x4*)(dtab + r * 128 + s0), d1 = *(const LAS f32x4*)(dtab + r * 128 + s0 + 4);
                    const float as[8] = {q0.x, q0.y, q0.z, q0.w, q1.x, q1.y, q1.z, q1.w}, ds[8] = {d0.x, d0.y, d0.z, d0.w, d1.x, d1.y, d1.z, d1.w};
                    unpack8(*(const LAS u32x4*)(BM + l0 * LROW + s0 * 2), f);
#pragma unroll
                    for (int j = 0; j < 8; ++j) { f[j] = (s0 + j <= l0) ? f[j] * __expf(al0 - as[j]) * ds[j] : 0.f; if (s0 + j == l0) f[j] += Dk; }
                    const bf16x8 a0 = __builtin_bit_cast(bf16x8, pack8(f));
                    acc[0][0] = MFMA32(a0, b0, acc[0][0]); acc[0][1] = MFMA32(a0, b1, acc[0][1]); } }
            else {
                const f32x4 q0 = *(const LAS f32x4*)(atab + r * 128 + s0), q1 = *(const LAS f32x4*)(atab + r * 128 + s0 + 4), d0 = *(const LAS f32x4*)(dtab + r * 128 + s0), d1 = *(const LAS f32x4*)(dtab + r * 128 + s0 + 4);
                const float as[8] = {q0.x, q0.y, q0.z, q0.w, q1.x, q1.y, q1.z, q1.w}, ds[8] = {d0.x, d0.y, d0.z, d0.w, d1.x, d1.y, d1.z, d1.w};
                unpack8(*(const LAS u32x4*)(BM + l1 * LROW + s0 * 2), f);
#pragma unroll
                for (int j = 0; j < 8; ++j) { f[j] = (s0 + j <= l1) ? f[j] * __expf(al1 - as[j]) * ds[j] : 0.f; if (s0 + j == l1) f[j] += Dk; }
                const bf16x8 a1 = __builtin_bit_cast(bf16x8, pack8(f));
                acc[1][0] = MFMA32(a1, b0, acc[1][0]); acc[1][1] = MFMA32(a1, b1, acc[1][1]); } }
#else
        for (int ks = 0; ks < 2 * lt1 + 2; ++ks) { const int s0 = ks * 16 + hh * 8;
            const bf16x8 b0 = *(const LAS bf16x8*)(XT + (rq * 64 + l31) * LROW + s0 * 2), b1 = *(const LAS bf16x8*)(XT + (rq * 64 + 32 + l31) * LROW + s0 * 2);
            const f32x4 q0 = *(const LAS f32x4*)(atab + r * 128 + s0), q1 = *(const LAS f32x4*)(atab + r * 128 + s0 + 4), d0 = *(const LAS f32x4*)(dtab + r * 128 + s0), d1 = *(const LAS f32x4*)(dtab + r * 128 + s0 + 4);
            const float as[8] = {q0.x, q0.y, q0.z, q0.w, q1.x, q1.y, q1.z, q1.w}, ds[8] = {d0.x, d0.y, d0.z, d0.w, d1.x, d1.y, d1.z, d1.w};
            float f[8]; unpack8(*(const LAS u32x4*)(BM + l1 * LROW + s0 * 2), f);
#pragma unroll
            for (int j = 0; j < 8; ++j) { f[j] = (s0 + j <= l1) ? f[j] * __expf(al1 - as[j]) * ds[j] : 0.f; if (s0 + j == l1) f[j] += Dk; }
            const bf16x8 a1 = __builtin_bit_cast(bf16x8, pack8(f));
            acc[1][0] = MFMA32(a1, b0, acc[1][0]); acc[1][1] = MFMA32(a1, b1, acc[1][1]);
            if (ks < 2 * lt0 + 2) {
                unpack8(*(const LAS u32x4*)(BM + l0 * LROW + s0 * 2), f);
#pragma unroll
                for (int j = 0; j < 8; ++j) { f[j] = (s0 + j <= l0) ? f[j] * __expf(al0 - as[j]) * ds[j] : 0.f; if (s0 + j == l0) f[j] += Dk; }
                const bf16x8 a0 = __builtin_bit_cast(bf16x8, pack8(f));
                acc[0][0] = MFMA32(a0, b0, acc[0][0]); acc[0][1] = MFMA32(a0, b1, acc[0][1]); } }
#endif
        __syncthreads();
#pragma unroll
        for (int li = 0; li < 2; ++li)
#pragma unroll
            for (int pt = 0; pt < 2; ++pt)
#pragma unroll
                for (int e = 0; e < 16; ++e) { const int le = (li ? lt1 : lt0) * 32 + (e & 3) + 8 * (e >> 2) + 4 * hh;
                    *(LAS unsigned short*)(XT + le * YROW + (rq * 64 + pt * 32 + l31) * 2) = f2bf(acc[li][pt][e]); }
        __syncthreads();
#pragma unroll
        for (int i = 0; i < 8; ++i) { const int l = lrow + 16 * i; const size_t colg = (size_t)g * 1024 + q * 256 + ch * 8;
            float ys[8], zs[8]; unpack8(*(const LAS u32x4*)(XT + l * YROW + ch * 16), ys); unpack8(__builtin_nontemporal_load((const u32x4*)(ZX + (row0 + l) * NZX + colg)), zs);
#pragma unroll
            for (int j = 0; j < 8; ++j) ys[j] = ys[j] * silu_f(zs[j]);
            const u32x4 w = pack8(ys); *(u32x4*)(Y + (row0 + l) * DINNER + colg) = w; unpack8(w, ys);
            float s = 0.f;
#pragma unroll
            for (int j = 0; j < 8; ++j) s += ys[j] * ys[j];
            ssq[i] += s; }
        __syncthreads();
    }
    asm volatile("s_waitcnt vmcnt(0)" ::: "memory");
    int tid = tid0; asm volatile("" : "+v"(tid));
    const int ch = tid & 31, lrow = tid >> 5;
#pragma unroll
    for (int i = 0; i < 8; ++i) { float s = ssq[i]; s += __shfl_xor(s, 1); s += __shfl_xor(s, 2); s += __shfl_xor(s, 4); s += __shfl_xor(s, 8); s += __shfl_xor(s, 16); ssq[i] = 1.0f / sqrtf(s * (1.0f / 1024.0f) + SSM_EPS); }
#pragma unroll
    for (int qp = 0; qp < 2; ++qp) { u32x4 raw[2][8];
#pragma unroll
        for (int q2 = 0; q2 < 2; ++q2)
#pragma unroll
            for (int i = 0; i < 8; ++i) raw[q2][i] = *(const u32x4*)(Y + (row0 + lrow + 16 * i) * DINNER + (size_t)g * 1024 + (2 * qp + q2) * 256 + ch * 8);
#pragma unroll
        for (int q2 = 0; q2 < 2; ++q2)
#pragma unroll
            for (int i = 0; i < 8; ++i) { float v[8]; unpack8(raw[q2][i], v);
#pragma unroll
                for (int j = 0; j < 8; ++j) v[j] *= ssq[i];
                *(u32x4*)(Y + (row0 + lrow + 16 * i) * DINNER + (size_t)g * 1024 + (2 * qp + q2) * 256 + ch * 8) = pack8(v); } }
}

DEV int t5_bucket(int rel) { if (rel < 16) return rel; const int v = 16 + (int)(logf((float)rel * (1.0f / 16.0f)) / logf(8.0f) * 16.0f); return v < 31 ? v : 31; }

constexpr int KROW = 144;
constexpr int VROW = 528;
DEV void attn_unit(const Ctx& C, int qb, int g, const bf16* __restrict__ Q, const bf16* __restrict__ KV, bf16* __restrict__ O, const float* __restrict__ sinks, const float* __restrict__ relb) {
    LAS unsigned char* KT = C.lds; LAS unsigned char* VT = C.lds + 36864; LAS float* btab = (LAS float*)(C.lds + 70656);
    const int tid = C.tid, lane = C.lane, wave = C.wave, hh = lane >> 5, l31 = lane & 31;
#pragma unroll
    for (int i = 0; i < 4; ++i) { const int task = tid + 512 * i, ch = task & 7, kr = task >> 3; const int row = (qb - 1) * 128 + kr;
        u32x4 kv = {0u, 0u, 0u, 0u}, vv = {0u, 0u, 0u, 0u};
        if (row >= 0) { const bf16* src = KV + (size_t)row * 1024 + g * 64 + ch * 8; kv = *(const u32x4*)src; vv = *(const u32x4*)(src + 512); }
        *(LAS u32x4*)(KT + kr * KROW + ch * 16) = kv;
        LAS unsigned short* vd = (LAS unsigned short*)(VT + (ch * 8) * VROW + kr * 2);
        vd[0 * (VROW / 2)] = (unsigned short)(vv.x & 0xffffu); vd[1 * (VROW / 2)] = (unsigned short)(vv.x >> 16); vd[2 * (VROW / 2)] = (unsigned short)(vv.y & 0xffffu); vd[3 * (VROW / 2)] = (unsigned short)(vv.y >> 16);
        vd[4 * (VROW / 2)] = (unsigned short)(vv.z & 0xffffu); vd[5 * (VROW / 2)] = (unsigned short)(vv.z >> 16); vd[6 * (VROW / 2)] = (unsigned short)(vv.w & 0xffffu); vd[7 * (VROW / 2)] = (unsigned short)(vv.w >> 16); }
    for (int idx = tid; idx < 1024; idx += 512) { const int w = idx >> 7, rel = idx & 127; btab[idx] = relb[t5_bucket(rel) * 64 + g * 8 + w]; }
    __syncthreads();
    const int hq = g * 8 + wave; const float sink = sinks[hq];
    for (int qt = 0; qt < 4; ++qt) {
        const size_t qrow = (size_t)qb * 128 + qt * 32 + l31;
        bf16x8 qf[4];
#pragma unroll
        for (int ks = 0; ks < 4; ++ks) qf[ks] = *(const bf16x8*)(Q + qrow * DM + hq * 64 + ks * 16 + hh * 8);
        f32x16 sc[5];
#pragma unroll
        for (int i = 0; i < 5; ++i) {
#pragma unroll
            for (int e = 0; e < 16; ++e) sc[i][e] = 0.f;
#pragma unroll
            for (int ks = 0; ks < 4; ++ks) { const bf16x8 a = *(const LAS bf16x8*)(KT + ((qt + i) * 32 + l31) * KROW + ks * 32 + hh * 16); sc[i] = MFMA32(a, qf[ks], sc[i]); } }
        float mx = -3.0e38f;
#pragma unroll
        for (int i = 0; i < 5; ++i)
#pragma unroll
            for (int e = 0; e < 16; ++e) { const int kl = (e & 3) + 8 * (e >> 2) + 4 * hh;
                const int rel = l31 - kl + 128 - 32 * i; const int key = (qt + i) * 32 + kl;
                const bool valid = (rel >= 0) && (rel < 128) && (qb > 0 || key >= 128);
                const float s = sc[i][e] + btab[wave * 128 + (rel & 127)];
                sc[i][e] = valid ? s : -3.0e38f; mx = fmaxf(mx, sc[i][e]); }
        mx = fmaxf(mx, __shfl_xor(mx, 32)); mx = fmaxf(mx, sink);
        float lsum = 0.f;
#pragma unroll
        for (int i = 0; i < 5; ++i)
#pragma unroll
            for (int e = 0; e < 16; ++e) { const float p = (sc[i][e] > -1.0e38f) ? __expf(sc[i][e] - mx) : 0.f; sc[i][e] = p; lsum += p; }
        lsum += __shfl_xor(lsum, 32);
        const float inv = 1.0f / (lsum + __expf(sink - mx));
        f32x16 oa[2];
#pragma unroll
        for (int dt = 0; dt < 2; ++dt)
#pragma unroll
            for (int e = 0; e < 16; ++e) oa[dt][e] = 0.f;
#pragma unroll
        for (int i = 0; i < 5; ++i)
#pragma unroll
            for (int s2 = 0; s2 < 2; ++s2) {
                asm volatile("" ::: "memory");
                u32x4 pw; pw.x = pk2(sc[i][8 * s2 + 0], sc[i][8 * s2 + 1]); pw.y = pk2(sc[i][8 * s2 + 2], sc[i][8 * s2 + 3]); pw.z = pk2(sc[i][8 * s2 + 4], sc[i][8 * s2 + 5]); pw.w = pk2(sc[i][8 * s2 + 6], sc[i][8 * s2 + 7]);
                const bf16x8 pb = __builtin_bit_cast(bf16x8, pw);
#pragma unroll
                for (int dt = 0; dt < 2; ++dt) { const LAS unsigned char* vp = VT + (dt * 32 + l31) * VROW + ((qt + i) * 32 + 16 * s2 + 4 * hh) * 2;
                    const u32x2 v0 = *(const LAS u32x2*)vp, v1 = *(const LAS u32x2*)(vp + 16);
                    u32x4 aw; aw.x = v0.x; aw.y = v0.y; aw.z = v1.x; aw.w = v1.y;
                    oa[dt] = MFMA32(__builtin_bit_cast(bf16x8, aw), pb, oa[dt]); } }
        bf16* op = O + qrow * DM + hq * 64 + 4 * hh;
#pragma unroll
        for (int dt = 0; dt < 2; ++dt)
#pragma unroll
            for (int g4 = 0; g4 < 4; ++g4) { u32x2 w; w.x = pk2(oa[dt][4 * g4] * inv, oa[dt][4 * g4 + 1] * inv); w.y = pk2(oa[dt][4 * g4 + 2] * inv, oa[dt][4 * g4 + 3] * inv);
                *(u32x2*)(op + dt * 32 + 8 * g4) = w; }
    }
    __syncthreads();
}

#ifndef REP_PRO
#define REP_PRO 1
#endif
#ifndef REP_GEMM_IN
#define REP_GEMM_IN 1
#endif
#ifndef REP_GEMM_OUT
#define REP_GEMM_OUT 1
#endif
#ifndef REP_GEMM_UP
#define REP_GEMM_UP 1
#endif
#ifndef REP_GEMM_DN
#define REP_GEMM_DN 1
#endif
#ifndef REP_GEMM_KVQ
#define REP_GEMM_KVQ 1
#endif
#ifndef REP_GEMM_O
#define REP_GEMM_O 1
#endif
#ifndef REP_PREP
#define REP_PREP 1
#endif
#ifndef REP_P2
#define REP_P2 1
#endif
#ifndef REP_P3
#define REP_P3 1
#endif
#ifndef REP_P4
#define REP_P4 1
#endif
#ifndef REP_THIN
#define REP_THIN 1
#endif
#ifndef REP_CONV
#define REP_CONV 1
#endif
#ifndef REP_ATT
#define REP_ATT 1
#endif
struct Args { const float* in[26]; float* out; unsigned char* ws; };
enum { I_X = 0, I_NMPRE, I_NMPOST, I_NFPRE, I_NFPOST, I_WIN, I_SCW, I_SCB, I_DTB, I_ALOG, I_D, I_SNORM, I_WOUT, I_KVN, I_WKV, I_BKV, I_WQ, I_BQ, I_SINK, I_WO, I_BO, I_RELB, I_WUP, I_FCW, I_FCB, I_WDN };

#ifndef GEMM_ALIGN
#define GEMM_ALIGN true
#endif
#ifndef GEMM_SP2
#define GEMM_SP2 true
#endif
#ifdef NOIDLE
#define IDLE_SLOT(n_units, W_, K_, N_, gain_, WT_, lo_, hi_) do { } while (0)
#else
#define IDLE_SLOT_REAL 1
#endif
#ifdef IDLE_SLOT_REAL
#define IDLE_SLOT(n_units, W_, K_, N_, gain_, WT_, lo_, hi_) do { const int ex_ = (n_units) % C.G; \
    const int iw_ = ex_ > 0 ? ((int)blockIdx.x - ex_) * NWAVES + C.wave : (int)blockIdx.x * NWAVES + C.wave, in_ = ex_ > 0 ? (C.G - ex_) * NWAVES : C.G * NWAVES;     \
    if (iw_ >= 0) tr_matrix(C, (W_), (K_), (N_), (gain_), (WT_), 0, iw_, in_, (lo_), (hi_)); } while (0)
#endif
#define RUN_GEMM_I8(EpiT, Aptr, Btptr, N_, K8_, Eobj) do { pg8::Gemm g_{(const pg8::bf16_t*)(Aptr), (const pg8::bf16_t*)(Btptr), SEQ, (N_), (K8_) / 2}; pg8::StaticOrder S_; S_.init(SEQ, (N_), C.G, (int)blockIdx.x); \
    pg8::gemm_phase<EpiT, pg8::StaticOrder, GEMM_ALIGN, GEMM_SP2, true>(C.lds, g_, S_, Eobj); } while (0)
#define RUN_GEMM(EpiT, Aptr, Btptr, N_, K_, Eobj) do { pg8::Gemm g_{(const pg8::bf16_t*)(Aptr), (const pg8::bf16_t*)(Btptr), SEQ, (N_), (K_)}; pg8::StaticOrder S_; S_.init(SEQ, (N_), C.G, (int)blockIdx.x); \
    pg8::gemm_phase<EpiT, pg8::StaticOrder, GEMM_ALIGN, GEMM_SP2>(C.lds, g_, S_, Eobj); } while (0)

__global__ void __launch_bounds__(NWAVES * 64, 2) mk_fwd(Args args) {
    extern __shared__ __attribute__((aligned(16))) unsigned char lds_raw[];
    Ctx C; C.lds = (LAS unsigned char*)lds_raw; C.tid = threadIdx.x; C.lane = C.tid & 63; C.wave = __builtin_amdgcn_readfirstlane(C.tid >> 6);
    C.G = gridDim.x; { const int bx = blockIdx.x; C.vcu = (C.G % 8 == 0) ? (bx % 8) * (C.G / 8) + bx / 8 : bx; }
    volatile LAS unsigned* MISC = (volatile LAS unsigned*)(C.lds + MISC_OFF);
    if (C.tid < 64) MISC[C.tid] = 0u;
    __syncthreads();
    unsigned char* ws = args.ws;
    gu32* ctl = (gu32*)(ws + WS_CTL);
    XcdBarrier bar = xcd_barrier_post((unsigned*)(ctl + CW_BAR), MISC + 8);
#define GRID_BAR() xcd_barrier(bar)
    const float* x = args.in[I_X]; float* out = args.out;
    bf16* Win_bc = (bf16*)(ws + WS_WIN + 64 * MiB);     bf16* Wout_t = (bf16*)(ws + WS_WOUT); bf16* Wkvq_t = (bf16*)(ws + WS_WKVQ); bf16* Wo_t = (bf16*)(ws + WS_WO);
    bf16* Abuf = (bf16*)(ws + WS_A); bf16* MIX = (bf16*)(ws + WS_MIX);
    float* DTRAW = (float*)(ws + WS_DTRAW); float* DT = (float*)(ws + WS_DT); float* ACUM = (float*)(ws + WS_ACUM);
    bf16* ZX = (bf16*)(ws + WS_ZX); bf16* Y = (bf16*)(ws + WS_Y);
    bf16* Sbuf = (bf16*)(ws + WS_S); bf16* STb = (bf16*)(ws + WS_ST);
    bf16* ACT = (bf16*)(ws + WS_ACT); float* HALO = (float*)(ws + WS_HALO); float* RS = (float*)(ws + WS_RS); float* RSQ = (float*)(ws + WS_RSQ); float* CMAX = (float*)(ws + WS_CMAX); signed char* A8 = (signed char*)(ws + WS_A8);
    bf16* Qb = (bf16*)(ws + WS_Q); bf16* KVb = (bf16*)(ws + WS_KV); bf16* Ob = (bf16*)(ws + WS_O);

#define PHASE(rep, ...) do { __VA_ARGS__; GRID_BAR(); if constexpr ((rep) > 1) { __VA_ARGS__; GRID_BAR(); } } while (0)
    PHASE(REP_PRO,
#if defined(ZHI8) && defined(TRWIDE)
        tr_wide<true>(C, args.in[I_WIN], DM, QCOL0, args.in[I_NMPRE], Win_bc, 0, NIN);
        tr_wide<true>(C, args.in[I_WIN] + 2 * DINNER, DM, NIN - 2 * DINNER, args.in[I_NMPRE], Win_bc, QCOL0, NIN);
#elif defined(ZHI8) && defined(BCI8)
        tr_matrix(C, args.in[I_WIN], DM, QCOL0, args.in[I_NMPRE], Win_bc, 0, -1, 0, 0, 20, NIN);
        tr_matrix(C, args.in[I_WIN] + NZX, DM, NIN - NZX, args.in[I_NMPRE], Win_bc, QCOL0, -1, 0, 0, 20, NIN);
#elif defined(ZHI8)
        tr_matrix(C, args.in[I_WIN], DM, QCOL0, args.in[I_NMPRE], Win_bc, 0, -1, 0, 0, 20, NIN);
        tr_matrix(C, args.in[I_WIN] + 2 * DINNER, DM, NIN - 2 * DINNER, args.in[I_NMPRE], Win_bc, QCOL0, -1, 0, 0, 20, NIN);
#elif defined(XBCI8)
        tr_matrix(C, args.in[I_WIN], DM, DINNER, args.in[I_NMPRE], Win_bc, 0, -1, 0, 0, 20, NIN);
        tr_matrix(C, args.in[I_WIN] + NZX, DM, NIN - NZX, args.in[I_NMPRE], Win_bc, DINNER, -1, 0, 0, 20, NIN);
#elif defined(ZXI8)
        tr_matrix(C, args.in[I_WIN] + 2 * DINNER, DM, NIN - 2 * DINNER, args.in[I_NMPRE], Win_bc, 0, -1, 0, 0, 20, NIN);
#else
        tr_matrix(C, args.in[I_WIN], DM, DINNER, args.in[I_NMPRE], Win_bc, 0, -1, 0, 0, 20, NIN);
        tr_matrix(C, args.in[I_WIN] + 2 * DINNER, DM, NIN - 2 * DINNER, args.in[I_NMPRE], Win_bc, DINNER, -1, 0, 0, 20, NIN);
#endif
#ifdef TRWIDE
        tr_wide<true>(C, args.in[I_WOUT], DINNER, DM, args.in[I_SNORM], Wout_t, 0, DM);
#else
        tr_matrix(C, args.in[I_WOUT], DINNER, DM, args.in[I_SNORM], Wout_t, 0);
#endif
#ifndef TRWIDE
#ifdef NOIDLE
        tr_matrix(C, args.in[I_WDN], DFF, DM, nullptr, (bf16*)(ws + WS_WDN0), 0);
        tr_matrix(C, args.in[I_WDN] + (size_t)DFF * DM, DFF, DM, nullptr, (bf16*)(ws + WS_WDN1), 0);
        tr_matrix(C, args.in[I_WO], DM, DM, nullptr, Wo_t, 0);
#else
        tr_matrix(C, args.in[I_WDN], DFF, DM, nullptr, (bf16*)(ws + WS_WDN0), 0, -1, 0, 0, 9);
#endif
#endif
#ifdef TRWIDE
        tr_wide<true>(C, args.in[I_WKV], DM, 1024, args.in[I_KVN], Wkvq_t, 0, 1024);
        tr_wide<true>(C, args.in[I_WQ], DM, DM, args.in[I_NMPRE] + DM, Wkvq_t, 1024, DM);
        tr_matrix(C, args.in[I_WDN], DFF, DM, nullptr, (bf16*)(ws + WS_WDN0), 0, -1, 0, 0, 9);
#else
        tr_matrix(C, args.in[I_WKV], DM, 1024, args.in[I_KVN], Wkvq_t, 0);
#ifndef QI8
        tr_matrix(C, args.in[I_WQ], DM, DM, args.in[I_NMPRE] + DM, Wkvq_t, 1024);
#endif
#endif
        xnorm_phase(C, x, Abuf, (signed char*)MIX, RSQ);
        __syncthreads();
#ifdef QWIDE
        w_quant_wide<QWIDE>(C, args.in[I_WIN] + QCOL0, args.in[I_NMPRE], args.in[I_WUP], args.in[I_NFPRE], CMAX, (signed char*)(ws + WS_WIN), (signed char*)(ws + WS_WUP0), (signed char*)(ws + WS_WUP1), (unsigned*)(ctl + CW_QCNT)));
#elif defined(QPIPE)
        w_quant_pipe(C, args.in[I_WIN] + QCOL0, args.in[I_NMPRE], args.in[I_WUP], args.in[I_NFPRE], CMAX, (signed char*)(ws + WS_WIN), (signed char*)(ws + WS_WUP0), (signed char*)(ws + WS_WUP1), (unsigned*)(ctl + CW_QCNT)));
#else
#ifdef QI8
        { constexpr int T_IN = NZI8 / 16, T_UP = NUP / 16, T_Q = DM / 16;
          for (int t = C.vcu; t < T_IN + 2 * T_UP + T_Q; t += C.G) {
              if (t < T_IN) w_quant_half<false, NIN>(C, args.in[I_WIN] + QCOL0, args.in[I_NMPRE], CMAX + 2 * NUP, (signed char*)(ws + WS_WIN), (unsigned*)(ctl + CW_QCNT) + (t >> 1), t);
              else if (t < T_IN + 2 * T_UP) { const int u = t - T_IN, L = u >= T_UP ? 1 : 0;
                  w_quant_half<true, NUP>(C, args.in[I_WUP] + (size_t)L * DM * NUP, args.in[I_NFPRE] + L * DM, CMAX + L * NUP, (signed char*)(ws + (L ? WS_WUP1 : WS_WUP0)), (unsigned*)(ctl + CW_QCNT) + (t >> 1), u - L * T_UP); }
              else w_quant_half<false, DM>(C, args.in[I_WQ], args.in[I_NMPRE] + DM, CMAX + 2 * NUP + 16384, (signed char*)(ws + WS_WKVQ + 8 * MiB), (unsigned*)(ctl + CW_QCNT) + (t >> 1), t - T_IN - 2 * T_UP); } });
#else
        { constexpr int T_IN = NZI8 / 16, T_UP = NUP / 16;
          for (int t = C.vcu; t < T_IN + 2 * T_UP; t += C.G) {
              if (t < T_IN) w_quant_half<false, NIN>(C, args.in[I_WIN] + QCOL0, args.in[I_NMPRE], CMAX + 2 * NUP, (signed char*)(ws + WS_WIN), (unsigned*)(ctl + CW_QCNT) + (t >> 1), t);
              else { const int u = t - T_IN, L = u >= T_UP ? 1 : 0;
                  w_quant_half<true, NUP>(C, args.in[I_WUP] + (size_t)L * DM * NUP, args.in[I_NFPRE] + L * DM, CMAX + L * NUP, (signed char*)(ws + (L ? WS_WUP1 : WS_WUP0)), (unsigned*)(ctl + CW_QCNT) + (t >> 1), u - L * T_UP); } } });
#endif
#endif

#ifdef ZHI8
    PHASE(REP_GEMM_IN, { pg8::EpiOutI8 E{(pg8::bf16_t*)(ZX + QCOL0), NZX, nullptr, 1.0f, RSQ, CMAX + 2 * NUP}; RUN_GEMM_I8(pg8::EpiOutI8, (signed char*)MIX, ws + WS_WIN, NZI8, DM, E); }
#ifdef BCI8
        { pg8::EpiOut E{(pg8::bf16_t*)ZX, NZX, nullptr, 1.0f, nullptr, nullptr}; RUN_GEMM(pg8::EpiOut, Abuf, Win_bc, NBC, DM, E); }
#else
        { pg8::EpiZBC E{{(pg8::bf16_t*)ZX, NZX, nullptr, 1.0f, nullptr, nullptr}}; RUN_GEMM(pg8::EpiZBC, Abuf, Win_bc, NBC, DM, E); }
#endif
#elif defined(XBCI8)
    PHASE(REP_GEMM_IN, { pg8::EpiOutI8 E{(pg8::bf16_t*)(ZX + DINNER), NZX, nullptr, 1.0f, RSQ, CMAX + 2 * NUP}; RUN_GEMM_I8(pg8::EpiOutI8, (signed char*)MIX, ws + WS_WIN, NZI8, DM, E); }
        { pg8::EpiOut E{(pg8::bf16_t*)ZX, NZX, nullptr, 1.0f, nullptr, nullptr}; RUN_GEMM(pg8::EpiOut, Abuf, Win_bc, NBC, DM, E); }
#elif defined(ZXI8)
    PHASE(REP_GEMM_IN, { pg8::EpiOutI8 E{(pg8::bf16_t*)ZX, NZX, nullptr, 1.0f, RSQ, CMAX + 2 * NUP}; RUN_GEMM_I8(pg8::EpiOutI8, (signed char*)MIX, ws + WS_WIN, NZI8, DM, E); }
        { pg8::EpiOut E{(pg8::bf16_t*)(ZX + NZI8), NZX, nullptr, 1.0f, nullptr, nullptr}; RUN_GEMM(pg8::EpiOut, Abuf, Win_bc, NBC, DM, E); }
#else
    PHASE(REP_GEMM_IN, { pg8::EpiOutI8 E{(pg8::bf16_t*)(ZX + DINNER), NZX, nullptr, 1.0f, RSQ, CMAX + 2 * NUP}; RUN_GEMM_I8(pg8::EpiOutI8, (signed char*)MIX, ws + WS_WIN, NZI8, DM, E); }
        { pg8::EpiZBC E{{(pg8::bf16_t*)ZX, NZX, nullptr, 1.0f, nullptr, nullptr}}; RUN_GEMM(pg8::EpiZBC, Abuf, Win_bc, NBC, DM, E); }
#endif
        dt_gemm(C, Abuf, Win_bc + (size_t)NBC * DM, DTRAW));
    PHASE(REP_PREP, ssd_prep(C, DTRAW, args.in[I_DTB], args.in[I_ALOG], DT, ACUM));
    PHASE(REP_P2, for (int u = C.vcu; u < NCHUNK * NGRP; u += C.G) ssd_states_unit(C, u >> 3, u & 7, ZX, args.in[I_SCW], args.in[I_SCB], DT, ACUM, Sbuf));
    PHASE(REP_P3, ssd_scan(C, Sbuf, ACUM, STb));
    PHASE(REP_P4, for (int u = C.vcu; u < NCHUNK * NGRP; u += C.G) ssd_out_unit(C, u >> 3, u & 7, args.in[I_SCW], args.in[I_SCB], ZX, DT, ACUM, STb, args.in[I_D], Y));
    PHASE(REP_GEMM_OUT, { pg8::EpiOut E{(pg8::bf16_t*)MIX, DM, nullptr, 1.0f, nullptr, nullptr}; RUN_GEMM(pg8::EpiOut, Y, Wout_t, DM, DINNER, E); });
    PHASE(REP_THIN, thin_phase<true, false, true>(C, MIX, x, Abuf, args.in[I_NMPOST], RS, A8, RSQ));
    PHASE(REP_GEMM_UP, { pg8::EpiConvGateI8 E{CMAX, (pg8::bf16_t*)ACT, HALO, args.in[I_FCW], args.in[I_FCB], (LAS float*)(C.lds + 131072), DFF, NUP, RSQ}; RUN_GEMM_I8(pg8::EpiConvGateI8, A8, ws + WS_WUP0, NUP, DM, E); }
        IDLE_SLOT((SEQ / 256) * (NUP / 256), args.in[I_WDN], DFF, DM, nullptr, (bf16*)(ws + WS_WDN0), 9, 20));
    PHASE(REP_CONV, ffn_fixup(C, HALO, ACT, args.in[I_FCW], args.in[I_FCB]));
    PHASE(REP_GEMM_DN, { pg8::EpiOut E{(pg8::bf16_t*)MIX, DM, nullptr, 1.0f, nullptr, nullptr}; RUN_GEMM(pg8::EpiOut, ACT, ws + WS_WDN0, DM, DFF, E); });
#ifdef QI8
    PHASE(1, thin_phase<false, false, true>(C, MIX, Abuf, Abuf, args.in[I_NFPOST], RS, (signed char*)(ws + WS_BIG + 160 * MiB), RSQ));
#else
    PHASE(1, thin_phase<false, false>(C, MIX, Abuf, Abuf, args.in[I_NFPOST], RS));
#endif

#ifdef QI8
    PHASE(REP_GEMM_KVQ, { pg8::EpiOutI8 E{(pg8::bf16_t*)Qb, DM, args.in[I_BQ], 0.125f, RSQ, CMAX + 2 * NUP + 16384}; RUN_GEMM_I8(pg8::EpiOutI8, (signed char*)(ws + WS_BIG + 160 * MiB), ws + WS_WKVQ + 8 * MiB, DM, DM, E); }
        { pg8::EpiOut E{(pg8::bf16_t*)KVb, 1024, args.in[I_BKV], 1.0f, RS, nullptr}; RUN_GEMM(pg8::EpiOut, Abuf, Wkvq_t, 1024, DM, E); }
        IDLE_SLOT((SEQ / 256) * (1024 / 256), args.in[I_WO], DM, DM, nullptr, Wo_t, 0, 20);
        IDLE_SLOT((SEQ / 256) * (1024 / 256), args.in[I_WDN] + (size_t)DFF * DM, DFF, DM, nullptr, (bf16*)(ws + WS_WDN1), 0, 12));
#else
    PHASE(REP_GEMM_KVQ, { pg8::EpiKVQ E{(pg8::bf16_t*)KVb, (pg8::bf16_t*)Qb, args.in[I_BKV], args.in[I_BQ], 0.125f, RS}; RUN_GEMM(pg8::EpiKVQ, Abuf, Wkvq_t, NKVQ, DM, E); }
        IDLE_SLOT((SEQ / 256) * (NKVQ / 256), args.in[I_WO], DM, DM, nullptr, Wo_t, 0, 20);
        IDLE_SLOT((SEQ / 256) * (NKVQ / 256), args.in[I_WDN] + (size_t)DFF * DM, DFF, DM, nullptr, (bf16*)(ws + WS_WDN1), 0, 12));
#endif
#ifdef PROBE_KVQ_GEMMONLY
    PHASE(1, { pg8::EpiKVQ E{(pg8::bf16_t*)KVb, (pg8::bf16_t*)Qb, args.in[I_BKV], args.in[I_BQ], 0.125f, RS}; RUN_GEMM(pg8::EpiKVQ, Abuf, Wkvq_t, NKVQ, DM, E); });
#endif
    PHASE(REP_ATT, for (int u = C.vcu; u < (SEQ / 128) * 8; u += C.G) attn_unit(C, u >> 3, u & 7, Qb, KVb, Ob, args.in[I_SINK], args.in[I_RELB]));
    PHASE(REP_GEMM_O, { pg8::EpiOut E{(pg8::bf16_t*)MIX, DM, args.in[I_BO], 1.0f, nullptr, nullptr}; RUN_GEMM(pg8::EpiOut, Ob, Wo_t, DM, DM, E); });
    PHASE(1, thin_phase<false, false, true>(C, MIX, Abuf, Abuf, args.in[I_NMPOST] + DM, RS, A8, RSQ));
    PHASE(1, { pg8::EpiConvGateI8 E{CMAX + NUP, (pg8::bf16_t*)ACT, HALO, args.in[I_FCW] + 3 * NUP, args.in[I_FCB] + NUP, (LAS float*)(C.lds + 131072), DFF, NUP, RSQ}; RUN_GEMM_I8(pg8::EpiConvGateI8, A8, ws + WS_WUP1, NUP, DM, E); }
        IDLE_SLOT((SEQ / 256) * (NUP / 256), args.in[I_WDN] + (size_t)DFF * DM, DFF, DM, nullptr, (bf16*)(ws + WS_WDN1), 12, 20));
    PHASE(1, ffn_fixup(C, HALO, ACT, args.in[I_FCW] + 3 * NUP, args.in[I_FCB] + NUP));
    PHASE(1, { pg8::EpiOut E{(pg8::bf16_t*)MIX, DM, nullptr, 1.0f, nullptr, nullptr}; RUN_GEMM(pg8::EpiOut, ACT, ws + WS_WDN1, DM, DFF, E); });
    thin_phase<false, true>(C, MIX, Abuf, out, args.in[I_NFPOST] + DM, RS);
}

extern "C" void kernel_launch(void* const* d_in, const int* in_sizes, int n_in, void* d_out, int out_size, void* d_ws, size_t ws_size, hipStream_t stream) {
    static int grid = 0;
    if (grid == 0) {
        if (n_in != 26 || in_sizes[0] != SEQ * DM || out_size != SEQ * DM || ws_size < WS_END) { fprintf(stderr, "kernel_launch: unexpected shapes: n_in %d in0 %d out %d ws %zu (need %zu)\n", n_in, n_in > 0 ? in_sizes[0] : -1, out_size, ws_size, (size_t)WS_END); grid = -1; return; }
        int dev = 0, cus = 0, per_cu = 0;
        if (hipGetDevice(&dev) != hipSuccess || hipDeviceGetAttribute(&cus, hipDeviceAttributeMultiprocessorCount, dev) != hipSuccess) { fprintf(stderr, "kernel_launch: device query failed\n"); grid = -1; return; }
        if (hipFuncSetAttribute((const void*)mk_fwd, hipFuncAttributeMaxDynamicSharedMemorySize, LDS_BYTES) != hipSuccess) { fprintf(stderr, "kernel_launch: hipFuncSetAttribute failed\n"); grid = -1; return; }
        if (hipOccupancyMaxActiveBlocksPerMultiprocessor(&per_cu, (const void*)mk_fwd, NWAVES * 64, LDS_BYTES) != hipSuccess || per_cu < 1) fprintf(stderr, "kernel_launch: occupancy query reports %d\n", per_cu);
        (void)hipGetLastError();
        grid = cus;
    }
    if (grid < 0) return;
    if (hipMemsetAsync((char*)d_ws + WS_CTL, 0, CTL_ZERO_BYTES, stream) != hipSuccess) { fprintf(stderr, "kernel_launch: memset failed\n"); return; }
    Args a{};
    for (int i = 0; i < 26; ++i) a.in[i] = (const float*)d_in[i];
    a.out = (float*)d_out; a.ws = (unsigned char*)d_ws;
    hipLaunchKernelGGL(mk_fwd, dim3(grid), dim3(NWAVES * 64), LDS_BYTES, stream, a);
    const hipError_t le = hipPeekAtLastError();
    if (le != hipSuccess) fprintf(stderr, "kernel_launch: launch failed: %s\n", hipGetErrorName(le));
}
```
